# Optimizing an MI355X kernel written in HIP

```python
import math
import jax, jax.numpy as jnp
from jax import lax
import numpy as np

D_MODEL = 1024
BATCH = 2
SEQ = 16384
DEPTH = 1

CTX_LEN = 256
GRID_W = 64
MIX_W = D_MODEL
GDN_W = MIX_W // 2
SGU_W = MIX_W - GDN_W
HEAD_DIM = 128
GDN_HEADS = GDN_W // HEAD_DIM
SGU_GROUP = 128
SGU_GROUPS = SGU_W // SGU_GROUP
SGU_CHUNK = 128
DELTA_CHUNK = 64
CONV_W = 3
N_EXPERTS = 32
TOP_K = 4
D_FF = D_MODEL
SWIGLU_LIMIT = 7.0
SWIGLU_ALPHA = 1.702
MOE_BLOCK = 128
NORM_EPS = 1e-6

QKV_COLS = 3 * GDN_W
STATE_COLS = QKV_COLS + 4 * GDN_HEADS
Z_END = STATE_COLS + GDN_W
U_END = Z_END + SGU_W
PROJ_COLS = U_END + SGU_W

kernel_name = "hybrid_gdn_sgu_moe_prefix_dit"


def _rmsnorm(x, g):
    x32 = x.astype(jnp.float32)
    y = x32 * lax.rsqrt(jnp.mean(x32 * x32, -1, keepdims=True) + NORM_EPS)
    return (y * g.astype(jnp.float32)).astype(x.dtype)


def _layernorm(x, g, b):
    x32 = x.astype(jnp.float32)
    xc = x32 - jnp.mean(x32, -1, keepdims=True)
    y = xc * lax.rsqrt(jnp.mean(xc * xc, -1, keepdims=True) + NORM_EPS)
    return (y * g + b).astype(x.dtype)


def _l2norm(x):
    x32 = x.astype(jnp.float32)
    return x32 * lax.rsqrt(jnp.sum(x32 * x32, -1, keepdims=True) + NORM_EPS)


def _dwconv_centred(x, w):
    pad = CONV_W // 2
    L = x.shape[-2]
    xp = jnp.pad(x, [(0, 0)] * (x.ndim - 2) + [(pad, pad), (0, 0)])
    return sum(xp[..., j:j + L, :] * w[j] for j in range(CONV_W))


def _state_step(s, u_i, w_i, kd_i, gl_i):
    v_new = u_i - jnp.einsum('bhck,bhkv->bhcv', w_i, s)
    s_next = s * gl_i[..., None, None] + jnp.einsum('bhck,bhcv->bhkv', kd_i, v_new)
    return s_next, v_new


def _chunk_gated_delta(q, k, v, g, beta, s0, need_out):
    B, H, L, Dk = q.shape
    Dv = v.shape[-1]
    C = DELTA_CHUNK
    N = L // C
    q = q.reshape(B, H, N, C, Dk)
    k = k.reshape(B, H, N, C, Dk)
    v = v.reshape(B, H, N, C, Dv)
    g = jnp.cumsum(g.reshape(B, H, N, C), -1)
    beta = beta.reshape(B, H, N, C)
    incl = jnp.tril(jnp.ones((C, C), bool))
    strict = jnp.tril(jnp.ones((C, C), bool), -1)
    decay = jnp.where(incl, jnp.exp(jnp.where(incl, g[..., :, None] - g[..., None, :], 0.0)), 0.0)
    kb = k * beta[..., None]
    a = jnp.where(strict, jnp.einsum('bhnid,bhnjd->bhnij', kb, k) * decay, 0.0)
    eye = jnp.eye(C, dtype=q.dtype)
    t_inv = lax.linalg.triangular_solve(eye + a, jnp.broadcast_to(eye, a.shape), left_side=True,
                                        lower=True, unit_diagonal=True)
    u = jnp.einsum('bhnij,bhnjd->bhnid', t_inv, v * beta[..., None])
    w = jnp.einsum('bhnij,bhnjd->bhnid', t_inv, kb * jnp.exp(g)[..., None])
    k_dec = k * jnp.exp(g[..., -1:] - g)[..., None]
    g_last = jnp.exp(g[..., -1])
    to_scan = lambda t: jnp.moveaxis(t, 2, 0)
    if need_out:
        attn = jnp.where(incl, jnp.einsum('bhnid,bhnjd->bhnij', q, k) * decay, 0.0)
        q_dec = q * jnp.exp(g)[..., None]

        def step(s, xs):
            u_i, w_i, kd_i, gl_i, qd_i, at_i = xs
            s_next, v_new = _state_step(s, u_i, w_i, kd_i, gl_i)
            o = jnp.einsum('bhck,bhkv->bhcv', qd_i, s) + jnp.einsum('bhij,bhjv->bhiv', at_i, v_new)
            return s_next, o

        s, o = lax.scan(step, s0, tuple(map(to_scan, (u, w, k_dec, g_last, q_dec, attn))))
        return jnp.moveaxis(o, 0, 2).reshape(B, H, L, Dv), s

    def step_state(s, xs):
        s_next, _ = _state_step(s, *xs)
        return s_next, None

    s, _ = lax.scan(step_state, s0, tuple(map(to_scan, (u, w, k_dec, g_last))))
    return None, s


def _gdn_prepare(p, conv_w, a_log, dt_bias, rows):
    B, L, _ = p.shape
    qkv = p[..., :QKV_COLS].reshape(B, rows, L // rows, QKV_COLS)
    qkv = jax.nn.silu(_dwconv_centred(qkv, conv_w)).astype(jnp.float32)
    qkv = qkv.reshape(B, L, 3, GDN_HEADS, HEAD_DIM).transpose(2, 0, 3, 1, 4)
    q = _l2norm(qkv[0]) * (HEAD_DIM ** -0.5)
    k = _l2norm(qkv[1])
    v = qkv[2]
    ba = p[..., QKV_COLS:STATE_COLS].astype(jnp.float32).reshape(B, L, 2, 2, GDN_HEADS)
    ba = ba.transpose(2, 3, 0, 4, 1)
    beta = jax.nn.sigmoid(ba[0])
    g = -jnp.exp(a_log)[:, None, :, None] * jax.nn.softplus(ba[1] + dt_bias[:, None, :, None])
    return q, k, v, g, beta


def _gdn_bidir(q, k, v, g, beta, s0, need_out):
    flip = lambda t: jnp.flip(t, axis=2)
    o_f, s_f = _chunk_gated_delta(q, k, v, g[0], beta[0], s0[0], need_out)
    o_b, s_b = _chunk_gated_delta(flip(q), flip(k), flip(v), flip(g[1]), flip(beta[1]), s0[1], need_out)
    o = o_f + flip(o_b) if need_out else None
    return o, jnp.stack([s_f, s_b])


def _gdn_output(o, z, norm_g):
    B, H, L, Dv = o.shape
    o = o.transpose(0, 2, 1, 3)
    zz = z.reshape(B, L, H, Dv).astype(jnp.float32)
    o = o * lax.rsqrt(jnp.mean(o * o, -1, keepdims=True) + NORM_EPS) * norm_g * jax.nn.silu(zz)
    return o.reshape(B, L, GDN_W).astype(z.dtype)


def _sgu(p, ln_g, ln_b, w_s, b_s):
    B, L, _ = p.shape
    shp = (B, L // SGU_CHUNK, SGU_CHUNK, SGU_GROUPS, SGU_GROUP)
    u = jax.nn.gelu(p[..., Z_END:U_END]).reshape(shp)
    v = _layernorm(jax.nn.gelu(p[..., U_END:PROJ_COLS]).reshape(shp), ln_g, ln_b)
    s = jnp.einsum('gpq,bnqgc->bnpgc', w_s, v) + b_s.T[:, :, None]
    return (u * s).reshape(B, L, SGU_W)


def _moe(h, router_w, router_b, w_gu, b_gu, w_down, b_down):
    T, D = h.shape
    logits = (h @ router_w + router_b).astype(jnp.float32)
    top_v, top_i = lax.top_k(logits, TOP_K)
    gates = jax.nn.softmax(top_v, axis=-1).astype(h.dtype)
    n_assign = T * TOP_K
    flat_e = top_i.reshape(-1)
    order = jnp.argsort(flat_e)
    e_sorted = flat_e[order]
    tok_sorted = (order // TOP_K).astype(jnp.int32)
    gate_sorted = gates.reshape(-1)[order]
    counts = jnp.bincount(flat_e, length=N_EXPERTS)
    padded = (counts + MOE_BLOCK - 1) // MOE_BLOCK * MOE_BLOCK
    pad_end = jnp.cumsum(padded)
    dest = ((pad_end - padded)[e_sorted] + jnp.arange(n_assign)
            - (jnp.cumsum(counts) - counts)[e_sorted])
    n_blocks = -(-n_assign // MOE_BLOCK) + N_EXPERTS
    slot_tok = jnp.full((n_blocks * MOE_BLOCK,), T, jnp.int32).at[dest].set(tok_sorted)
    block_e = jnp.minimum(jnp.searchsorted(pad_end, jnp.arange(n_blocks) * MOE_BLOCK, side='right'),
                          N_EXPERTS - 1)
    xb = jnp.concatenate([h, jnp.zeros((1, D), h.dtype)])[slot_tok].reshape(n_blocks, MOE_BLOCK, D)

    def expert_block(args):
        xblk, e = args
        gu = xblk @ w_gu[e] + b_gu[e]
        gate = jnp.minimum(gu[:, ::2], SWIGLU_LIMIT)
        up = jnp.clip(gu[:, 1::2], -SWIGLU_LIMIT, SWIGLU_LIMIT)
        act = (up + 1.0) * gate * jax.nn.sigmoid(SWIGLU_ALPHA * gate)
        return act @ w_down[e] + b_down[e]

    yb = lax.map(expert_block, (xb, block_e))
    y = yb.reshape(-1, D)[dest] * gate_sorted[:, None]
    return jnp.zeros_like(h).at[tok_sorted].add(y)


def setup_inputs(seed: int = 0) -> dict:
    key = jax.random.key(seed)
    ks = jax.random.split(key, 24)
    D = D_MODEL
    nrm = lambda k, shape, s: jax.random.normal(k, shape, jnp.float32) * s
    dt = jnp.exp(jax.random.uniform(ks[10], (DEPTH, 2, GDN_HEADS), jnp.float32,
                                    minval=math.log(1e-3), maxval=math.log(1e-1)))
    return {
        "x": nrm(ks[0], (BATCH, SEQ, D), 1.0),
        "c": nrm(ks[1], (BATCH, D), 1.0),
        "ctx": nrm(ks[2], (BATCH, CTX_LEN, D), 1.0),
        "c_ctx": nrm(ks[3], (D,), 1.0),
        "w_ada": nrm(ks[4], (DEPTH, D, 6 * D), D ** -0.5),
        "b_ada": nrm(ks[5], (DEPTH, 6 * D), 0.02),
        "norm_g": 1.0 + nrm(ks[6], (DEPTH, 4, D), 0.05),
        "w_in": nrm(ks[7], (DEPTH, D, PROJ_COLS), D ** -0.5),
        "conv_w": nrm(ks[8], (DEPTH, CONV_W, QKV_COLS), CONV_W ** -0.5),
        "a_log": jnp.log(jax.random.uniform(ks[9], (DEPTH, 2, GDN_HEADS), jnp.float32, minval=1.0, maxval=16.0)),
        "dt_bias": dt + jnp.log(-jnp.expm1(-dt)),
        "gdn_norm_g": 1.0 + nrm(ks[11], (DEPTH, HEAD_DIM), 0.05),
        "sgu_ln_g": 1.0 + nrm(ks[12], (DEPTH, SGU_GROUPS, SGU_GROUP), 0.05),
        "sgu_ln_b": nrm(ks[13], (DEPTH, SGU_GROUPS, SGU_GROUP), 0.02),
        "sgu_w": nrm(ks[14], (DEPTH, SGU_GROUPS, SGU_CHUNK, SGU_CHUNK), SGU_CHUNK ** -0.5),
        "sgu_b": 1.0 + nrm(ks[15], (DEPTH, SGU_GROUPS, SGU_CHUNK), 0.1),
        "w_out": nrm(ks[16], (DEPTH, MIX_W, D), MIX_W ** -0.5),
        "router_w": nrm(ks[17], (DEPTH, D, N_EXPERTS), D ** -0.5),
        "router_b": nrm(ks[18], (DEPTH, N_EXPERTS), 0.01),
        "w_gu": nrm(ks[19], (DEPTH, N_EXPERTS, D, 2 * D_FF), D ** -0.5),
        "b_gu": nrm(ks[20], (DEPTH, N_EXPERTS, 2 * D_FF), 0.02),
        "w_down": nrm(ks[21], (DEPTH, N_EXPERTS, D_FF, D), D_FF ** -0.5),
        "b_down": nrm(ks[22], (DEPTH, N_EXPERTS, D), 0.02),
    }


def reference(x, c, ctx, c_ctx, w_ada, b_ada, norm_g, w_in, conv_w, a_log, dt_bias, gdn_norm_g,
              sgu_ln_g, sgu_ln_b, sgu_w, sgu_b, w_out, router_w, router_b, w_gu, b_gu, w_down, b_down):
    B, L, D = x.shape
    rows = L // GRID_W
    xc = ctx
    for layer in range(DEPTH):
        last = layer == DEPTH - 1
        mod = (jax.nn.silu(c) @ w_ada[layer] + b_ada[layer]).reshape(B, 6, 1, D)
        mod_c = (jax.nn.silu(c_ctx) @ w_ada[layer] + b_ada[layer]).reshape(6, 1, 1, D)
        ng = norm_g[layer]

        h = _rmsnorm(x, ng[0]) * (1.0 + mod[:, 1]) + mod[:, 0]
        hc = _rmsnorm(xc, ng[0]) * (1.0 + mod_c[1]) + mod_c[0]
        p = h @ w_in[layer]
        pc = hc @ (w_in[layer][:, :STATE_COLS] if last else w_in[layer])

        qc, kc, vc, gcx, bcx = _gdn_prepare(pc, conv_w[layer], a_log[layer], dt_bias[layer], 1)
        s_zero = jnp.zeros((2, B, GDN_HEADS, HEAD_DIM, HEAD_DIM), jnp.float32)
        oc, s_ctx = _gdn_bidir(qc, kc, vc, gcx, bcx, s_zero, not last)

        q, k, v, g, beta = _gdn_prepare(p, conv_w[layer], a_log[layer], dt_bias[layer], rows)
        o, _ = _gdn_bidir(q, k, v, g, beta, s_ctx, True)
        mix = jnp.concatenate([
            _gdn_output(o, p[..., STATE_COLS:Z_END], gdn_norm_g[layer]),
            _sgu(p, sgu_ln_g[layer], sgu_ln_b[layer], sgu_w[layer], sgu_b[layer])], axis=-1)
        x = x + mod[:, 2] * _rmsnorm(mix @ w_out[layer], ng[1])
        if not last:
            mix_c = jnp.concatenate([
                _gdn_output(oc, pc[..., STATE_COLS:Z_END], gdn_norm_g[layer]),
                _sgu(pc, sgu_ln_g[layer], sgu_ln_b[layer], sgu_w[layer], sgu_b[layer])], axis=-1)
            xc = xc + mod_c[2] * _rmsnorm(mix_c @ w_out[layer], ng[1])

        h = (_rmsnorm(x, ng[2]) * (1.0 + mod[:, 4]) + mod[:, 3]).reshape(-1, D)
        if not last:
            hc = (_rmsnorm(xc, ng[2]) * (1.0 + mod_c[4]) + mod_c[3]).reshape(-1, D)
            h = jnp.concatenate([h, hc], axis=0)
        y = _moe(h, router_w[layer], router_b[layer], w_gu[layer], b_gu[layer], w_down[layer], b_down[layer])
        x = x + mod[:, 5] * _rmsnorm(y[:B * L].reshape(B, L, D), ng[3])
        if not last:
            xc = xc + mod_c[5] * _rmsnorm(y[B * L:].reshape(xc.shape), ng[3])
    return x
```

```cpp
#include <hip/hip_runtime.h>
#include <cstdio>
#include <cstdint>
namespace pg8 {
#define PG8_LAS __attribute__((address_space(3)))
typedef unsigned short bf16_t;
typedef short bf16x8 __attribute__((ext_vector_type(8)));
typedef float f32x4 __attribute__((ext_vector_type(4)));
typedef unsigned u32x4 __attribute__((ext_vector_type(4)));
constexpr int BM = 256, BK = 64, HALF = 128, HTB = HALF * BK * 2  , STAGE_BYTES = 8 * HTB, NXCD = 8, WGM = 8;

__host__ __device__ __forceinline__ int lds_byte(int r, int c) { const int st = (r >> 4) * 2 + (c >> 5), rr = r & 15, cc = c & 31, ob = rr * 64 + cc * 2; return st * 1024 + (ob ^ (((ob >> 9) & 1) << 5)); }
__host__ __device__ __forceinline__ void stage_rc(int b, int& R, int& C) { const int st = b / 1024, sb = b % 1024, swz = sb ^ (((sb >> 9) & 1) << 5); R = (st >> 1) * 16 + swz / 64; C = (st & 1) * 32 + (swz % 64) / 2; }
__host__ __device__ __forceinline__ int perm32(int rho) { const int n = rho >> 4, i = rho & 15; return 8 * (i >> 2) + 4 * n + (i & 3); }

struct Unit { int pm, pn; };
struct Gemm { const bf16_t* A; const bf16_t* Bt; int M, N, K; };

struct StaticOrder {
    int nM, nN, nwg, G, c;
    __host__ __device__ void init(int M, int N, int G_, int c_) { nM = M / BM; nN = N / BM; nwg = nM * nN; G = G_; c = c_; }
    __host__ __device__ bool next(int i, Unit& u) const {
        const long L = (long)i * G + c; if (L >= nwg) return false;
        int wgid = (int)L; { const int q = nwg / NXCD, r = nwg % NXCD, xcd = wgid % NXCD, off = wgid / NXCD; wgid = (xcd < r ? xcd * (q + 1) : r * (q + 1) + (xcd - r) * q) + off; }
        const int nig = WGM * nN, gid = wgid / nig, fm = gid * WGM, gsz = (nM - fm) < WGM ? (nM - fm) : WGM;
        u.pm = fm + ((wgid % nig) % gsz); u.pn = (wgid % nig) / gsz; return true;
    }
    __device__ __forceinline__ void a_ready(const Unit&) const {}
    __device__ __forceinline__ void done(const Unit&) const {}
};
__device__ __forceinline__ unsigned cvt_pk_bf16(float lo, float hi) { unsigned r; asm volatile("v_cvt_pk_bf16_f32 %0, %1, %2" : "=v"(r) : "v"(lo), "v"(hi)); return r; }
template <class Epi, class Sched, bool ALIGN_EPI = false, bool SP2 = false, bool FP8 = false, bool GATHER = false>
__device__ __forceinline__ void gemm_phase(PG8_LAS unsigned char* lds, const Gemm g, const Sched& S, const Epi& E, const PG8_LAS int* gmap = nullptr) {
    typedef int i32x8_ __attribute__((ext_vector_type(8))); typedef int i32x4_ __attribute__((ext_vector_type(4)));
    const int tid = threadIdx.x, wid = __builtin_amdgcn_readfirstlane(tid >> 6), lane = tid & 63, wr = wid >> 2, wc = wid & 3, fr = lane & 15, fq = lane >> 4;
    const int K = g.K, nt = K / BK;
    unsigned voffA[2], voffB[2];
    int gR[2]; unsigned gCb[2]; unsigned gC0[2], gC1[2], gN0[2], gN1[2];
#pragma unroll
    for (int i = 0; i < 2; ++i) { int R, C; stage_rc(tid * 16 + i * 8192, R, C); const int Rb = Epi::PERM ? ((R & ~31) + perm32(R & 31)) : R;
        voffA[i] = (unsigned)(R * K + C) * 2u; voffB[i] = (unsigned)(Rb * K + C) * 2u; gR[i] = R; gCb[i] = (unsigned)C * 2u; }
#define PG8_GOFF(D0, D1, ui_) do { _Pragma("unroll") for (int i_ = 0; i_ < 2; ++i_) { D0[i_] = (unsigned)gmap[(ui_) * 256 + gR[i_]] * (unsigned)(K * 2) + gCb[i_]; D1[i_] = (unsigned)gmap[(ui_) * 256 + 128 + gR[i_]] * (unsigned)(K * 2) + gCb[i_]; } } while (0)
#define PG8_STAGE_A(bufoff, gbase, h_, nx_) do { if constexpr (GATHER) { if (nx_) PG8_STAGE(bufoff, gbase, ((h_) ? gN1 : gN0)); else PG8_STAGE(bufoff, gbase, ((h_) ? gC1 : gC0)); } \
        else PG8_STAGE(bufoff, (gbase) + ((h_) ? hstep : 0), voffA); } while (0)
    const size_t kstep = (size_t)(BK * 2);
    const size_t hstep = (size_t)HALF * K * 2;
    const size_t tstep = 2 * hstep;
    const unsigned ldsw = (unsigned)wid * 1024u;
    const int aoff = lds_byte(wr * 64 + fr, fq * 8), boff = lds_byte(wc * 32 + fr, fq * 8);
#define PG8_SA(b, h) (((b) * 2 + (h)) * HTB)
#define PG8_SB(b, h) ((4 + (b) * 2 + (h)) * HTB)
#define PG8_STAGE(bufoff, gbase, voff) do { _Pragma("unroll") for (int _i = 0; _i < 2; ++_i) \
        __builtin_amdgcn_global_load_lds((const unsigned*)((const char*)(gbase) + (voff)[_i]), (PG8_LAS unsigned*)(lds + (bufoff) + ldsw + _i * 8192), 16, 0, 0); } while (0)
#define PG8_LDA(dst, b, h) do { _Pragma("unroll") for (int m = 0; m < 4; ++m) _Pragma("unroll") for (int k = 0; k < 2; ++k) dst[m][k] = *(const PG8_LAS bf16x8*)(lds + PG8_SA(b, h) + aoff + m * 2048 + k * 1024); } while (0)
#define PG8_LDB(dst, b, h) do { _Pragma("unroll") for (int n = 0; n < 2; ++n) _Pragma("unroll") for (int k = 0; k < 2; ++k) dst[n][k] = *(const PG8_LAS bf16x8*)(lds + PG8_SB(b, h) + boff + n * 2048 + k * 1024); } while (0)
#define PG8_MMA16(ai, bj, At, Bt) do { __builtin_amdgcn_s_setprio(1); _Pragma("unroll") for (int m = 0; m < 4; ++m) _Pragma("unroll") for (int n = 0; n < 2; ++n) _Pragma("unroll") for (int k = 0; k < 2; ++k) \
        acc[ai][bj][m][n] = __builtin_amdgcn_mfma_f32_16x16x32_bf16(Bt[n][k], At[m][k], acc[ai][bj][m][n], 0, 0, 0); __builtin_amdgcn_s_setprio(0); } while (0)
#define PG8_LDA8(dst, b, h) do { _Pragma("unroll") for (int m = 0; m < 4; ++m) { const i32x4_ lo_ = *(const PG8_LAS i32x4_*)(lds + PG8_SA(b, h) + aoff + m * 2048), hi_ = *(const PG8_LAS i32x4_*)(lds + PG8_SA(b, h) + aoff + m * 2048 + 1024); \
        dst[m] = __builtin_shufflevector(lo_, hi_, 0, 1, 2, 3, 4, 5, 6, 7); } } while (0)
#define PG8_LDB8(dst, b, h) do { _Pragma("unroll") for (int n = 0; n < 2; ++n) { const i32x4_ lo_ = *(const PG8_LAS i32x4_*)(lds + PG8_SB(b, h) + boff + n * 2048), hi_ = *(const PG8_LAS i32x4_*)(lds + PG8_SB(b, h) + boff + n * 2048 + 1024); \
        dst[n] = __builtin_shufflevector(lo_, hi_, 0, 1, 2, 3, 4, 5, 6, 7); } } while (0)
#define PG8_MMA8(ai, bj, At, Bt) do { __builtin_amdgcn_s_setprio(1); _Pragma("unroll") for (int m = 0; m < 4; ++m) _Pragma("unroll") for (int n = 0; n < 2; ++n) \
        asm volatile("v_mfma_scale_f32_16x16x128_f8f6f4 %0, %1, %2, %0, %3, %3 op_sel_hi:[0,0,0]" : "+v"(acc[ai][bj][m][n]) : "v"(Bt[n]), "v"(At[m]), "v"(scale1)); \
        __builtin_amdgcn_s_setprio(0); } while (0)
#define PG8_LDAX(dst, b, h) do { if constexpr (FP8) PG8_LDA8(dst##8, b, h); else PG8_LDA(dst, b, h); } while (0)
#define PG8_LDBX(dst, b, h) do { if constexpr (FP8) PG8_LDB8(dst##8, b, h); else PG8_LDB(dst, b, h); } while (0)
#define PG8_MMA(ai, bj, At, Bt) do { if constexpr (FP8) PG8_MMA8(ai, bj, At##8, Bt##8); else PG8_MMA16(ai, bj, At, Bt); } while (0)
#define PG8_WAIT_V(n) asm volatile("s_waitcnt vmcnt(" #n ")" ::: "memory")
#define PG8_WAIT_L(n) asm volatile("s_waitcnt lgkmcnt(" #n ")" ::: "memory")
#define PG8_BAR __builtin_amdgcn_s_barrier()
#define PG8_SCHED __builtin_amdgcn_sched_barrier(0)
    Unit cur, nxt; int ui = 0;
    if (!S.next(0, cur)) return;
    f32x4 acc[2][2][4][2];
#pragma unroll
    for (int a = 0; a < 2; ++a)
#pragma unroll
        for (int b = 0; b < 2; ++b)
#pragma unroll
            for (int m = 0; m < 4; ++m)
#pragma unroll
                for (int n = 0; n < 2; ++n) acc[a][b][m][n] = (f32x4){0.f, 0.f, 0.f, 0.f};
    bf16x8 At[4][2], B0[2][2], B1[2][2];
    i32x8_ At8[4], B08[2], B18[2]; int scale1 = 0x7f7f7f7f; asm volatile("" : "+v"(scale1));
    const char* cA = (const char*)g.A + (GATHER ? (size_t)0 : (size_t)cur.pm * tstep); const char* cB = (const char*)g.Bt + (size_t)cur.pn * tstep;
    if constexpr (GATHER) { PG8_GOFF(gC0, gC1, 0); }
    S.a_ready(cur);
    if constexpr (SP2) {
        PG8_STAGE(PG8_SB(0, 0), cB, voffB); PG8_STAGE(PG8_SB(0, 1), cB + hstep, voffB); PG8_STAGE_A(PG8_SA(0, 0), cA, 0, false); PG8_STAGE_A(PG8_SA(0, 1), cA, 1, false);
        if (wr == 1) PG8_BAR;
        PG8_WAIT_V(2); PG8_BAR;
        PG8_STAGE(PG8_SB(1, 0), cB + kstep, voffB); PG8_STAGE_A(PG8_SA(1, 0), cA + kstep, 0, false); PG8_STAGE(PG8_SB(1, 1), cB + hstep + kstep, voffB);
        PG8_WAIT_V(6); PG8_BAR;
    } else {
        PG8_STAGE(PG8_SB(0, 0), cB, voffB); PG8_STAGE(PG8_SA(0, 0), cA, voffA); PG8_STAGE(PG8_SB(0, 1), cB + hstep, voffB); PG8_STAGE(PG8_SA(0, 1), cA + hstep, voffA);
        if (wr == 1) PG8_BAR;
        PG8_WAIT_V(4); PG8_BAR;
        PG8_STAGE(PG8_SB(1, 0), cB + kstep, voffB); PG8_STAGE(PG8_SA(1, 0), cA + kstep, voffA); PG8_STAGE(PG8_SB(1, 1), cB + hstep + kstep, voffB);
        PG8_WAIT_V(6); PG8_BAR;
    }
    for (;;) {
        const bool has_next = S.next(ui + 1, nxt);
        const char* nA = (has_next && !GATHER) ? (const char*)g.A + (size_t)nxt.pm * tstep : cA; const char* nB = has_next ? (const char*)g.Bt + (size_t)nxt.pn * tstep : cB;
        if constexpr (GATHER) { if (has_next) { PG8_GOFF(gN0, gN1, ui + 1); } else { _Pragma("unroll") for (int i_ = 0; i_ < 2; ++i_) { gN0[i_] = gC0[i_]; gN1[i_] = gC1[i_]; } } }
#pragma clang loop unroll(disable)
        for (int t = 0; t < nt; t += 2) {
            const bool last = (t == nt - 2);
            const char* a1 = cA + (size_t)(t + 1) * kstep;
            const char* a2 = last ? nA : cA + (size_t)(t + 2) * kstep; const char* b2 = last ? nB : cB + (size_t)(t + 2) * kstep;
            const char* a3 = a2 + kstep; const char* b3 = b2 + kstep;
            if (last && has_next) S.a_ready(nxt);
            if constexpr (SP2) {
            PG8_LDBX(B0, 0, 0); PG8_LDBX(B1, 0, 1); PG8_SCHED; PG8_LDAX(At, 0, 0); PG8_STAGE_A(PG8_SA(1, 1), a1, 1, false);
            PG8_WAIT_V(8); PG8_WAIT_L(0); PG8_BAR; PG8_MMA(0, 0, At, B0); PG8_MMA(0, 1, At, B1); PG8_BAR; PG8_SCHED;
            PG8_LDAX(At, 0, 1); PG8_STAGE(PG8_SB(0, 0), b2, voffB); PG8_STAGE(PG8_SB(0, 1), b2 + hstep, voffB); PG8_STAGE_A(PG8_SA(0, 0), a2, 0, last);
            PG8_WAIT_V(8); PG8_WAIT_L(0); PG8_BAR; PG8_MMA(1, 0, At, B0); PG8_MMA(1, 1, At, B1); PG8_BAR; PG8_SCHED;
            PG8_LDBX(B0, 1, 0); PG8_LDBX(B1, 1, 1); PG8_SCHED; PG8_LDAX(At, 1, 0); PG8_STAGE_A(PG8_SA(0, 1), a2, 1, last);
            PG8_WAIT_V(8); PG8_WAIT_L(0); PG8_BAR; PG8_MMA(0, 0, At, B0); PG8_MMA(0, 1, At, B1); PG8_BAR; PG8_SCHED;
            PG8_LDAX(At, 1, 1); PG8_STAGE(PG8_SB(1, 0), b3, voffB); PG8_STAGE(PG8_SB(1, 1), b3 + hstep, voffB); PG8_STAGE_A(PG8_SA(1, 0), a3, 0, last);
            PG8_WAIT_V(8); PG8_WAIT_L(0); PG8_BAR; PG8_MMA(1, 0, At, B0); PG8_MMA(1, 1, At, B1); PG8_BAR; PG8_SCHED;
            } else {
            PG8_LDBX(B0, 0, 0); PG8_SCHED; PG8_LDAX(At, 0, 0); PG8_STAGE(PG8_SA(1, 1), a1 + hstep, voffA);
            PG8_WAIT_L(8); PG8_BAR; PG8_WAIT_L(0); PG8_MMA(0, 0, At, B0); PG8_BAR; PG8_SCHED;
            PG8_LDBX(B1, 0, 1); PG8_STAGE(PG8_SB(0, 0), b2, voffB);
            PG8_BAR; PG8_WAIT_L(0); PG8_MMA(0, 1, At, B1); PG8_BAR;
            PG8_LDAX(At, 0, 1); PG8_STAGE(PG8_SA(0, 0), a2, voffA);
            PG8_BAR; PG8_WAIT_L(0); PG8_MMA(1, 0, At, B0); PG8_BAR; PG8_SCHED;
            PG8_STAGE(PG8_SB(0, 1), b2 + hstep, voffB);
            PG8_WAIT_V(6); PG8_BAR; PG8_MMA(1, 1, At, B1); PG8_BAR;
            PG8_LDBX(B0, 1, 0); PG8_SCHED; PG8_LDAX(At, 1, 0); PG8_STAGE(PG8_SA(0, 1), a2 + hstep, voffA);
            PG8_WAIT_L(8); PG8_BAR; PG8_WAIT_L(0); PG8_MMA(0, 0, At, B0); PG8_BAR; PG8_SCHED;
            PG8_LDBX(B1, 1, 1); PG8_STAGE(PG8_SB(1, 0), b3, voffB);
            PG8_BAR; PG8_WAIT_L(0); PG8_MMA(0, 1, At, B1); PG8_BAR;
            PG8_LDAX(At, 1, 1); PG8_STAGE(PG8_SA(1, 0), a3, voffA);
            PG8_BAR; PG8_WAIT_L(0); PG8_MMA(1, 0, At, B0); PG8_BAR; PG8_SCHED;
            PG8_STAGE(PG8_SB(1, 1), b3 + hstep, voffB);
            PG8_WAIT_V(6); PG8_BAR; PG8_MMA(1, 1, At, B1); PG8_BAR;
            }
        }
        if constexpr (ALIGN_EPI) { if (wr == 0) PG8_BAR; }
        if constexpr (FP8) asm volatile("s_nop 15\n\ts_nop 15\n\ts_nop 15\n\ts_nop 15\n\ts_nop 15" ::: "memory");
        if constexpr (!Epi::AFTER_DRAIN) { Unit eu = cur; int fr_ = fr, fq_ = fq; asm volatile("" : "+v"(eu.pm), "+v"(eu.pn), "+v"(fr_), "+v"(fq_));
            E(acc, eu, wr, wc, fr_, fq_); S.done(cur); }
        if (!has_next) break;
#pragma unroll
        for (int a = 0; a < 2; ++a)
#pragma unroll
            for (int b = 0; b < 2; ++b)
#pragma unroll
                for (int m = 0; m < 4; ++m)
#pragma unroll
                    for (int n = 0; n < 2; ++n) acc[a][b][m][n] = (f32x4){0.f, 0.f, 0.f, 0.f};
        cur = nxt; cA = nA; cB = nB; ++ui;
        if constexpr (GATHER) { _Pragma("unroll") for (int i_ = 0; i_ < 2; ++i_) { gC0[i_] = gN0[i_]; gC1[i_] = gN1[i_]; } }
        if constexpr (ALIGN_EPI) { if (wr == 1) PG8_BAR; }
    }
    PG8_WAIT_V(0);
    if constexpr (!ALIGN_EPI) { if (wr == 0) PG8_BAR; }
    PG8_BAR;
    if constexpr (Epi::AFTER_DRAIN) { E.fused(acc, cur, wr, wc, fr, fq, lds, wid, lane); S.done(cur); }
#undef PG8_SA
#undef PG8_SB
#undef PG8_STAGE
#undef PG8_STAGE_A
#undef PG8_GOFF
#undef PG8_LDA
#undef PG8_LDB
#undef PG8_MMA
#undef PG8_MMA16
#undef PG8_MMA8
#undef PG8_LDA8
#undef PG8_LDB8
#undef PG8_LDAX
#undef PG8_LDBX
#undef PG8_WAIT_V
#undef PG8_WAIT_L
#undef PG8_BAR
#undef PG8_SCHED
}
}

#ifndef MK_PER_PHASE
#define MK_PER_PHASE 0
#endif
#ifndef PROBE_TWICE
#define PROBE_TWICE -1
#endif
#ifndef DBG_SEL
#define DBG_SEL 9
#endif
#ifndef DBG_MODE
#define DBG_MODE 0
#endif
#if 0
#endif

#define GAS __attribute__((address_space(1)))
#define LAS __attribute__((address_space(3)))
typedef unsigned short bf16;
typedef float f32x4 __attribute__((ext_vector_type(4)));
typedef short bf16x8 __attribute__((ext_vector_type(8)));
typedef unsigned u32x4 __attribute__((ext_vector_type(4)));
typedef unsigned u32x2 __attribute__((ext_vector_type(2)));

constexpr int NB = 2, SEQ = 16384, D = 1024, T = NB * SEQ, CTXL = 256, TC = NB * CTXL, TALL = T + TC;
constexpr int NPROJ = 3328, NPROJ_SRC = 3088;
constexpr int PC_Z = 1536, PC_U = 2048, PC_V = 2560, PC_BA = 3072;
constexpr int NH = 4, NE = 32, NCH = 260;
constexpr int MAXPAN = 544, MAXROWS = MAXPAN * 256;
constexpr float EPS = 1e-6f;
constexpr int NWAVES = 8, NTHR = 512;
constexpr int NPHASE = 12;
constexpr int CV_A0 = 0, CV_A1 = 5712, CV_B1 = CV_A1 + 5376, CV_C1 = CV_B1 + 2304, CV_D0 = NE * 768 - 3072;

constexpr size_t MiB = 1ull << 20;
constexpr size_t WS_CTL = 0, CTL_BYTES = 1 * MiB;
constexpr size_t WS_MOD = 1 * MiB;
constexpr size_t WS_WRT = 1 * MiB + 128 * 1024;
constexpr size_t WS_BGUP = 1 * MiB + 256 * 1024;
constexpr size_t WS_TKE = 2 * MiB, WS_TKRANK = 2 * MiB + 512 * 1024, WS_TKGATE = 3 * MiB, WS_TKROW = 3 * MiB + 512 * 1024;
constexpr size_t WS_ROWGATE = 4 * MiB;
constexpr size_t WS_WINT = 6 * MiB;
constexpr size_t WS_WOUTT = 13 * MiB;
constexpr size_t WS_WGUT = 16 * MiB;
constexpr size_t WS_WDT = 144 * MiB;
constexpr size_t WS_X1 = 208 * MiB;
constexpr size_t WS_MIX = WS_X1;
constexpr size_t WS_H2 = 336 * MiB;
constexpr size_t WS_R1 = 400 * MiB;
constexpr size_t WS_P = WS_R1, WS_ACT = WS_R1;
constexpr size_t WS_R2 = 672 * MiB;
constexpr size_t WS_HALL = WS_R2, WS_O = WS_R2;
constexpr size_t WS_PREP = WS_R2 + 65 * MiB;
constexpr size_t WS_R = WS_PREP;
constexpr size_t WS_VEC = WS_R2 + 261 * MiB;
constexpr size_t WS_ETOK = WS_X1 + 64 * MiB, WS_EGATE = WS_ETOK + 4 * MiB;
constexpr int ECAP = 32768;
constexpr size_t WS_ROWTOK = WS_R2;
constexpr size_t WS_XS = WS_R2, WS_Y = WS_R2;
constexpr size_t WS_END = 944 * MiB;
constexpr size_t PREP_UNIT = 98304;
constexpr int PO_KQ = 0, PO_KT = 32768, PO_V = 49152, PO_T = 65536, PO_A = 81920;
constexpr int CW_BAR = 4096, CW_GCNT = 8192;

constexpr int LDS_BYTES = 163840;
constexpr int LDS_TAB = 131072;
constexpr int LDS_GMAP = LDS_TAB + 4096;
constexpr int LDS_MISC = LDS_BYTES - 64;

#define LDS_WAIT() asm volatile("s_waitcnt lgkmcnt(0)" ::: "memory")
#define VM_WAIT() asm volatile("s_waitcnt vmcnt(0)" ::: "memory")

__device__ __forceinline__ float bf2f(unsigned b) { return __uint_as_float(b << 16); }
__device__ __forceinline__ float bflo(unsigned w) { return __uint_as_float(w << 16); }
__device__ __forceinline__ float bfhi(unsigned w) { return __uint_as_float(w & 0xffff0000u); }
typedef __bf16 bf16x2_t __attribute__((ext_vector_type(2)));
typedef float f32x2_t __attribute__((ext_vector_type(2)));
__device__ __forceinline__ unsigned pk2(float lo, float hi) { const f32x2_t f = {lo, hi}; const bf16x2_t v = __builtin_convertvector(f, bf16x2_t); return __builtin_bit_cast(unsigned, v); }
__device__ __forceinline__ float sat8(float x) { return __builtin_amdgcn_fmed3f(x, -448.f, 448.f); }
__device__ __forceinline__ unsigned pk_fp8x4(float a, float b, float c, float d) { a = sat8(a); b = sat8(b); c = sat8(c); d = sat8(d); int w = 0; w = __builtin_amdgcn_cvt_pk_fp8_f32(a, b, w, false); w = __builtin_amdgcn_cvt_pk_fp8_f32(c, d, w, true); return (unsigned)w; }
constexpr float W8_SCALE = 32.f, W8_INV = 1.f / 32.f;
__device__ __forceinline__ float frcp(float x) { return __builtin_amdgcn_rcpf(x); }
__device__ __forceinline__ float sigm(float x) { return frcp(1.f + __expf(-x)); }
__device__ __forceinline__ float silu_(float x) { return x * frcp(1.f + __expf(-x)); }
__device__ __forceinline__ float gelu_t(float x) { const float y = 0.7978845608028654f * (x + 0.044715f * x * x * x); const float t = 1.f - 2.f * frcp(__expf(2.f * y) + 1.f); return 0.5f * x * (1.f + t); }
#define DPP_MOV(v, ctrl) __builtin_bit_cast(float, __builtin_amdgcn_update_dpp(0, __builtin_bit_cast(int, (v)), (ctrl), 0xf, 0xf, true))
__device__ __forceinline__ float sum16(float v) { v += DPP_MOV(v, 0xB1); v += DPP_MOV(v, 0x4E); v += DPP_MOV(v, 0x124); v += DPP_MOV(v, 0x128); return v; }
__device__ __forceinline__ float wave_sum(float v) {
    v = sum16(v); const int iv = __builtin_bit_cast(int, v);
    return (__builtin_bit_cast(float, __builtin_amdgcn_readlane(iv, 0)) + __builtin_bit_cast(float, __builtin_amdgcn_readlane(iv, 16))) + (__builtin_bit_cast(float, __builtin_amdgcn_readlane(iv, 32)) + __builtin_bit_cast(float, __builtin_amdgcn_readlane(iv, 48)));
}
#define XB_TMO      128
#define XB_XCNT(j)  (256  + 64 * (j))
#define XB_XSUB(j)  (1280 + 64 * (j))
#define XB_XGEN(j)  (2304 + 64 * (j))
#define XB_TOP      3328
#define XB_TOPGEN   3392
#define XCD_BAR_WORDS 3456
#define XB_SPIN_CAP (1u << 18)
__device__ __forceinline__ unsigned xb_ld(unsigned* p)              { return __hip_atomic_load(p, __ATOMIC_RELAXED, __HIP_MEMORY_SCOPE_AGENT); }
__device__ __forceinline__ unsigned xb_add(unsigned* p, unsigned v) { return __hip_atomic_fetch_add(p, v, __ATOMIC_RELAXED, __HIP_MEMORY_SCOPE_AGENT); }
__device__ __forceinline__ unsigned xb_xcc_id() { return (unsigned)__builtin_amdgcn_s_getreg((3 << 11) | 20) & 0xFu; }
#define XB_SPIN(cond, bar) do { unsigned _sp = 0; while (cond) { __builtin_amdgcn_s_sleep(1); \
    if ((++_sp & 255u) == 0u) { if (xb_ld(&(bar)[XB_TMO])) break; if (_sp > XB_SPIN_CAP) { atomicAdd(&(bar)[XB_TMO], 1u); break; } } } } while (0)
struct XcdBarrier { unsigned* bar; unsigned x; volatile LAS unsigned* st; };
__device__ __forceinline__ XcdBarrier xcd_barrier_post(unsigned* bar, volatile LAS unsigned* st) {
    XcdBarrier b; b.bar = bar; b.x = xb_xcc_id(); b.st = st;
    if (threadIdx.x == 0) (void)xb_add(&bar[XB_XCNT(b.x)], 1u);
    return b;
}
__device__ __forceinline__ void xcd_barrier_complete(unsigned* bar, unsigned x, unsigned& nloc, unsigned& nx) {
    const unsigned G = gridDim.x * gridDim.y * gridDim.z;
    unsigned sum, cnt, mine, sp = 0u;
    for (;;) {
        sum = 0u; cnt = 0u; mine = 0u;
#pragma unroll
        for (unsigned j = 0; j < 16; ++j) { const unsigned c = xb_ld(&bar[XB_XCNT(j)]); sum += c; cnt += (c > 0u) ? 1u : 0u; mine = (j == x) ? c : mine; }
        if (sum == G) break;
        __builtin_amdgcn_s_sleep(1);
        if ((++sp & 255u) == 0u) { if (xb_ld(&bar[XB_TMO])) break; if (sp > XB_SPIN_CAP) { atomicAdd(&bar[XB_TMO], 1u); break; } }
    }
    nloc = mine > 0u ? mine : 1u; nx = cnt > 0u ? cnt : 1u;
}
__device__ __forceinline__ void xcd_barrier(const XcdBarrier& b) {
    asm volatile("s_waitcnt vmcnt(0)" ::: "memory");
    __syncthreads();
    if (threadIdx.x == 0) {
        unsigned* bar = b.bar;
        __builtin_amdgcn_s_waitcnt(0);
        unsigned nloc = b.st[0], nx = b.st[1];
        if (nloc == 0u) { xcd_barrier_complete(bar, b.x, nloc, nx); b.st[0] = nloc; b.st[1] = nx; }
        const unsigned old = xb_add(&bar[XB_XSUB(b.x)], 1u);
        const unsigned gen = old / nloc;
        if (old + 1u == (gen + 1u) * nloc) {
            __builtin_amdgcn_fence(__ATOMIC_RELEASE, "agent");
            asm volatile("s_waitcnt vmcnt(0)" ::: "memory");
            const unsigned og = xb_add(&bar[XB_TOP], 1u);
            const unsigned tg = og / nx;
            if (og + 1u == (tg + 1u) * nx) xb_add(&bar[XB_TOPGEN], 1u);
            else XB_SPIN(xb_ld(&bar[XB_TOPGEN]) == tg, bar);
            __builtin_amdgcn_fence(__ATOMIC_ACQUIRE, "agent");
            xb_add(&bar[XB_XGEN(b.x)], 1u);
            asm volatile("s_waitcnt vmcnt(0)" ::: "memory");
        } else {
            XB_SPIN(xb_ld(&bar[XB_XGEN(b.x)]) == gen, bar);
            __builtin_amdgcn_fence(__ATOMIC_ACQUIRE, "agent");
            asm volatile("s_waitcnt vmcnt(0)" ::: "memory");
        }
    }
    __syncthreads();
}

struct Fr {
    LAS unsigned char* lds; unsigned char* ws; const float* in[23]; float* out;
    int tid, lane, wave, wg, G;
};
#define WSP(T_, off) ((T_*)(F.ws + (off)))

struct MapId { __device__ __forceinline__ int operator()(int n) const { return n; } };
struct MapIn { __device__ __forceinline__ int operator()(int n) const { return n < 1536 ? n : (n < 1552 ? PC_BA + (n - 1536) : n - 16); } };
struct MapGu { __device__ __forceinline__ int operator()(int s) const { const int a = s >> 1; return 32 * (a >> 4) + 16 * (s & 1) + (a & 15); } };
template <class RM> __device__ __forceinline__ void tr_item(const float* W, int N, int k0, int n0, bf16* WT, RM rm, LAS float* scr, int lane) {
    const int cq = lane & 15, rq = lane >> 4;
#pragma unroll
    for (int i = 0; i < 16; ++i) { const int kk = 4 * i + rq, n = n0 + 4 * cq; f32x4 v = (f32x4){0.f, 0.f, 0.f, 0.f};
        if (n < N) v = *(const f32x4*)(W + (size_t)(k0 + kk) * N + n);
        *(LAS f32x4*)(scr + kk * 68 + 4 * cq) = v; }
    LDS_WAIT();
    const int c = lane & 7;
#pragma unroll
    for (int j = 0; j < 8; ++j) { const int n = 8 * j + (lane >> 3);
        if (n0 + n < N) { const LAS float* s = scr + (8 * c) * 68 + n;
            u32x4 o; o.x = pk2(s[0], s[68]); o.y = pk2(s[136], s[204]); o.z = pk2(s[272], s[340]); o.w = pk2(s[408], s[476]);
            *(u32x4*)(WT + (size_t)rm(n0 + n) * 1024 + k0 + 8 * c) = o; } }
    LDS_WAIT();
}
struct MapGu8 { __device__ __forceinline__ int operator()(int s) const { const int a = s >> 1, n = s & 1, pn = a >> 7, al = a & 127; return 256 * pn + 128 * ((al >> 2) & 1) + 32 * (al >> 5) + 16 * n + 4 * ((al >> 3) & 3) + (al & 3); } };
template <class RM> __device__ __forceinline__ void tr_item8(const float* W, int N, int k0, int n0, unsigned char* WT, RM rm, LAS float* scr, int lane) {
    const int cq = lane & 15, rq = lane >> 4;
#pragma unroll
    for (int i = 0; i < 16; ++i) { const int kk = 4 * i + rq, n = n0 + 4 * cq; *(LAS f32x4*)(scr + kk * 68 + 4 * cq) = *(const f32x4*)(W + (size_t)(k0 + kk) * N + n); }
    LDS_WAIT();
    const int c = lane & 7;
#pragma unroll
    for (int j = 0; j < 8; ++j) { const int n = 8 * j + (lane >> 3); const LAS float* sp = scr + (8 * c) * 68 + n;
        u32x2 o; o.x = pk_fp8x4(sp[0] * W8_SCALE, sp[68] * W8_SCALE, sp[136] * W8_SCALE, sp[204] * W8_SCALE); o.y = pk_fp8x4(sp[272] * W8_SCALE, sp[340] * W8_SCALE, sp[408] * W8_SCALE, sp[476] * W8_SCALE);
        *(u32x2*)(WT + (size_t)rm(n0 + n) * 1024 + k0 + 8 * c) = o; }
    LDS_WAIT();
}
__device__ __forceinline__ void p0_prologue(const Fr& F) {
    const float* c = F.in[1]; const float* cc = F.in[3]; const float* wada = F.in[4]; const float* bada = F.in[5];
    {
        LAS float* SIL = (LAS float*)F.lds; LAS float* RED = SIL + 3072; float* MOD = WSP(float, WS_MOD);
        for (int u = F.wg; u < 96; u += F.G) {
            for (int i = F.tid; i < 3072; i += NTHR) { const int r = i >> 10, k = i & 1023; const float x = r == 0 ? c[k] : (r == 1 ? c[1024 + k] : cc[k]); SIL[i] = silu_(x); }
            __syncthreads();
            const int n0 = u * 64, kb = F.wave * 128; float a0 = 0.f, a1 = 0.f, a2 = 0.f;
#pragma unroll 8
            for (int k = 0; k < 128; ++k) { const float w = wada[(size_t)(kb + k) * 6144 + n0 + F.lane]; a0 += SIL[kb + k] * w; a1 += SIL[1024 + kb + k] * w; a2 += SIL[2048 + kb + k] * w; }
            RED[(F.wave * 3 + 0) * 64 + F.lane] = a0; RED[(F.wave * 3 + 1) * 64 + F.lane] = a1; RED[(F.wave * 3 + 2) * 64 + F.lane] = a2;
            __syncthreads();
            if (F.tid < 192) { const int r = F.tid >> 6, l = F.tid & 63; float s = bada[n0 + l];
#pragma unroll
                for (int w = 0; w < 8; ++w) s += RED[(w * 3 + r) * 64 + l];
                MOD[r * 6144 + n0 + l] = s; }
            __syncthreads();
        }
    }
    {
        LAS float* scr = (LAS float*)(F.lds + F.wave * 17408);
        const int gw = F.wg * NWAVES + F.wave, NGW = F.G * NWAVES;
        constexpr int I_IN = 16 * 49, I_OUT = 16 * 16;
        for (int it = gw; it < I_IN + I_OUT; it += NGW) {
            int r = it;
            if (r < I_IN) { tr_item(F.in[7], NPROJ_SRC, (r / 49) * 64, (r % 49) * 64, WSP(bf16, WS_WINT), MapIn{}, scr, F.lane); continue; } r -= I_IN;
            tr_item(F.in[16], 1024, (r / 16) * 64, (r % 16) * 64, WSP(bf16, WS_WOUTT), MapId{}, scr, F.lane);
        }
    }
    {
        const int gt = F.wg * NTHR + F.tid, NGT = F.G * NTHR;
        float* WRT = WSP(float, WS_WRT); const float* rw = F.in[17];
        for (int i = gt; i < NE * 1024; i += NGT) { const int e = i >> 10, k = i & 1023; WRT[i] = rw[k * NE + e]; }
        float* BG = WSP(float, WS_BGUP); const float* bgu = F.in[20]; MapGu8 mg;
        for (int i = gt; i < NE * 2048; i += NGT) { const int e = i >> 11, s = i & 2047; BG[e * 2048 + mg(s)] = bgu[i]; }
        { u32x4* ez = (u32x4*)WSP(int, WS_ETOK); for (int i = gt; i < NE * ECAP / 4; i += NGT) ez[i] = (u32x4){0u, 0u, 0u, 0u}; }
        u32x4* z = (u32x4*)(WSP(bf16, WS_WINT) + (size_t)NPROJ_SRC * 1024);
        for (int i = gt; i < (NPROJ - NPROJ_SRC) * 1024 / 8; i += NGT) z[i] = (u32x4){0u, 0u, 0u, 0u};
    }
}

__device__ __forceinline__ void p4_convert(const Fr& F, int worker, int nworkers, int it_lo, int it_hi) {
    LAS float* scr = (LAS float*)(F.lds + F.wave * 17408);
    const int gw = worker * NWAVES + F.wave, NGW = nworkers * NWAVES;
    constexpr int I_GU = NE * 16 * 32, I_DN = NE * 16 * 16;
    for (int it = it_lo + gw; it < it_hi; it += NGW) {
        int r = it;
        if (r < I_GU) { const int e = r / 512, rr = r % 512; tr_item8(F.in[19] + (size_t)e * 1024 * 2048, 2048, (rr / 32) * 64, (rr % 32) * 64, WSP(unsigned char, WS_WGUT) + (size_t)e * 2048 * 1024, MapGu8{}, scr, F.lane); continue; } r -= I_GU;
        { const int e = r / 256, rr = r % 256; tr_item8(F.in[21] + (size_t)e * 1024 * 1024, 1024, (rr / 16) * 64, (rr % 16) * 64, WSP(unsigned char, WS_WDT) + (size_t)e * 1024 * 1024, MapId{}, scr, F.lane); }
    }
}
__device__ __forceinline__ void p1_norm(const Fr& F) {
    const float* x = F.in[0]; const float* ctx = F.in[2]; const float* ng = F.in[6]; const float* MOD = WSP(float, WS_MOD); bf16* H = WSP(bf16, WS_HALL);
    const int gw = F.wg * NWAVES + F.wave, NGW = F.G * NWAVES, lane = F.lane;
    for (int blk = gw; blk < TALL / 4; blk += NGW) {
        const int r0 = blk * 4; const float* xb = r0 < T ? x + (size_t)r0 * D : ctx + (size_t)(r0 - T) * D; const int mi = r0 < T ? (r0 >> 14) : 2;
        const float* m0 = MOD + mi * 6144; const float* m1 = m0 + 1024;
        f32x4 sc[4], sh[4];
#pragma unroll
        for (int j = 0; j < 4; ++j) { const int k = 256 * j + 4 * lane; sc[j] = *(const f32x4*)(ng + k) * (*(const f32x4*)(m1 + k) + 1.f); sh[j] = *(const f32x4*)(m0 + k); }
        f32x4 cur[4], nxt[4];
#pragma unroll
        for (int j = 0; j < 4; ++j) cur[j] = *(const f32x4*)(xb + 256 * j + 4 * lane);
#pragma clang loop unroll(disable)
        for (int i = 0; i < 4; ++i) {
            const int in = i + 1 < 4 ? i + 1 : i;
#pragma unroll
            for (int j = 0; j < 4; ++j) nxt[j] = *(const f32x4*)(xb + (size_t)in * D + 256 * j + 4 * lane);
            float ss = 0.f;
#pragma unroll
            for (int j = 0; j < 4; ++j) ss += (cur[j].x * cur[j].x + cur[j].y * cur[j].y) + (cur[j].z * cur[j].z + cur[j].w * cur[j].w);
            const float rstd = rsqrtf(wave_sum(ss) * (1.f / D) + EPS);
#pragma unroll
            for (int j = 0; j < 4; ++j) { const f32x4 h = cur[j] * rstd * sc[j] + sh[j];
                u32x2 o; o.x = pk2(h.x, h.y); o.y = pk2(h.z, h.w); *(u32x2*)(H + (size_t)(r0 + i) * D + 256 * j + 4 * lane) = o; cur[j] = nxt[j]; }
        }
    }
}

__device__ __forceinline__ void p3_prep(const Fr& F) {
    const bf16* P = WSP(bf16, WS_P); const float* convw = F.in[8]; const float* alog = F.in[9]; const float* dtb = F.in[10];
    LAS bf16* QL = (LAS bf16*)F.lds; LAS bf16* KL = QL + 64 * 136; LAS bf16* VL = KL + 64 * 136;
    LAS float* AM = (LAS float*)(F.lds + 52224); LAS float* XM = AM + 2 * 64 * 65; LAS bf16* AT = (LAS bf16*)(F.lds + 118784);
    LAS float* TMPW = (LAS float*)(F.lds + 137216); LAS float* GV = (LAS float*)(F.lds + 139392);
    for (int u = F.wg; u < NB * NCH * NH; u += F.G) {
        int tid = F.tid; asm volatile("" : "+v"(tid));
        const int lane = tid & 63, wave = __builtin_amdgcn_readfirstlane(tid >> 6), l16 = lane & 15, q4 = lane >> 4;
        const int b = u / (NCH * NH), rem = u % (NCH * NH), cn = rem >> 2, h = rem & 3;
        int rowbase, lo, hi;
        if (cn < 4) { lo = T + b * CTXL; hi = lo + CTXL; rowbase = lo + cn * 64; } else { rowbase = b * SEQ + (cn - 4) * 64; lo = rowbase; hi = rowbase + 64; }
        unsigned char* pu = F.ws + WS_PREP + (size_t)u * PREP_UNIT; float* vec = WSP(float, WS_VEC) + (size_t)u * 512;
        u32x4 xc[6], xn[6]; f32x4 cwc[6], cwn[6];
#define P3_LOAD(XD, WD, part_) do { const int cg_ = tid & 15, col_ = (part_) * 512 + h * 128 + cg_ * 8; \
            _Pragma("unroll") for (int sub_ = 0; sub_ < 2; ++sub_) { const int row_ = rowbase + (sub_ << 5) + (tid >> 4); const u32x4 zero_ = (u32x4){0u, 0u, 0u, 0u}; \
                XD[sub_ * 3 + 1] = *(const u32x4*)(P + (size_t)row_ * NPROJ + col_); XD[sub_ * 3 + 0] = zero_; XD[sub_ * 3 + 2] = zero_; \
                if (row_ - 1 >= lo) XD[sub_ * 3 + 0] = *(const u32x4*)(P + (size_t)(row_ - 1) * NPROJ + col_); \
                if (row_ + 1 < hi) XD[sub_ * 3 + 2] = *(const u32x4*)(P + (size_t)(row_ + 1) * NPROJ + col_); } \
            _Pragma("unroll") for (int hh_ = 0; hh_ < 2; ++hh_) { WD[hh_ * 3 + 0] = *(const f32x4*)(convw + col_ + 4 * hh_); WD[hh_ * 3 + 1] = *(const f32x4*)(convw + 1536 + col_ + 4 * hh_); WD[hh_ * 3 + 2] = *(const f32x4*)(convw + 3072 + col_ + 4 * hh_); } } while (0)
        P3_LOAD(xc, cwc, 0);
#pragma unroll
        for (int part = 0; part < 3; ++part) {
            const int cg = tid & 15;
            if (part < 2) P3_LOAD(xn, cwn, part + 1);
#pragma unroll
            for (int sub = 0; sub < 2; ++sub) {
                const int i = (sub << 5) + (tid >> 4);
                const u32x4 xm = xc[sub * 3 + 0], x0 = xc[sub * 3 + 1], xp = xc[sub * 3 + 2];
                float val[8];
#pragma unroll
                for (int hh = 0; hh < 2; ++hh) {
                    const f32x4 w0 = cwc[hh * 3 + 0], w1 = cwc[hh * 3 + 1], w2 = cwc[hh * 3 + 2];
                    const unsigned m0 = hh ? xm.z : xm.x, m1 = hh ? xm.w : xm.y, c0 = hh ? x0.z : x0.x, c1 = hh ? x0.w : x0.y, p0 = hh ? xp.z : xp.x, p1 = hh ? xp.w : xp.y;
                    val[4 * hh + 0] = w0.x * bflo(m0) + w1.x * bflo(c0) + w2.x * bflo(p0);
                    val[4 * hh + 1] = w0.y * bfhi(m0) + w1.y * bfhi(c0) + w2.y * bfhi(p0);
                    val[4 * hh + 2] = w0.z * bflo(m1) + w1.z * bflo(c1) + w2.z * bflo(p1);
                    val[4 * hh + 3] = w0.w * bfhi(m1) + w1.w * bfhi(c1) + w2.w * bfhi(p1);
                }
                float ss = 0.f;
#pragma unroll
                for (int e = 0; e < 8; ++e) { val[e] = silu_(val[e]); ss += val[e] * val[e]; }
                if (part < 2) { ss = sum16(ss); const float sc = rsqrtf(ss + EPS) * (part == 0 ? 0.08838834764831845f : 1.f);
#pragma unroll
                    for (int e = 0; e < 8; ++e) val[e] *= sc; }
                u32x4 w; w.x = pk2(val[0], val[1]); w.y = pk2(val[2], val[3]); w.z = pk2(val[4], val[5]); w.w = pk2(val[6], val[7]);
                LAS bf16* dst = part == 0 ? QL : (part == 1 ? KL : VL);
                *(LAS u32x4*)(dst + i * 136 + cg * 8) = w;
                if (part < 2) { const int rb = (part == 0 ? 4 : 0) + (i >> 4), ks = cg >> 2, ln = (i & 15) + 16 * (cg & 3);
                    *(u32x4*)(pu + PO_KQ + ((rb * 4 + ks) * 64 + ln) * 16) = w; }
            }
#pragma unroll
            for (int e = 0; e < 6; ++e) { cwc[e] = cwn[e]; xc[e] = xn[e]; }
        }
#undef P3_LOAD
        if (wave < 2) {
            const int d = wave, row = rowbase + lane;
            const float bb = bf2f(P[(size_t)row * NPROJ + PC_BA + d * 4 + h]), aa = bf2f(P[(size_t)row * NPROJ + PC_BA + 8 + d * 4 + h]);
            const float beta = sigm(bb), xx = aa + dtb[d * 4 + h];
            const float sp = xx > 20.f ? xx : log1pf(expf(xx));
            float Gc = -expf(alog[d * 4 + h]) * sp;
#pragma unroll
            for (int o = 1; o < 64; o <<= 1) { const float up = __shfl_up(Gc, o), dn = __shfl_down(Gc, o);
                if (d == 0) { if (lane >= o) Gc += up; } else { if (lane + o < 64) Gc += dn; } }
            const float glast = __shfl(Gc, d == 0 ? 63 : 0);
            GV[d * 64 + lane] = Gc; GV[128 + d * 64 + lane] = beta;
            float* vd = vec + d * 256;
            vd[lane] = expf(Gc); vd[64 + lane] = beta; vd[128 + lane] = expf(glast - Gc); vd[192 + lane] = expf(glast);
        }
        __syncthreads();
#pragma unroll
        for (int jj = 0; jj < 4; ++jj) {
            const int job = wave * 4 + jj, mat = job >> 4, ti = (job >> 2) & 3, tj = job & 3;
            const LAS bf16* Ap = (mat == 0 ? KL : QL) + (ti * 16 + l16) * 136 + q4 * 8;
            const LAS bf16* Bp = KL + (tj * 16 + l16) * 136 + q4 * 8;
            f32x4 acc = (f32x4){0.f, 0.f, 0.f, 0.f};
#pragma unroll
            for (int ks = 0; ks < 4; ++ks) acc = __builtin_amdgcn_mfma_f32_16x16x32_bf16(*(const LAS bf16x8*)(Ap + ks * 32), *(const LAS bf16x8*)(Bp + ks * 32), acc, 0, 0, 0);
            const int j = tj * 16 + l16;
#pragma unroll
            for (int d = 0; d < 2; ++d) {
                const float Gj = GV[d * 64 + j];
#pragma unroll
                for (int r = 0; r < 4; ++r) { const int i = ti * 16 + 4 * q4 + r; const float Gi = GV[d * 64 + i];
                    const float dec = __expf(fminf(Gi - Gj, 0.f));
                    if (mat == 0) { const bool ok = d == 0 ? (j < i) : (j > i); const float v = ok ? GV[128 + d * 64 + i] * acc[r] * dec : 0.f;
                        const int ii = d == 0 ? i : 63 - i, jx = d == 0 ? j : 63 - j; AM[d * 4160 + ii * 65 + jx] = v; }
                    else { const bool ok = d == 0 ? (j <= i) : (j >= i); const float v = ok ? acc[r] * dec : 0.f; AT[d * 4608 + i * 72 + j] = (bf16)(pk2(v, 0.f) & 0xffffu); }
                }
            }
        }
        __syncthreads();
        if (wave < 2) {
            const int d = wave; LAS float* A = AM + d * 4160; LAS float* X = XM + d * 4160; LAS float* TW = TMPW + d * 272;
            for (int r = 0; r < 64; ++r) X[r * 65 + lane] = 0.f;
            LDS_WAIT();
            { const int blk = q4, c = l16; const LAS float* Ab = A + (blk * 16) * 65 + blk * 16; float xv[16];
#pragma unroll
                for (int r = 0; r < 16; ++r) { float s = (r == c) ? 1.f : 0.f;
#pragma unroll
                    for (int m = 0; m < r; ++m) s -= Ab[r * 65 + m] * xv[m];
                    xv[r] = s; }
#pragma unroll
                for (int r = 0; r < 16; ++r) X[(blk * 16 + r) * 65 + blk * 16 + c] = xv[r];
            }
            LDS_WAIT();
#pragma unroll
            for (int dd = 1; dd <= 3; ++dd)
#pragma unroll
                for (int a = dd; a <= 3; ++a) { const int bq = a - dd;
                    f32x4 acc = (f32x4){0.f, 0.f, 0.f, 0.f};
#pragma unroll
                    for (int cc2 = bq; cc2 < a; ++cc2)
#pragma unroll
                        for (int kk = 0; kk < 4; ++kk) { const float av = A[(a * 16 + l16) * 65 + cc2 * 16 + 4 * kk + q4], bv = X[(cc2 * 16 + 4 * kk + q4) * 65 + bq * 16 + l16];
                            acc = __builtin_amdgcn_mfma_f32_16x16x4f32(av, bv, acc, 0, 0, 0); }
#pragma unroll
                    for (int r = 0; r < 4; ++r) TW[(4 * q4 + r) * 17 + l16] = acc[r];
                    LDS_WAIT();
                    f32x4 acc2 = (f32x4){0.f, 0.f, 0.f, 0.f};
#pragma unroll
                    for (int kk = 0; kk < 4; ++kk) { const float av = X[(a * 16 + l16) * 65 + a * 16 + 4 * kk + q4], bv = TW[(4 * kk + q4) * 17 + l16];
                        acc2 = __builtin_amdgcn_mfma_f32_16x16x4f32(av, bv, acc2, 0, 0, 0); }
#pragma unroll
                    for (int r = 0; r < 4; ++r) X[(a * 16 + 4 * q4 + r) * 65 + bq * 16 + l16] = -acc2[r];
                    LDS_WAIT();
                }
        } else {
            const int t6 = tid - 128;
            for (int idx = t6; idx < 1024; idx += 384) { const int d = idx >> 9, e = idx & 511, rb = e >> 7, ks = (e >> 6) & 1, ln = e & 63, i = rb * 16 + (ln & 15), j0 = ks * 32 + (ln >> 4) * 8;
                *(u32x4*)(pu + PO_A + d * 8192 + e * 16) = *(const LAS u32x4*)(AT + d * 4608 + i * 72 + j0); }
            for (int e = t6; e < 1024; e += 384) { const int mb = e >> 7, ks = (e >> 6) & 1, ln = e & 63, m = mb * 16 + (ln & 15), kk0 = ks * 32 + (ln >> 4) * 8;
                unsigned short kv[8];
#pragma unroll
                for (int jj = 0; jj < 8; ++jj) kv[jj] = KL[(kk0 + jj) * 136 + m];
                u32x4 w; w.x = kv[0] | ((unsigned)kv[1] << 16); w.y = kv[2] | ((unsigned)kv[3] << 16); w.z = kv[4] | ((unsigned)kv[5] << 16); w.w = kv[6] | ((unsigned)kv[7] << 16);
                *(u32x4*)(pu + PO_KT + e * 16) = w; }
            for (int e = t6; e < 2048; e += 384) { const int nt = e >> 8, rb = (e >> 6) & 3, ln = e & 63, col = nt * 16 + (ln & 15), row0 = rb * 16 + 4 * (ln >> 4);
                const unsigned v0 = VL[(row0 + 0) * 136 + col], v1 = VL[(row0 + 1) * 136 + col], v2 = VL[(row0 + 2) * 136 + col], v3 = VL[(row0 + 3) * 136 + col];
                u32x2 w; w.x = v0 | (v1 << 16); w.y = v2 | (v3 << 16);
                *(u32x2*)(pu + PO_V + e * 8) = w; }
        }
        __syncthreads();
#pragma unroll
        for (int rep = 0; rep < 2; ++rep) { const int idx = rep * NTHR + tid, d = idx >> 9, e = idx & 511, rb = e >> 7, ks = (e >> 6) & 1, ln = e & 63, i = rb * 16 + (ln & 15), j0 = ks * 32 + (ln >> 4) * 8;
            float tv[8];
#pragma unroll
            for (int jj = 0; jj < 8; ++jj) tv[jj] = d == 0 ? XM[i * 65 + j0 + jj] : XM[4160 + (63 - i) * 65 + (63 - (j0 + jj))];
            u32x4 w; w.x = pk2(tv[0], tv[1]); w.y = pk2(tv[2], tv[3]); w.z = pk2(tv[4], tv[5]); w.w = pk2(tv[6], tv[7]);
            *(u32x4*)(pu + PO_T + d * 8192 + e * 16) = w;
        }
        __syncthreads();
    }
}

constexpr int SNT = 8;
constexpr size_t WS_SLOC = WS_R1 + 212 * MiB, WS_PMAT = WS_SLOC + 16 * MiB, WS_SST = WS_PMAT + 16 * MiB;
__device__ __forceinline__ int sb_lo(int j) { return j < 4 ? 17 * j : 68 + 16 * (j - 4); }
struct ScanRegs { bf16x8 kqA[4], kqB[4]; bf16x8 kt[2], ta[2]; f32x4 eg; float gl; u32x2 vv[SNT]; f32x4 be, kd; };
struct ScanAddr { const unsigned char* pu; const float* vd; };
__device__ __forceinline__ ScanAddr scan_addr(const unsigned char* ws, int d, int b, int h, int s) {
    const int cn = d == 0 ? s : (s < 4 ? 3 - s : 263 - s);
    const int u = (b * NCH + cn) * NH + h;
    ScanAddr a; a.pu = ws + WS_PREP + (size_t)u * PREP_UNIT; a.vd = (const float*)(ws + WS_VEC) + (size_t)u * 512 + d * 256; return a;
}
template <bool OUT> __device__ __forceinline__ void ld_kq(bf16x8 (&kq)[4], const ScanAddr& a, int w, int lane) {
    const int rb = OUT ? w : (w & 3);
#pragma unroll
    for (int ks = 0; ks < 4; ++ks) kq[ks] = *(const bf16x8*)(a.pu + PO_KQ + ((rb * 4 + ks) * 64 + lane) * 16);
}
template <bool HASV, bool OUT> __device__ __forceinline__ void ld_p1(ScanRegs& R, const ScanAddr& a, int w, int lane) {
    const int r0 = 16 * (w & 3) + 4 * (lane >> 4);
    R.eg = *(const f32x4*)(a.vd + r0); R.be = *(const f32x4*)(a.vd + 64 + r0);
    if (HASV) { const int nt0 = OUT ? 0 : 4 * (w >> 2);
#pragma unroll
        for (int i = 0; i < (OUT ? SNT : SNT / 2); ++i) R.vv[i] = *(const u32x2*)(a.pu + PO_V + (((nt0 + i) * 4 + (w & 3)) * 64 + lane) * 8); }
}
template <bool OUT> __device__ __forceinline__ void ld_ta(ScanRegs& R, const ScanAddr& a, int d, int w, int lane) {
    const int tao = ((OUT && w >= 4) ? PO_A : PO_T) + d * 8192;
#pragma unroll
    for (int ks = 0; ks < 2; ++ks) R.ta[ks] = *(const bf16x8*)(a.pu + tao + (((w & 3) * 2 + ks) * 64 + lane) * 16);
}
__device__ __forceinline__ void ld_p3(ScanRegs& R, const ScanAddr& a, int w, int lane) {
#pragma unroll
    for (int ks = 0; ks < 2; ++ks) R.kt[ks] = *(const bf16x8*)(a.pu + PO_KT + ((w * 2 + ks) * 64 + lane) * 16);
    R.gl = a.vd[192];
}
template <bool HASV, bool OUT, int PAR>
__device__ __forceinline__ void scan_step(ScanRegs& R, f32x4 (&S)[SNT], LAS bf16* ST, LAS bf16* TT, LAS bf16* VN, LAS bf16* VS, bf16* Od, int col0,
                                          const unsigned char* ws, int d, int b, int h, int s, int s1, int w, int lane) {
    constexpr int NTW = OUT ? SNT : SNT / 2;
    const int l16 = lane & 15, q4 = lane >> 4, rowo = 16 * (w & 3) + 4 * q4, nt0 = OUT ? 0 : 4 * (w >> 2);
    const bool kwave = !OUT || w < 4;
    const int sn1 = s + 1 < s1 ? s + 1 : s1 - 1, sn2 = s + 2 < s1 ? s + 2 : s1 - 1;
    const ScanAddr a1 = scan_addr(ws, d, b, h, sn1);
    bf16x8 (&kq)[4] = PAR ? R.kqB : R.kqA;
    bf16x8 fb[2][8];
    f32x4 a1v[NTW];
    {
#define RD1(c_) do { _Pragma("unroll") for (int i_ = 0; i_ < 8; ++i_) fb[(c_) & 1][i_] = *(const LAS bf16x8*)(ST + ((nt0 + 2 * (c_) + (i_ >> 2)) * 16 + l16) * 136 + (i_ & 3) * 32 + q4 * 8); } while (0)
        RD1(0);
#pragma unroll
        for (int c = 0; c < NTW / 2; ++c) {
            if (c + 1 < NTW / 2) RD1(c + 1);
            __builtin_amdgcn_sched_barrier(0);
#pragma unroll
            for (int j = 0; j < 2; ++j) { f32x4 acc = (f32x4){0.f, 0.f, 0.f, 0.f};
#pragma unroll
                for (int ks = 0; ks < 4; ++ks) acc = __builtin_amdgcn_mfma_f32_16x16x32_bf16(kq[ks], fb[c & 1][j * 4 + ks], acc, 0, 0, 0);
                a1v[2 * c + j] = acc; }
            __builtin_amdgcn_sched_barrier(0);
        }
#undef RD1
    }
    if (kwave) {
#pragma unroll
        for (int i = 0; i < NTW; ++i) { f32x4 t;
            if (HASV) { const f32x4 v = (f32x4){bflo(R.vv[i].x), bfhi(R.vv[i].x), bflo(R.vv[i].y), bfhi(R.vv[i].y)}; t = R.be * (v - R.eg * a1v[i]); }
            else t = R.be * (R.eg * a1v[i]) * -1.f;
            u32x2 pw; pw.x = pk2(t.x, t.y); pw.y = pk2(t.z, t.w); *(LAS u32x2*)(TT + ((nt0 + i) * 16 + l16) * 72 + rowo) = pw; }
    } else {
#pragma unroll
        for (int i = 0; i < NTW; ++i) a1v[i] = R.eg * a1v[i];
    }
    { const ScanAddr a2 = scan_addr(ws, d, b, h, sn2); ld_kq<OUT>(kq, a2, w, lane); ld_p1<HASV, OUT>(R, a1, w, lane); }
    __syncthreads();
#define RD2(BUF, t0_, c_) do { _Pragma("unroll") for (int i_ = 0; i_ < 8; ++i_) fb[(c_) & 1][i_] = *(const LAS bf16x8*)(BUF + (((t0_) + 4 * (c_) + (i_ >> 1)) * 16 + l16) * 72 + (i_ & 1) * 32 + q4 * 8); } while (0)
    if (kwave) {
        RD2(TT, nt0, 0);
#pragma unroll
        for (int c = 0; c < NTW / 4; ++c) {
            if (c + 1 < NTW / 4) RD2(TT, nt0, c + 1);
            __builtin_amdgcn_sched_barrier(0);
#pragma unroll
            for (int j = 0; j < 4; ++j) { const int nt = nt0 + 4 * c + j; f32x4 vn = (f32x4){0.f, 0.f, 0.f, 0.f};
#pragma unroll
                for (int ks = 0; ks < 2; ++ks) vn = __builtin_amdgcn_mfma_f32_16x16x32_bf16(R.ta[ks], fb[c & 1][j * 2 + ks], vn, 0, 0, 0);
                const f32x4 vs = R.kd * vn;
                u32x2 pw; pw.x = pk2(vn.x, vn.y); pw.y = pk2(vn.z, vn.w); *(LAS u32x2*)(VN + (nt * 16 + l16) * 72 + rowo) = pw;
                u32x2 ps; ps.x = pk2(vs.x, vs.y); ps.y = pk2(vs.z, vs.w); *(LAS u32x2*)(VS + (nt * 16 + l16) * 72 + rowo) = ps; }
            __builtin_amdgcn_sched_barrier(0);
        }
        ld_ta<OUT>(R, a1, d, w, lane); R.kd = *(const f32x4*)(a1.vd + 128 + rowo);
    }
    __syncthreads();
    if (!kwave) {
        RD2(VN, 0, 0);
#pragma unroll
        for (int c = 0; c < 2; ++c) {
            if (c + 1 < 2) RD2(VN, 0, c + 1);
            __builtin_amdgcn_sched_barrier(0);
#pragma unroll
            for (int j = 0; j < 4; ++j) { const int nt = 4 * c + j;
#pragma unroll
                for (int ks = 0; ks < 2; ++ks) a1v[nt < NTW ? nt : 0] = __builtin_amdgcn_mfma_f32_16x16x32_bf16(R.ta[ks], fb[c & 1][j * 2 + ks], a1v[nt < NTW ? nt : 0], 0, 0, 0); }
            __builtin_amdgcn_sched_barrier(0);
        }
        ld_ta<OUT>(R, a1, d, w, lane);
    }
    RD2(VS, 0, 0);
#pragma unroll
    for (int c = 0; c < 2; ++c) {
        if (c + 1 < 2) RD2(VS, 0, c + 1);
        __builtin_amdgcn_sched_barrier(0);
#pragma unroll
        for (int j = 0; j < 4; ++j) { const int nt = 4 * c + j; f32x4 sv = S[nt] * R.gl;
#pragma unroll
            for (int ks = 0; ks < 2; ++ks) sv = __builtin_amdgcn_mfma_f32_16x16x32_bf16(R.kt[ks], fb[c & 1][j * 2 + ks], sv, 0, 0, 0);
            S[nt] = sv;
            u32x2 pw; pw.x = pk2(sv.x, sv.y); pw.y = pk2(sv.z, sv.w); *(LAS u32x2*)(ST + (nt * 16 + l16) * 136 + 16 * w + 4 * q4) = pw; }
        __builtin_amdgcn_sched_barrier(0);
    }
#undef RD2
    ld_p3(R, a1, w, lane);
    if (OUT && w >= 4 && s >= 4) {
        const int n = d == 0 ? s - 4 : 259 - s, trow0 = b * SEQ + n * 64;
#pragma unroll
        for (int nt = 0; nt < NTW; ++nt)
#pragma unroll
            for (int r = 0; r < 4; ++r) Od[(size_t)(trow0 + rowo + r) * 512 + col0 + nt * 16 + l16] = (bf16)(pk2(a1v[nt][r], 0.f) & 0xffffu); }
    __syncthreads();
}
template <int KIND>
__device__ __forceinline__ void scan_run(const Fr& F, int chain, int j) {
    int tid_ = F.tid; asm volatile("" : "+v"(tid_));
    const int d = chain >> 3, b = (chain >> 2) & 1, h = chain & 3, w = __builtin_amdgcn_readfirstlane(tid_ >> 6), lane = tid_ & 63, l16 = lane & 15, q4 = lane >> 4;
    LAS bf16* ST = (LAS bf16*)F.lds; LAS bf16* TT = ST + SNT * 16 * 136; LAS bf16* VN = TT + SNT * 16 * 72; LAS bf16* VS = VN + SNT * 16 * 72;
    f32x4 S[SNT];
    const size_t sidx = ((size_t)chain * 16 + j) * 16384;
#pragma unroll
    for (int nt = 0; nt < SNT; ++nt) {
        if (KIND == 0) S[nt] = (f32x4){0.f, 0.f, 0.f, 0.f};
        else if (KIND == 1) { const int col = nt * 16 + l16;
#pragma unroll
            for (int r = 0; r < 4; ++r) S[nt][r] = (16 * w + 4 * q4 + r == col) ? 1.f : 0.f; }
        else S[nt] = j == 0 ? (f32x4){0.f, 0.f, 0.f, 0.f} : *(const f32x4*)(WSP(float, WS_SST) + sidx + ((nt * 8 + w) * 64 + lane) * 4);
        u32x2 pw; pw.x = pk2(S[nt].x, S[nt].y); pw.y = pk2(S[nt].z, S[nt].w); *(LAS u32x2*)(ST + (nt * 16 + l16) * 136 + 16 * w + 4 * q4) = pw; }
    __syncthreads();
    bf16* Od = WSP(bf16, WS_O) + (size_t)d * T * 512; const int col0 = h * 128;
    const int s0 = sb_lo(j), s1 = sb_lo(j + 1);
    ScanRegs R;
    { const ScanAddr a0 = scan_addr(F.ws, d, b, h, s0), a1 = scan_addr(F.ws, d, b, h, s0 + 1 < s1 ? s0 + 1 : s1 - 1);
        ld_kq<KIND == 2>(R.kqA, a0, w, lane); ld_p1<KIND != 1, KIND == 2>(R, a0, w, lane); ld_ta<KIND == 2>(R, a0, d, w, lane); R.kd = *(const f32x4*)(a0.vd + 128 + 16 * (w & 3) + 4 * q4); ld_p3(R, a0, w, lane);
        ld_kq<KIND == 2>(R.kqB, a1, w, lane); }
    for (int s = s0; s < s1; s += 2) {
        scan_step<KIND != 1, KIND == 2, 0>(R, S, ST, TT, VN, VS, Od, col0, F.ws, d, b, h, s, s1, w, lane);
        if (s + 1 < s1) scan_step<KIND != 1, KIND == 2, 1>(R, S, ST, TT, VN, VS, Od, col0, F.ws, d, b, h, s + 1, s1, w, lane);
    }
    if (KIND == 0) {
#pragma unroll
        for (int nt = 0; nt < SNT; ++nt) *(f32x4*)(WSP(float, WS_SLOC) + sidx + ((nt * 8 + w) * 64 + lane) * 4) = S[nt];
    } else if (KIND == 1) { bf16* Pm = WSP(bf16, WS_PMAT) + sidx;
#pragma unroll
        for (int nt = 0; nt < SNT; ++nt)
#pragma unroll
            for (int r = 0; r < 4; ++r) Pm[(16 * w + 4 * q4 + r) * 128 + nt * 16 + l16] = (bf16)(pk2(S[nt][r], 0.f) & 0xffffu);
    }
    __syncthreads();
}
__device__ __forceinline__ void scan_combine(const Fr& F, int cu) {
    const int chain = cu >> 3, nt = cu & 7, w = F.wave, lane = F.lane, l16 = lane & 15, q4 = lane >> 4;
    LAS bf16* ST = (LAS bf16*)F.lds;
    f32x4 S = (f32x4){0.f, 0.f, 0.f, 0.f};
    { u32x2 z; z.x = 0u; z.y = 0u; *(LAS u32x2*)(ST + l16 * 136 + 16 * w + 4 * q4) = z; }
    __syncthreads();
    bf16x8 pa[4]; f32x4 sl;
#define SC2_LOAD(j_) do { const size_t si_ = ((size_t)chain * 16 + (j_)) * 16384; const bf16* Pm_ = WSP(bf16, WS_PMAT) + si_; \
        _Pragma("unroll") for (int ks = 0; ks < 4; ++ks) pa[ks] = *(const bf16x8*)(Pm_ + (16 * w + l16) * 128 + ks * 32 + q4 * 8); \
        sl = *(const f32x4*)(WSP(float, WS_SLOC) + si_ + ((nt * 8 + w) * 64 + lane) * 4); } while (0)
    SC2_LOAD(0);
    for (int j = 0; j < 15; ++j) {
        f32x4 acc = sl;
#pragma unroll
        for (int ks = 0; ks < 4; ++ks) acc = __builtin_amdgcn_mfma_f32_16x16x32_bf16(pa[ks], *(const LAS bf16x8*)(ST + l16 * 136 + ks * 32 + q4 * 8), acc, 0, 0, 0);
        S = acc;
        if (j + 1 < 15) SC2_LOAD(j + 1);
        *(f32x4*)(WSP(float, WS_SST) + ((size_t)chain * 16 + j + 1) * 16384 + ((nt * 8 + w) * 64 + lane) * 4) = S;
        __syncthreads();
        { u32x2 pw; pw.x = pk2(S.x, S.y); pw.y = pk2(S.z, S.w); *(LAS u32x2*)(ST + l16 * 136 + 16 * w + 4 * q4) = pw; }
        __syncthreads();
    }
#undef SC2_LOAD
}
__device__ __forceinline__ void p4_sgu(const Fr& F, int worker, int nworkers, int u_lo, int u_hi) {
    const bf16* P = WSP(bf16, WS_P); bf16* MIX = WSP(bf16, WS_MIX);
    const float* lng = F.in[12]; const float* lnb = F.in[13]; const float* sw = F.in[14]; const float* sb = F.in[15];
    LAS bf16* VT = (LAS bf16*)F.lds;
    for (int u = u_lo + worker; u < u_hi; u += nworkers) {
        int tid = F.tid; asm volatile("" : "+v"(tid));
        const int lane = tid & 63, wave = __builtin_amdgcn_readfirstlane(tid >> 6), l16 = lane & 15, q4 = lane >> 4;
        const int g = u & 3, ch = u >> 2, row00 = ch * 128;
#pragma unroll
        for (int it = 0; it < 4; ++it) { const int item = it * NTHR + tid, cg = item & 15, row = item >> 4;
            const u32x4 xv = *(const u32x4*)(P + (size_t)(row00 + row) * NPROJ + PC_V + g * 128 + cg * 8);
            float v[8]; v[0] = bflo(xv.x); v[1] = bfhi(xv.x); v[2] = bflo(xv.y); v[3] = bfhi(xv.y); v[4] = bflo(xv.z); v[5] = bfhi(xv.z); v[6] = bflo(xv.w); v[7] = bfhi(xv.w);
            float s = 0.f;
#pragma unroll
            for (int e = 0; e < 8; ++e) { v[e] = gelu_t(v[e]); s += v[e]; }
            const float mean = sum16(s) * (1.f / 128.f); float q = 0.f;
#pragma unroll
            for (int e = 0; e < 8; ++e) { v[e] -= mean; q += v[e] * v[e]; }
            const float rstd = rsqrtf(sum16(q) * (1.f / 128.f) + EPS);
#pragma unroll
            for (int e = 0; e < 8; ++e) { const int c = cg * 8 + e; const float y = v[e] * rstd * lng[g * 128 + c] + lnb[g * 128 + c]; VT[c * 136 + ((((row >> 3) ^ cg) << 3) | (row & 7))] = (bf16)(pk2(y, 0.f) & 0xffffu); }
        }
        __syncthreads();
        bf16x8 wf[4];
#pragma unroll
        for (int ks = 0; ks < 4; ++ks) { const float* wp = sw + (size_t)g * 16384 + (wave * 16 + l16) * 128 + ks * 32 + q4 * 8; const f32x4 a = *(const f32x4*)wp, bq = *(const f32x4*)(wp + 4);
            u32x4 t; t.x = pk2(a.x, a.y); t.y = pk2(a.z, a.w); t.z = pk2(bq.x, bq.y); t.w = pk2(bq.z, bq.w); wf[ks] = __builtin_bit_cast(bf16x8, t); }
        const int prow = wave * 16 + l16; const float bs = sb[g * 128 + prow];
        u32x2 uq[8];
#pragma unroll
        for (int ct = 0; ct < 8; ++ct) uq[ct] = *(const u32x2*)(P + (size_t)(row00 + prow) * NPROJ + PC_U + g * 128 + ct * 16 + 4 * q4);
#pragma unroll
        for (int ct = 0; ct < 8; ++ct) { f32x4 acc = (f32x4){0.f, 0.f, 0.f, 0.f};
#pragma unroll
            for (int ks = 0; ks < 4; ++ks) acc = __builtin_amdgcn_mfma_f32_16x16x32_bf16(*(const LAS bf16x8*)(VT + (ct * 16 + l16) * 136 + (((ks * 4 + q4) ^ (ct * 2 + (l16 >> 3))) << 3)), wf[ks], acc, 0, 0, 0);
            const int c0 = ct * 16 + 4 * q4;
            const u32x2 uv = uq[ct];
            const float o0 = gelu_t(bflo(uv.x)) * (acc[0] + bs), o1 = gelu_t(bfhi(uv.x)) * (acc[1] + bs), o2 = gelu_t(bflo(uv.y)) * (acc[2] + bs), o3 = gelu_t(bfhi(uv.y)) * (acc[3] + bs);
            u32x2 w; w.x = pk2(o0, o1); w.y = pk2(o2, o3); if (DBG_MODE == 3) w = (u32x2){0u, 0u}; *(u32x2*)(MIX + (size_t)(row00 + prow) * D + 512 + g * 128 + c0) = w; }
        __syncthreads();
    }
}

__device__ __forceinline__ void p5_gdn_out(const Fr& F) {
    const bf16* P = WSP(bf16, WS_P); const bf16* O = WSP(bf16, WS_O); bf16* MIX = WSP(bf16, WS_MIX); const float* gng = F.in[11];
    const int gw = F.wg * NWAVES + F.wave, NGW = F.G * NWAVES, lane = F.lane;
    const f32x4 g0 = *(const f32x4*)(gng + (lane & 15) * 8), g1 = *(const f32x4*)(gng + (lane & 15) * 8 + 4);
    const float gg[8] = {g0.x, g0.y, g0.z, g0.w, g1.x, g1.y, g1.z, g1.w};
    for (int blk = gw; blk < T / 16; blk += NGW) {
        const int t0 = blk * 16;
        u32x4 a = *(const u32x4*)(O + (size_t)t0 * 512 + lane * 8), bq = *(const u32x4*)(O + (size_t)(T + t0) * 512 + lane * 8), z = *(const u32x4*)(P + (size_t)t0 * NPROJ + PC_Z + lane * 8);
#pragma clang loop unroll(disable)
        for (int i = 0; i < 16; ++i) {
            const int t = t0 + i, tn = t0 + (i + 1 < 16 ? i + 1 : i);
            const u32x4 an = *(const u32x4*)(O + (size_t)tn * 512 + lane * 8), bn = *(const u32x4*)(O + (size_t)(T + tn) * 512 + lane * 8), zn = *(const u32x4*)(P + (size_t)tn * NPROJ + PC_Z + lane * 8);
            float o[8]; o[0] = bflo(a.x) + bflo(bq.x); o[1] = bfhi(a.x) + bfhi(bq.x); o[2] = bflo(a.y) + bflo(bq.y); o[3] = bfhi(a.y) + bfhi(bq.y);
            o[4] = bflo(a.z) + bflo(bq.z); o[5] = bfhi(a.z) + bfhi(bq.z); o[6] = bflo(a.w) + bflo(bq.w); o[7] = bfhi(a.w) + bfhi(bq.w);
            float ss = 0.f;
#pragma unroll
            for (int e = 0; e < 8; ++e) ss += o[e] * o[e];
            const float rstd = rsqrtf(sum16(ss) * (1.f / 128.f) + EPS);
            const float zz[8] = {bflo(z.x), bfhi(z.x), bflo(z.y), bfhi(z.y), bflo(z.z), bfhi(z.z), bflo(z.w), bfhi(z.w)};
            float r[8];
#pragma unroll
            for (int e = 0; e < 8; ++e) r[e] = o[e] * rstd * gg[e] * silu_(zz[e]);
            u32x4 w; w.x = pk2(r[0], r[1]); w.y = pk2(r[2], r[3]); w.z = pk2(r[4], r[5]); w.w = pk2(r[6], r[7]);
            if (DBG_MODE == 2) w = (u32x4){0u, 0u, 0u, 0u};
            *(u32x4*)(MIX + (size_t)t * D + lane * 8) = w;
            a = an; bq = bn; z = zn;
        }
    }
}

__device__ __forceinline__ void p7_mid(const Fr& F) {
    const float* x = F.in[0]; const float* ng = F.in[6]; const float* MOD = WSP(float, WS_MOD); const bf16* R = WSP(bf16, WS_R); const float* rbias = F.in[18];
    bf16* X1 = WSP(bf16, WS_X1); unsigned char* H2 = WSP(unsigned char, WS_H2);
    LAS bf16* HI = (LAS bf16*)F.lds; LAS bf16* LO = HI + 16 * 1032; LAS float* PART = (LAS float*)(F.lds + 66048);
    LAS int* ENT_E = (LAS int*)(F.lds + 83968); LAS int* ENT_R = ENT_E + 1024; LAS int* CNT = ENT_R + 1024; LAS int* BASE = CNT + 32; LAS float* ENT_G = (LAS float*)(F.lds + 104960);
    const int tid = F.tid, lane = F.lane, wave = F.wave, l16 = lane & 15, q4 = lane >> 4;
    if (tid < 32) CNT[tid] = 0;
    const int TPW = T / F.G, t0 = F.wg * TPW;
    LAS float* AV = (LAS float*)(F.lds + 92672); LAS float* BV = AV + 1024; LAS float* CV = BV + 1024;
    { const float* mb = MOD + (t0 >> 14) * 6144;
        for (int k = tid; k < 1024; k += NTHR) { AV[k] = mb[2048 + k] * ng[1024 + k]; BV[k] = ng[2048 + k] * (mb[4096 + k] + 1.f); CV[k] = mb[3072 + k]; } }
    const float my_rbias = rbias[tid & 31];
    bf16x8 wh[4][2], wl[4][2];
    { const float* WRT = WSP(float, WS_WRT);
#pragma unroll
        for (int ks = 0; ks < 4; ++ks)
#pragma unroll
            for (int nt = 0; nt < 2; ++nt) { const float* wp = WRT + (size_t)(nt * 16 + l16) * 1024 + wave * 128 + ks * 32 + q4 * 8; const f32x4 a = *(const f32x4*)wp, b = *(const f32x4*)(wp + 4);
                u32x4 h; h.x = pk2(a.x, a.y); h.y = pk2(a.z, a.w); h.z = pk2(b.x, b.y); h.w = pk2(b.z, b.w);
                u32x4 l; l.x = pk2(a.x - bflo(h.x), a.y - bfhi(h.x)); l.y = pk2(a.z - bflo(h.y), a.w - bfhi(h.y)); l.z = pk2(b.x - bflo(h.z), b.y - bfhi(h.z)); l.w = pk2(b.z - bflo(h.w), b.w - bfhi(h.w));
                wh[ks][nt] = __builtin_bit_cast(bf16x8, h); wl[ks][nt] = __builtin_bit_cast(bf16x8, l); } }
    __syncthreads();
    u32x2 rq[2][4]; f32x4 xq[2][4];
#define P7_LOAD(tile_) do { _Pragma("unroll") for (int sub_ = 0; sub_ < 2; ++sub_) { const int t_ = t0 + (tile_) * 16 + 2 * wave + sub_; \
        _Pragma("unroll") for (int j_ = 0; j_ < 4; ++j_) { rq[sub_][j_] = *(const u32x2*)(R + (size_t)t_ * D + 256 * j_ + 4 * lane); xq[sub_][j_] = *(const f32x4*)(x + (size_t)t_ * D + 256 * j_ + 4 * lane); } } } while (0)
    P7_LOAD(0);
    for (int tile = 0; tile < TPW / 16; ++tile) {
        f32x4 hq[2][4];
#pragma unroll
        for (int sub = 0; sub < 2; ++sub) {
            f32x4 rv[4]; float ss = 0.f;
#pragma unroll
            for (int j = 0; j < 4; ++j) { const u32x2 rw = rq[sub][j]; rv[j] = (f32x4){bflo(rw.x), bfhi(rw.x), bflo(rw.y), bfhi(rw.y)};
                ss += (rv[j].x * rv[j].x + rv[j].y * rv[j].y) + (rv[j].z * rv[j].z + rv[j].w * rv[j].w); }
            const float rstd1 = rsqrtf(wave_sum(ss) * (1.f / D) + EPS);
            f32x4 xv[4]; float s2 = 0.f;
#pragma unroll
            for (int j = 0; j < 4; ++j) { const int k = 256 * j + 4 * lane; const f32x4 av = *(const LAS f32x4*)(AV + k);
                xv[j] = xq[sub][j] + av * (rv[j] * rstd1);
                s2 += (xv[j].x * xv[j].x + xv[j].y * xv[j].y) + (xv[j].z * xv[j].z + xv[j].w * xv[j].w); }
            const float rstd2 = rsqrtf(wave_sum(s2) * (1.f / D) + EPS);
#pragma unroll
            for (int j = 0; j < 4; ++j) { const int k = 256 * j + 4 * lane; const f32x4 bv = *(const LAS f32x4*)(BV + k), cv = *(const LAS f32x4*)(CV + k);
                hq[sub][j] = xv[j] * rstd2 * bv + cv; xq[sub][j] = xv[j]; }
        }
#pragma unroll
        for (int sub = 0; sub < 2; ++sub) { const int tr = 2 * wave + sub, t = t0 + tile * 16 + tr;
#pragma unroll
            for (int j = 0; j < 4; ++j) { const int k = 256 * j + 4 * lane; const f32x4 hv = hq[sub][j];
                { u32x2 x1w; x1w.x = pk2(xq[sub][j].x, xq[sub][j].y); x1w.y = pk2(xq[sub][j].z, xq[sub][j].w); *(u32x2*)(X1 + (size_t)t * D + k) = x1w; }
                u32x2 o; o.x = pk2(hv.x, hv.y); o.y = pk2(hv.z, hv.w); *(unsigned*)(H2 + (size_t)t * D + k) = pk_fp8x4(hv.x, hv.y, hv.z, hv.w);
                u32x2 lo; lo.x = pk2(hv.x - bflo(o.x), hv.y - bfhi(o.x)); lo.y = pk2(hv.z - bflo(o.y), hv.w - bfhi(o.y));
                *(LAS u32x2*)(HI + tr * 1032 + k) = o; *(LAS u32x2*)(LO + tr * 1032 + k) = lo; } }
        if (tile + 1 < TPW / 16) P7_LOAD(tile + 1);
        __syncthreads();
        { f32x4 acc[2]; acc[0] = (f32x4){0.f, 0.f, 0.f, 0.f}; acc[1] = acc[0];
#pragma unroll
            for (int ks = 0; ks < 4; ++ks) { const int ko = l16 * 1032 + wave * 128 + ks * 32 + q4 * 8;
                const bf16x8 ah = *(const LAS bf16x8*)(HI + ko), al = *(const LAS bf16x8*)(LO + ko);
#pragma unroll
                for (int nt = 0; nt < 2; ++nt) { acc[nt] = __builtin_amdgcn_mfma_f32_16x16x32_bf16(ah, wh[ks][nt], acc[nt], 0, 0, 0);
                    acc[nt] = __builtin_amdgcn_mfma_f32_16x16x32_bf16(al, wh[ks][nt], acc[nt], 0, 0, 0);
                    acc[nt] = __builtin_amdgcn_mfma_f32_16x16x32_bf16(ah, wl[ks][nt], acc[nt], 0, 0, 0); } }
#pragma unroll
            for (int nt = 0; nt < 2; ++nt)
#pragma unroll
                for (int r = 0; r < 4; ++r) PART[(wave * 16 + 4 * q4 + r) * 33 + nt * 16 + l16] = acc[nt][r]; }
        __syncthreads();
        { const int tok = tid >> 5, me = tid & 31, t = t0 + tile * 16 + tok;
            float logit = my_rbias;
#pragma unroll
            for (int w = 0; w < 8; ++w) logit += PART[(w * 16 + tok) * 33 + me];
            float tv[4]; int ti[4];
#pragma unroll
            for (int k = 0; k < 4; ++k) { float bv = logit; int bi = me;
#define P7_AMAX(OV, OI) do { const float ov_ = (OV); const int oi_ = (OI); const bool tk_ = (ov_ > bv) | ((ov_ == bv) & (oi_ < bi)); bv = tk_ ? ov_ : bv; bi = tk_ ? oi_ : bi; } while (0)
                P7_AMAX(DPP_MOV(bv, 0xB1), __builtin_amdgcn_update_dpp(0, bi, 0xB1, 0xf, 0xf, true));
                P7_AMAX(DPP_MOV(bv, 0x4E), __builtin_amdgcn_update_dpp(0, bi, 0x4E, 0xf, 0xf, true));
                P7_AMAX(DPP_MOV(bv, 0x124), __builtin_amdgcn_update_dpp(0, bi, 0x124, 0xf, 0xf, true));
                P7_AMAX(DPP_MOV(bv, 0x128), __builtin_amdgcn_update_dpp(0, bi, 0x128, 0xf, 0xf, true));
                P7_AMAX(__shfl_xor(bv, 16), __shfl_xor(bi, 16));
#undef P7_AMAX
                tv[k] = bv; ti[k] = bi; if (me == bi) logit = -3.0e38f; }
            const float e1 = __expf(tv[1] - tv[0]), e2 = __expf(tv[2] - tv[0]), e3 = __expf(tv[3] - tv[0]), inv = 1.f / (1.f + e1 + e2 + e3);
            if (me == 0) { const float gt[4] = {inv, e1 * inv, e2 * inv, e3 * inv}; const int tl = tile * 16 + tok;
#pragma unroll
                for (int k = 0; k < 4; ++k) { const int rk = atomicAdd((int*)&CNT[ti[k]], 1); ENT_E[tl * 4 + k] = ti[k]; ENT_R[tl * 4 + k] = rk; ENT_G[tl * 4 + k] = gt[k]; } }
        }
    }
#undef P7_LOAD
    __syncthreads();
    if (tid < 32) BASE[tid] = (int)__hip_atomic_fetch_add(WSP(unsigned, WS_CTL) + CW_GCNT + 64 * tid, (unsigned)CNT[tid], __ATOMIC_RELAXED, __HIP_MEMORY_SCOPE_AGENT);
    __syncthreads();
    int* TE = WSP(int, WS_TKE); int* TR = WSP(int, WS_TKRANK);
    int* ET = WSP(int, WS_ETOK); float* EG = WSP(float, WS_EGATE);
    for (int i = tid; i < TPW * 4; i += NTHR) { const int e = ENT_E[i], rk = BASE[e] + ENT_R[i]; TE[(size_t)t0 * 4 + i] = e; TR[(size_t)t0 * 4 + i] = rk;
        const int rc = rk < ECAP ? rk : ECAP - 1; ET[(size_t)e * ECAP + rc] = t0 + (i >> 2); EG[(size_t)e * ECAP + rc] = ENT_G[i]; }
}

__device__ __forceinline__ void moe_tables(const Fr& F) {
    LAS int* NPL = (LAS int*)(F.lds + LDS_TAB); LAS int* RB = NPL + 32; LAS int* NPAN = NPL + 64; LAS int* PEXP = NPL + 128;
    if (F.tid < 32) NPL[F.tid] = ((int)__hip_atomic_load(WSP(unsigned, WS_CTL) + CW_GCNT + 64 * F.tid, __ATOMIC_RELAXED, __HIP_MEMORY_SCOPE_AGENT) + 255) >> 8;
    __syncthreads();
    if (F.tid < 32) { int s = 0; for (int e = 0; e < F.tid; ++e) s += NPL[e]; RB[F.tid] = s * 256; if (F.tid == 31) NPAN[0] = s + NPL[31];
        const int np = NPL[F.tid]; for (int p = 0; p < np; ++p) if (s + p < MAXPAN) PEXP[s + p] = F.tid; }
    __syncthreads();
}
__device__ __forceinline__ void p8_permute(const Fr& F) { (void)F; }
struct MoeOrder {
    int nM, nN, nwg, G, c; const LAS int* pexp;
    __device__ __forceinline__ void init(int nM_, int nN_, int G_, int c_, const LAS int* pexp_) { nM = nM_; nN = nN_; nwg = nM * nN; G = G_; c = c_; pexp = pexp_; }
    __device__ __forceinline__ bool next(int i, pg8::Unit& u) const {
        const long L = (long)i * G + c; if (L >= nwg) return false;
        int wgid = (int)L; { const int q = nwg / pg8::NXCD, r = nwg % pg8::NXCD, xcd = wgid % pg8::NXCD, off = wgid / pg8::NXCD; wgid = (xcd < r ? xcd * (q + 1) : r * (q + 1) + (xcd - r) * q) + off; }
        const int nig = pg8::WGM * nN, gid = wgid / nig, fm = gid * pg8::WGM, gsz = (nM - fm) < pg8::WGM ? (nM - fm) : pg8::WGM;
        u.pm = fm + ((wgid % nig) % gsz); u.pn = pexp[u.pm] * nN + (wgid % nig) / gsz; return true;
    }
    __device__ __forceinline__ void a_ready(const pg8::Unit&) const {}
    __device__ __forceinline__ void done(const pg8::Unit&) const {}
};
struct EpiStore {
    static constexpr bool PERM = true, AFTER_DRAIN = false;
    bf16* O; int ldc;
    __device__ __forceinline__ void operator()(const pg8::f32x4 (&acc)[2][2][4][2], const pg8::Unit& u, int wr, int wc, int fr, int fq) const {
        const int row0 = u.pm * 256 + wr * 64 + fr, col0 = u.pn * 256 + wc * 32 + 8 * fq;
#pragma unroll
        for (int ai = 0; ai < 2; ++ai)
#pragma unroll
            for (int m = 0; m < 4; ++m) { bf16* rowp = O + (size_t)(row0 + ai * 128 + m * 16) * ldc + col0;
#pragma unroll
                for (int bj = 0; bj < 2; ++bj) { const pg8::f32x4 v0 = acc[ai][bj][m][0], v1 = acc[ai][bj][m][1];
                    u32x4 w; w.x = pk2(v0[0], v0[1]); w.y = pk2(v0[2], v0[3]); w.z = pk2(v1[0], v1[1]); w.w = pk2(v1[2], v1[3]);
                    *(u32x4*)(rowp + bj * 128) = w; } }
    }
};
struct EpiSwiGLU {
    static constexpr bool PERM = false, AFTER_DRAIN = false;
    unsigned char* ACT; const float* bias;
    __device__ __forceinline__ void operator()(const pg8::f32x4 (&acc)[2][2][4][2], const pg8::Unit& u, int wr, int wc, int fr, int fq) const {
        const int e = u.pn >> 3, pnl = u.pn & 7, row0 = u.pm * 256 + wr * 64 + fr;
        const float* bb = bias + e * 2048 + pnl * 256 + wc * 32 + 4 * fq;
        pg8::f32x4 bg[2], bu[2];
#pragma unroll
        for (int bj = 0; bj < 2; ++bj) { bg[bj] = *(const pg8::f32x4*)(bb + bj * 128); bu[bj] = *(const pg8::f32x4*)(bb + bj * 128 + 16); }
#pragma unroll
        for (int ai = 0; ai < 2; ++ai)
#pragma unroll
            for (int m = 0; m < 4; ++m) { float a[8];
#pragma unroll
                for (int bj = 0; bj < 2; ++bj) { const pg8::f32x4 gv = acc[ai][bj][m][0] * W8_INV + bg[bj], uv = acc[ai][bj][m][1] * W8_INV + bu[bj];
#pragma unroll
                    for (int j = 0; j < 4; ++j) { const float gt = fminf(gv[j], 7.f), up = fminf(fmaxf(uv[j], -7.f), 7.f); a[4 * bj + j] = (up + 1.f) * gt * frcp(1.f + __expf(-1.702f * gt)); } }
                u32x2 w; w.x = pk_fp8x4(a[0], a[1], a[2], a[3]); w.y = pk_fp8x4(a[4], a[5], a[6], a[7]);
                *(u32x2*)(ACT + (size_t)(row0 + ai * 128 + m * 16) * D + pnl * 128 + wc * 32 + 8 * fq) = w; }
    }
};
constexpr float Y8_SCALE = 16.f, Y8_INV = 1.f / 16.f;
struct EpiDown {
    static constexpr bool PERM = true, AFTER_DRAIN = false;
    unsigned char* Y; const float* bias; const float* egate; const LAS int* rb;
    __device__ __forceinline__ void operator()(const pg8::f32x4 (&acc)[2][2][4][2], const pg8::Unit& u, int wr, int wc, int fr, int fq) const {
        const int e = u.pn >> 2, pnl = u.pn & 3, row0 = u.pm * 256 + wr * 64 + fr, col0 = pnl * 256 + wc * 32 + 8 * fq;
        pg8::f32x4 bv[2][2];
#pragma unroll
        for (int bj = 0; bj < 2; ++bj)
#pragma unroll
            for (int n = 0; n < 2; ++n) bv[bj][n] = *(const pg8::f32x4*)(bias + e * 1024 + col0 + bj * 128 + 4 * n);
#pragma unroll
        for (int ai = 0; ai < 2; ++ai)
#pragma unroll
            for (int m = 0; m < 4; ++m) { const int row = row0 + ai * 128 + m * 16; const int rk = row - rb[e]; const float gt = egate[(size_t)e * ECAP + (rk < ECAP ? rk : ECAP - 1)] * Y8_SCALE; unsigned char* rowp = Y + (size_t)row * D + col0;
#pragma unroll
                for (int bj = 0; bj < 2; ++bj) { const pg8::f32x4 v0 = (acc[ai][bj][m][0] * W8_INV + bv[bj][0]) * gt, v1 = (acc[ai][bj][m][1] * W8_INV + bv[bj][1]) * gt;
                    u32x2 w; w.x = pk_fp8x4(v0[0], v0[1], v0[2], v0[3]); w.y = pk_fp8x4(v1[0], v1[1], v1[2], v1[3]);
                    *(u32x2*)(rowp + bj * 128) = w; } }
    }
};
__device__ __forceinline__ void p11_final(const Fr& F) {
    moe_tables(F);
    const LAS int* RB = (const LAS int*)(F.lds + LDS_TAB) + 32;
    const float* ng = F.in[6]; const float* MOD = WSP(float, WS_MOD); const bf16* X1 = WSP(bf16, WS_X1); const unsigned char* Y = WSP(unsigned char, WS_Y); const int* TE = WSP(int, WS_TKE); const int* TR = WSP(int, WS_TKRANK);
    const int gw = F.wg * NWAVES + F.wave, NGW = F.G * NWAVES, lane = F.lane;
    typedef float f32x2_ __attribute__((ext_vector_type(2)));
    for (int blk = gw; blk < T / 16; blk += NGW) {
        const int t0 = blk * 16, b = t0 >> 14; const float* mb = MOD + b * 6144 + 5120;
        int myrow = RB[TE[(size_t)t0 * 4 + lane]] + TR[(size_t)t0 * 4 + lane]; myrow = myrow < MAXROWS ? myrow : MAXROWS - 1;
        f32x4 gm[4];
#pragma unroll
        for (int j = 0; j < 4; ++j) { const int k = 256 * j + 4 * lane; gm[j] = *(const f32x4*)(ng + 3072 + k) * *(const f32x4*)(mb + k); }
        int yq0[4][4], yq1[4][4]; u32x2 xq0[4], xq1[4];
#define P11_LOAD(YQ, XQ, tk_) do { _Pragma("unroll") for (int k_ = 0; k_ < 4; ++k_) { const int row_ = __builtin_amdgcn_readlane(myrow, 4 * (tk_) + k_); \
            _Pragma("unroll") for (int j_ = 0; j_ < 4; ++j_) YQ[k_][j_] = *(const int*)(Y + (size_t)row_ * D + 256 * j_ + 4 * lane); } \
            _Pragma("unroll") for (int j_ = 0; j_ < 4; ++j_) XQ[j_] = *(const u32x2*)(X1 + (size_t)(t0 + (tk_)) * D + 256 * j_ + 4 * lane); } while (0)
#define P11_DO(YQ, XQ, tk_) do { f32x4 y[4]; \
            _Pragma("unroll") for (int j = 0; j < 4; ++j) y[j] = (f32x4){0.f, 0.f, 0.f, 0.f}; \
            _Pragma("unroll") for (int k = 0; k < 4; ++k) _Pragma("unroll") for (int j = 0; j < 4; ++j) { const int w = YQ[k][j]; const f32x2_ lo = __builtin_amdgcn_cvt_pk_f32_fp8(w, false), hi = __builtin_amdgcn_cvt_pk_f32_fp8(w, true); y[j] += (f32x4){lo.x, lo.y, hi.x, hi.y}; } \
            float ss = 0.f; \
            _Pragma("unroll") for (int j = 0; j < 4; ++j) { y[j] = y[j] * Y8_INV; ss += (y[j].x * y[j].x + y[j].y * y[j].y) + (y[j].z * y[j].z + y[j].w * y[j].w); } \
            const float rstd = rsqrtf(wave_sum(ss) * (1.f / D) + EPS); \
            _Pragma("unroll") for (int j = 0; j < 4; ++j) { const int k = 256 * j + 4 * lane; const u32x2 xw = XQ[j]; const f32x4 x1 = (f32x4){bflo(xw.x), bfhi(xw.x), bflo(xw.y), bfhi(xw.y)}; \
                *(f32x4*)(F.out + (size_t)(t0 + (tk_)) * D + k) = (DBG_MODE >= 1) ? x1 : x1 + gm[j] * (y[j] * rstd); } } while (0)
        P11_LOAD(yq0, xq0, 0);
#pragma clang loop unroll(disable)
        for (int tk = 0; tk < 16; tk += 2) {
            P11_LOAD(yq1, xq1, tk + 1);
            P11_DO(yq0, xq0, tk);
            if (tk + 2 < 16) P11_LOAD(yq0, xq0, tk + 2);
            P11_DO(yq1, xq1, tk + 1);
        }
#undef P11_DO
#undef P11_LOAD
    }
}

struct Args { const float* in[23]; float* out; unsigned char* ws; int ph_lo, ph_hi; };
__global__ void __launch_bounds__(NTHR, 2) mk_fwd(Args args) {
    extern __shared__ __attribute__((aligned(16))) unsigned char lds_raw[];
    Fr F; F.lds = (LAS unsigned char*)lds_raw; F.ws = args.ws; F.out = args.out;
#pragma unroll
    for (int i = 0; i < 23; ++i) F.in[i] = args.in[i];
    F.tid = threadIdx.x; F.lane = F.tid & 63; F.wave = __builtin_amdgcn_readfirstlane(F.tid >> 6); F.wg = blockIdx.x; F.G = gridDim.x;
    volatile LAS unsigned* MISC = (volatile LAS unsigned*)(F.lds + LDS_MISC);
    if (F.tid < 16) MISC[F.tid] = 0u;
    __syncthreads();
    const int lo = args.ph_lo, hi = args.ph_hi;
    XcdBarrier bar; bar.bar = WSP(unsigned, WS_CTL) + CW_BAR; bar.x = 0; bar.st = nullptr;
    if (hi - lo > 1) bar = xcd_barrier_post(WSP(unsigned, WS_CTL) + CW_BAR, MISC + 8);
#define IN(k) (lo <= (k) && (k) < hi)
#define SEAM(k) do { if (IN(k) && IN((k) + 1)) xcd_barrier(bar); } while (0)
#define PH0 { p0_prologue(F); }
#define PH1 { p1_norm(F); }
#define PH2 { pg8::Gemm g{WSP(bf16, WS_HALL), WSP(bf16, WS_WINT), TALL, NPROJ, D}; pg8::StaticOrder S; S.init(TALL, NPROJ, F.G, F.wg); \
        EpiStore E{WSP(bf16, WS_P), NPROJ}; pg8::gemm_phase<EpiStore, pg8::StaticOrder, true, true>(F.lds, g, S, E); \
        if (F.wg >= 154 && F.G == 256) p4_convert(F, F.wg - 154, 102, CV_A0, CV_A1); }
#define PH3 { p3_prep(F); if (F.wg >= 32 && F.G == 256) p4_convert(F, F.wg - 32, 224, CV_A1, CV_B1); }
#define PH4 {   \
        if (F.wg < 240) { scan_run<0>(F, F.wg / 15, F.wg % 15); scan_run<1>(F, F.wg / 15, F.wg % 15); } else if (F.G == 256) p4_convert(F, F.wg - 240, 16, CV_B1, CV_C1);        \
        xcd_barrier(bar); \
        if (F.wg < 128) scan_combine(F, F.wg); else { p4_sgu(F, F.wg - 128, F.G - 128, 0, 256); }        \
        xcd_barrier(bar); \
        if (F.wg < 256) scan_run<2>(F, F.wg >> 4, F.wg & 15); \
        p4_sgu(F, F.wg, F.G, 256, NB * 128 * 4); p4_convert(F, F.wg, F.G, F.G == 256 ? CV_C1 : 0, CV_D0); }
#define PH5 { p5_gdn_out(F); }
#define PH6 { pg8::Gemm g{WSP(bf16, WS_MIX), WSP(bf16, WS_WOUTT), T, D, D}; pg8::StaticOrder S; S.init(T, D, F.G, F.wg); \
        EpiStore E{WSP(bf16, WS_R), D}; pg8::gemm_phase<EpiStore, pg8::StaticOrder, true, true>(F.lds, g, S, E); }
#define PH7 { p7_mid(F); }
#define PH8 { p8_permute(F); }
#define PH9 { moe_tables(F); const LAS int* tab = (const LAS int*)(F.lds + LDS_TAB); const int npan = tab[64] < MAXPAN ? tab[64] : MAXPAN; \
        pg8::Gemm g{WSP(bf16, WS_H2), WSP(bf16, WS_WGUT), npan * 256, 2048, D / 2}; MoeOrder S; S.init(npan, 8, F.G, F.wg, tab + 128); \
        { LAS int* gm = (LAS int*)(F.lds + LDS_GMAP); const int* RT = WSP(int, WS_ETOK); pg8::Unit uu; \
            for (int i = 0; i < 17 && S.next(i, uu); ++i) if (F.tid < 256) { const int e_ = uu.pn >> 3, rk_ = uu.pm * 256 - tab[32 + e_] + F.tid; gm[i * 256 + F.tid] = RT[(size_t)e_ * ECAP + (rk_ < ECAP ? rk_ : ECAP - 1)]; } \
            __syncthreads(); } \
        EpiSwiGLU E{WSP(unsigned char, WS_ACT), WSP(float, WS_BGUP)}; pg8::gemm_phase<EpiSwiGLU, MoeOrder, true, true, true, true>(F.lds, g, S, E, (const LAS int*)(F.lds + LDS_GMAP)); \
        { const int rem = (npan * 8) % F.G; if (rem == 0) p4_convert(F, F.wg, F.G, CV_D0, NE * 768); else if (F.wg >= rem) p4_convert(F, F.wg - rem, F.G - rem, CV_D0, NE * 768); } }
#define PH10 { moe_tables(F); const LAS int* tab = (const LAS int*)(F.lds + LDS_TAB); const int npan = tab[64] < MAXPAN ? tab[64] : MAXPAN; \
        pg8::Gemm g{WSP(bf16, WS_ACT), WSP(bf16, WS_WDT), npan * 256, 1024, D / 2}; MoeOrder S; S.init(npan, 4, F.G, F.wg, tab + 128); \
        EpiDown E{WSP(unsigned char, WS_Y), F.in[22], WSP(float, WS_EGATE), tab + 32}; pg8::gemm_phase<EpiDown, MoeOrder, true, true, true>(F.lds, g, S, E); }
#define RUN(k, BODY) do { if (IN(k)) BODY if (PROBE_TWICE == (k) && IN(k)) { xcd_barrier(bar); BODY } } while (0)
    RUN(0, PH0); SEAM(0);
    RUN(1, PH1); SEAM(1);
    RUN(2, PH2); SEAM(2);
    RUN(3, PH3); SEAM(3);
    RUN(4, PH4);
    if (PROBE_TWICE == 46 && IN(4)) { xcd_barrier(bar); if (F.wg < 240) scan_run<0>(F, F.wg / 15, F.wg % 15); else if (F.wg < 256) scan_run<1>(F, (F.wg - 240) / 15, (F.wg - 240) % 15); if (F.wg < 224) scan_run<1>(F, (F.wg + 16) / 15, (F.wg + 16) % 15); }
    if (PROBE_TWICE == 47 && IN(4)) { xcd_barrier(bar); if (F.wg < 256) scan_run<2>(F, F.wg >> 4, F.wg & 15); }
    if (PROBE_TWICE == 48 && IN(4)) { xcd_barrier(bar); p4_convert(F, F.wg, F.G, CV_C1, CV_D0); }
    if (PROBE_TWICE == 49 && IN(4)) { xcd_barrier(bar); if (F.wg < 128) scan_combine(F, F.wg); }
    SEAM(4);
    RUN(5, PH5); SEAM(5);
    RUN(6, PH6); SEAM(6);
    RUN(7, PH7); SEAM(7);
    RUN(9, PH9); SEAM(9);
    RUN(10, PH10); SEAM(10);
    if (IN(11)) {
        if (DBG_MODE == 10) { const unsigned short* src = (const unsigned short*)(F.ws + WS_PREP);
            for (size_t i = (size_t)F.wg * NTHR + F.tid; i < (size_t)T * D; i += (size_t)F.G * NTHR) { float v = bf2f(src[i * 3]); F.out[i] = (v == v && fabsf(v) < 1e30f) ? v : 0.f; } }
        else if (DBG_MODE == 11) { const unsigned short* src = (const unsigned short*)(F.ws + WS_O);
            for (size_t i = (size_t)F.wg * NTHR + F.tid; i < (size_t)T * D; i += (size_t)F.G * NTHR) { float v = bf2f(src[i]); F.out[i] = (v == v && fabsf(v) < 1e30f) ? v : 0.f; } }
        else { p11_final(F); if (PROBE_TWICE == 11) { xcd_barrier(bar); p11_final(F); } } }
#undef IN
#undef SEAM
}

extern "C" void kernel_launch(void* const* d_in, const int* in_sizes, int n_in, void* d_out, int out_size, void* d_ws, size_t ws_size, hipStream_t stream) {
    static int grid = 0;
    if (grid == 0) {
        if (n_in != 23 || out_size != T * D || ws_size < WS_END) { fprintf(stderr, "kernel_launch: unexpected problem (n_in %d, out %d, ws %zu)\n", n_in, out_size, ws_size); grid = -1; return; }
        int dev = 0, cus = 0;
        if (hipGetDevice(&dev) != hipSuccess || hipDeviceGetAttribute(&cus, hipDeviceAttributeMultiprocessorCount, dev) != hipSuccess) { grid = -1; return; }
        if (hipFuncSetAttribute((const void*)mk_fwd, hipFuncAttributeMaxDynamicSharedMemorySize, LDS_BYTES) != hipSuccess) { fprintf(stderr, "kernel_launch: hipFuncSetAttribute failed\n"); grid = -1; return; }
        int per_cu = 0;
        if (hipOccupancyMaxActiveBlocksPerMultiprocessor(&per_cu, (const void*)mk_fwd, NTHR, LDS_BYTES) != hipSuccess || per_cu < 1) fprintf(stderr, "kernel_launch: occupancy query says %d\n", per_cu);
        (void)hipGetLastError();
        grid = cus;
        if (T % grid != 0 || T / grid > 256 || (T / grid) % 16 != 0 || SEQ % (T / grid) != 0) { fprintf(stderr, "kernel_launch: grid %d unsupported\n", grid); grid = -1; return; }
    }
    if (grid < 0) return;
    (void)hipMemsetAsync((char*)d_ws + WS_CTL, 0, CTL_BYTES, stream);
    Args a{};
    for (int i = 0; i < 23; ++i) a.in[i] = (const float*)d_in[i];
    a.out = (float*)d_out; a.ws = (unsigned char*)d_ws;
#if MK_PER_PHASE
    for (int p = 0; p < NPHASE; ++p) { if (DBG_MODE >= 10 && p >= 5 && p <= 10) continue; a.ph_lo = p; a.ph_hi = p + 1; hipLaunchKernelGGL(mk_fwd, dim3(grid), dim3(NTHR), LDS_BYTES, stream, a); }
#else
    a.ph_lo = 0; a.ph_hi = NPHASE; hipLaunchKernelGGL(mk_fwd, dim3(grid), dim3(NTHR), LDS_BYTES, stream, a);
#endif
}
```

```cpp
#include <hip/hip_runtime.h>
#include <cstdio>
#include <cstdint>
namespace pg8 {
#define PG8_LAS __attribute__((address_space(3)))
typedef unsigned short bf16_t;
typedef short bf16x8 __attribute__((ext_vector_type(8)));
typedef float f32x4 __attribute__((ext_vector_type(4)));
typedef unsigned u32x4 __attribute__((ext_vector_type(4)));
constexpr int BM = 256, BK = 64, HALF = 128, HTB = HALF * BK * 2  , STAGE_BYTES = 8 * HTB, NXCD = 8, WGM = 8;

__host__ __device__ __forceinline__ int lds_byte(int r, int c) { const int st = (r >> 4) * 2 + (c >> 5), rr = r & 15, cc = c & 31, ob = rr * 64 + cc * 2; return st * 1024 + (ob ^ (((ob >> 9) & 1) << 5)); }
__host__ __device__ __forceinline__ void stage_rc(int b, int& R, int& C) { const int st = b / 1024, sb = b % 1024, swz = sb ^ (((sb >> 9) & 1) << 5); R = (st >> 1) * 16 + swz / 64; C = (st & 1) * 32 + (swz % 64) / 2; }
__host__ __device__ __forceinline__ int perm32(int rho) { const int n = rho >> 4, i = rho & 15; return 8 * (i >> 2) + 4 * n + (i & 3); }

struct Unit { int pm, pn; };
struct Gemm { const bf16_t* A; const bf16_t* Bt; int M, N, K; };

struct StaticOrder {
    int nM, nN, nwg, G, c;
    __host__ __device__ void init(int M, int N, int G_, int c_) { nM = M / BM; nN = N / BM; nwg = nM * nN; G = G_; c = c_; }
    __host__ __device__ bool next(int i, Unit& u) const {
        const long L = (long)i * G + c; if (L >= nwg) return false;
        int wgid = (int)L; { const int q = nwg / NXCD, r = nwg % NXCD, xcd = wgid % NXCD, off = wgid / NXCD; wgid = (xcd < r ? xcd * (q + 1) : r * (q + 1) + (xcd - r) * q) + off; }
        const int nig = WGM * nN, gid = wgid / nig, fm = gid * WGM, gsz = (nM - fm) < WGM ? (nM - fm) : WGM;
        u.pm = fm + ((wgid % nig) % gsz); u.pn = (wgid % nig) / gsz; return true;
    }
    __device__ __forceinline__ void a_ready(const Unit&) const {}
    __device__ __forceinline__ void done(const Unit&) const {}
};
__device__ __forceinline__ unsigned cvt_pk_bf16(float lo, float hi) { unsigned r; asm volatile("v_cvt_pk_bf16_f32 %0, %1, %2" : "=v"(r) : "v"(lo), "v"(hi)); return r; }
template <class Epi, class Sched, bool ALIGN_EPI = false, bool SP2 = false, bool FP8 = false, bool GATHER = false>
__device__ __forceinline__ void gemm_phase(PG8_LAS unsigned char* lds, const Gemm g, const Sched& S, const Epi& E, const PG8_LAS int* gmap = nullptr) {
    typedef int i32x8_ __attribute__((ext_vector_type(8))); typedef int i32x4_ __attribute__((ext_vector_type(4)));
    const int tid = threadIdx.x, wid = __builtin_amdgcn_readfirstlane(tid >> 6), lane = tid & 63, wr = wid >> 2, wc = wid & 3, fr = lane & 15, fq = lane >> 4;
    const int K = g.K, nt = K / BK;
    unsigned voffA[2], voffB[2];
    int gR[2]; unsigned gCb[2]; unsigned gC0[2], gC1[2], gN0[2], gN1[2];
#pragma unroll
    for (int i = 0; i < 2; ++i) { int R, C; stage_rc(tid * 16 + i * 8192, R, C); const int Rb = Epi::PERM ? ((R & ~31) + perm32(R & 31)) : R;
        voffA[i] = (unsigned)(R * K + C) * 2u; voffB[i] = (unsigned)(Rb * K + C) * 2u; gR[i] = R; gCb[i] = (unsigned)C * 2u; }
#define PG8_GOFF(D0, D1, ui_) do { _Pragma("unroll") for (int i_ = 0; i_ < 2; ++i_) { D0[i_] = (unsigned)gmap[(ui_) * 256 + gR[i_]] * (unsigned)(K * 2) + gCb[i_]; D1[i_] = (unsigned)gmap[(ui_) * 256 + 128 + gR[i_]] * (unsigned)(K * 2) + gCb[i_]; } } while (0)
#define PG8_STAGE_A(bufoff, gbase, h_, nx_) do { if constexpr (GATHER) { if (nx_) PG8_STAGE(bufoff, gbase, ((h_) ? gN1 : gN0)); else PG8_STAGE(bufoff, gbase, ((h_) ? gC1 : gC0)); } \
        else PG8_STAGE(bufoff, (gbase) + ((h_) ? hstep : 0), voffA); } while (0)
    const size_t kstep = (size_t)(BK * 2);
    const size_t hstep = (size_t)HALF * K * 2;
    const size_t tstep = 2 * hstep;
    const unsigned ldsw = (unsigned)wid * 1024u;
    const int aoff = lds_byte(wr * 64 + fr, fq * 8), boff = lds_byte(wc * 32 + fr, fq * 8);
#define PG8_SA(b, h) (((b) * 2 + (h)) * HTB)
#define PG8_SB(b, h) ((4 + (b) * 2 + (h)) * HTB)
#define PG8_STAGE(bufoff, gbase, voff) do { _Pragma("unroll") for (int _i = 0; _i < 2; ++_i) \
        __builtin_amdgcn_global_load_lds((const unsigned*)((const char*)(gbase) + (voff)[_i]), (PG8_LAS unsigned*)(lds + (bufoff) + ldsw + _i * 8192), 16, 0, 0); } while (0)
#define PG8_LDA(dst, b, h) do { _Pragma("unroll") for (int m = 0; m < 4; ++m) _Pragma("unroll") for (int k = 0; k < 2; ++k) dst[m][k] = *(const PG8_LAS bf16x8*)(lds + PG8_SA(b, h) + aoff + m * 2048 + k * 1024); } while (0)
#define PG8_LDB(dst, b, h) do { _Pragma("unroll") for (int n = 0; n < 2; ++n) _Pragma("unroll") for (int k = 0; k < 2; ++k) dst[n][k] = *(const PG8_LAS bf16x8*)(lds + PG8_SB(b, h) + boff + n * 2048 + k * 1024); } while (0)
#define PG8_MMA16(ai, bj, At, Bt) do { __builtin_amdgcn_s_setprio(1); _Pragma("unroll") for (int m = 0; m < 4; ++m) _Pragma("unroll") for (int n = 0; n < 2; ++n) _Pragma("unroll") for (int k = 0; k < 2; ++k) \
        acc[ai][bj][m][n] = __builtin_amdgcn_mfma_f32_16x16x32_bf16(Bt[n][k], At[m][k], acc[ai][bj][m][n], 0, 0, 0); __builtin_amdgcn_s_setprio(0); } while (0)
#define PG8_LDA8(dst, b, h) do { _Pragma("unroll") for (int m = 0; m < 4; ++m) { const i32x4_ lo_ = *(const PG8_LAS i32x4_*)(lds + PG8_SA(b, h) + aoff + m * 2048), hi_ = *(const PG8_LAS i32x4_*)(lds + PG8_SA(b, h) + aoff + m * 2048 + 1024); \
        dst[m] = __builtin_shufflevector(lo_, hi_, 0, 1, 2, 3, 4, 5, 6, 7); } } while (0)
#define PG8_LDB8(dst, b, h) do { _Pragma("unroll") for (int n = 0; n < 2; ++n) { const i32x4_ lo_ = *(const PG8_LAS i32x4_*)(lds + PG8_SB(b, h) + boff + n * 2048), hi_ = *(const PG8_LAS i32x4_*)(lds + PG8_SB(b, h) + boff + n * 2048 + 1024); \
        dst[n] = __builtin_shufflevector(lo_, hi_, 0, 1, 2, 3, 4, 5, 6, 7); } } while (0)
#define PG8_MMA8(ai, bj, At, Bt) do { __builtin_amdgcn_s_setprio(1); _Pragma("unroll") for (int m = 0; m < 4; ++m) _Pragma("unroll") for (int n = 0; n < 2; ++n) \
        asm volatile("v_mfma_scale_f32_16x16x128_f8f6f4 %0, %1, %2, %0, %3, %3 op_sel_hi:[0,0,0]" : "+v"(acc[ai][bj][m][n]) : "v"(Bt[n]), "v"(At[m]), "v"(scale1)); \
        __builtin_amdgcn_s_setprio(0); } while (0)
#define PG8_LDAX(dst, b, h) do { if constexpr (FP8) PG8_LDA8(dst##8, b, h); else PG8_LDA(dst, b, h); } while (0)
#define PG8_LDBX(dst, b, h) do { if constexpr (FP8) PG8_LDB8(dst##8, b, h); else PG8_LDB(dst, b, h); } while (0)
#define PG8_MMA(ai, bj, At, Bt) do { if constexpr (FP8) PG8_MMA8(ai, bj, At##8, Bt##8); else PG8_MMA16(ai, bj, At, Bt); } while (0)
#define PG8_WAIT_V(n) asm volatile("s_waitcnt vmcnt(" #n ")" ::: "memory")
#define PG8_WAIT_L(n) asm volatile("s_waitcnt lgkmcnt(" #n ")" ::: "memory")
#define PG8_BAR __builtin_amdgcn_s_barrier()
#define PG8_SCHED __builtin_amdgcn_sched_barrier(0)
    Unit cur, nxt; int ui = 0;
    if (!S.next(0, cur)) return;
    f32x4 acc[2][2][4][2];
#pragma unroll
    for (int a = 0; a < 2; ++a)
#pragma unroll
        for (int b = 0; b < 2; ++b)
#pragma unroll
            for (int m = 0; m < 4; ++m)
#pragma unroll
                for (int n = 0; n < 2; ++n) acc[a][b][m][n] = (f32x4){0.f, 0.f, 0.f, 0.f};
    bf16x8 At[4][2], B0[2][2], B1[2][2];
    i32x8_ At8[4], B08[2], B18[2]; int scale1 = 0x7f7f7f7f; asm volatile("" : "+v"(scale1));
    const char* cA = (const char*)g.A + (GATHER ? (size_t)0 : (size_t)cur.pm * tstep); const char* cB = (const char*)g.Bt + (size_t)cur.pn * tstep;
    if constexpr (GATHER) { PG8_GOFF(gC0, gC1, 0); }
    S.a_ready(cur);
    if constexpr (SP2) {
        PG8_STAGE(PG8_SB(0, 0), cB, voffB); PG8_STAGE(PG8_SB(0, 1), cB + hstep, voffB); PG8_STAGE_A(PG8_SA(0, 0), cA, 0, false); PG8_STAGE_A(PG8_SA(0, 1), cA, 1, false);
        if (wr == 1) PG8_BAR;
        PG8_WAIT_V(2); PG8_BAR;
        PG8_STAGE(PG8_SB(1, 0), cB + kstep, voffB); PG8_STAGE_A(PG8_SA(1, 0), cA + kstep, 0, false); PG8_STAGE(PG8_SB(1, 1), cB + hstep + kstep, voffB);
        PG8_WAIT_V(6); PG8_BAR;
    } else {
        PG8_STAGE(PG8_SB(0, 0), cB, voffB); PG8_STAGE(PG8_SA(0, 0), cA, voffA); PG8_STAGE(PG8_SB(0, 1), cB + hstep, voffB); PG8_STAGE(PG8_SA(0, 1), cA + hstep, voffA);
        if (wr == 1) PG8_BAR;
        PG8_WAIT_V(4); PG8_BAR;
        PG8_STAGE(PG8_SB(1, 0), cB + kstep, voffB); PG8_STAGE(PG8_SA(1, 0), cA + kstep, voffA); PG8_STAGE(PG8_SB(1, 1), cB + hstep + kstep, voffB);
        PG8_WAIT_V(6); PG8_BAR;
    }
    for (;;) {
        const bool has_next = S.next(ui + 1, nxt);
        const char* nA = (has_next && !GATHER) ? (const char*)g.A + (size_t)nxt.pm * tstep : cA; const char* nB = has_next ? (const char*)g.Bt + (size_t)nxt.pn * tstep : cB;
        if constexpr (GATHER) { if (has_next) { PG8_GOFF(gN0, gN1, ui + 1); } else { _Pragma("unroll") for (int i_ = 0; i_ < 2; ++i_) { gN0[i_] = gC0[i_]; gN1[i_] = gC1[i_]; } } }
#pragma clang loop unroll(disable)
        for (int t = 0; t < nt; t += 2) {
            const bool last = (t == nt - 2);
            const char* a1 = cA + (size_t)(t + 1) * kstep;
            const char* a2 = last ? nA : cA + (size_t)(t + 2) * kstep; const char* b2 = last ? nB : cB + (size_t)(t + 2) * kstep;
            const char* a3 = a2 + kstep; const char* b3 = b2 + kstep;
            if (last && has_next) S.a_ready(nxt);
            if constexpr (SP2) {
            PG8_LDBX(B0, 0, 0); PG8_LDBX(B1, 0, 1); PG8_SCHED; PG8_LDAX(At, 0, 0); PG8_STAGE_A(PG8_SA(1, 1), a1, 1, false);
            PG8_WAIT_V(8); PG8_WAIT_L(0); PG8_BAR; PG8_MMA(0, 0, At, B0); PG8_MMA(0, 1, At, B1); PG8_BAR; PG8_SCHED;
            PG8_LDAX(At, 0, 1); PG8_STAGE(PG8_SB(0, 0), b2, voffB); PG8_STAGE(PG8_SB(0, 1), b2 + hstep, voffB); PG8_STAGE_A(PG8_SA(0, 0), a2, 0, last);
            PG8_WAIT_V(8); PG8_WAIT_L(0); PG8_BAR; PG8_MMA(1, 0, At, B0); PG8_MMA(1, 1, At, B1); PG8_BAR; PG8_SCHED;
            PG8_LDBX(B0, 1, 0); PG8_LDBX(B1, 1, 1); PG8_SCHED; PG8_LDAX(At, 1, 0); PG8_STAGE_A(PG8_SA(0, 1), a2, 1, last);
            PG8_WAIT_V(8); PG8_WAIT_L(0); PG8_BAR; PG8_MMA(0, 0, At, B0); PG8_MMA(0, 1, At, B1); PG8_BAR; PG8_SCHED;
            PG8_LDAX(At, 1, 1); PG8_STAGE(PG8_SB(1, 0), b3, voffB); PG8_STAGE(PG8_SB(1, 1), b3 + hstep, voffB); PG8_STAGE_A(PG8_SA(1, 0), a3, 0, last);
            PG8_WAIT_V(8); PG8_WAIT_L(0); PG8_BAR; PG8_MMA(1, 0, At, B0); PG8_MMA(1, 1, At, B1); PG8_BAR; PG8_SCHED;
            } else {
            PG8_LDBX(B0, 0, 0); PG8_SCHED; PG8_LDAX(At, 0, 0); PG8_STAGE(PG8_SA(1, 1), a1 + hstep, voffA);
            PG8_WAIT_L(8); PG8_BAR; PG8_WAIT_L(0); PG8_MMA(0, 0, At, B0); PG8_BAR; PG8_SCHED;
            PG8_LDBX(B1, 0, 1); PG8_STAGE(PG8_SB(0, 0), b2, voffB);
            PG8_BAR; PG8_WAIT_L(0); PG8_MMA(0, 1, At, B1); PG8_BAR;
            PG8_LDAX(At, 0, 1); PG8_STAGE(PG8_SA(0, 0), a2, voffA);
            PG8_BAR; PG8_WAIT_L(0); PG8_MMA(1, 0, At, B0); PG8_BAR; PG8_SCHED;
            PG8_STAGE(PG8_SB(0, 1), b2 + hstep, voffB);
            PG8_WAIT_V(6); PG8_BAR; PG8_MMA(1, 1, At, B1); PG8_BAR;
            PG8_LDBX(B0, 1, 0); PG8_SCHED; PG8_LDAX(At, 1, 0); PG8_STAGE(PG8_SA(0, 1), a2 + hstep, voffA);
            PG8_WAIT_L(8); PG8_BAR; PG8_WAIT_L(0); PG8_MMA(0, 0, At, B0); PG8_BAR; PG8_SCHED;
            PG8_LDBX(B1, 1, 1); PG8_STAGE(PG8_SB(1, 0), b3, voffB);
            PG8_BAR; PG8_WAIT_L(0); PG8_MMA(0, 1, At, B1); PG8_BAR;
            PG8_LDAX(At, 1, 1); PG8_STAGE(PG8_SA(1, 0), a3, voffA);
            PG8_BAR; PG8_WAIT_L(0); PG8_MMA(1, 0, At, B0); PG8_BAR; PG8_SCHED;
            PG8_STAGE(PG8_SB(1, 1), b3 + hstep, voffB);
            PG8_WAIT_V(6); PG8_BAR; PG8_MMA(1, 1, At, B1); PG8_BAR;
            }
        }
        if constexpr (ALIGN_EPI) { if (wr == 0) PG8_BAR; }
        if constexpr (FP8) asm volatile("s_nop 15\n\ts_nop 15\n\ts_nop 15\n\ts_nop 15\n\ts_nop 15" ::: "memory");
        if constexpr (!Epi::AFTER_DRAIN) { Unit eu = cur; int fr_ = fr, fq_ = fq; asm volatile("" : "+v"(eu.pm), "+v"(eu.pn), "+v"(fr_), "+v"(fq_));
            E(acc, eu, wr, wc, fr_, fq_); S.done(cur); }
        if (!has_next) break;
#pragma unroll
        for (int a = 0; a < 2; ++a)
#pragma unroll
            for (int b = 0; b < 2; ++b)
#pragma unroll
                for (int m = 0; m < 4; ++m)
#pragma unroll
                    for (int n = 0; n < 2; ++n) acc[a][b][m][n] = (f32x4){0.f, 0.f, 0.f, 0.f};
        cur = nxt; cA = nA; cB = nB; ++ui;
        if constexpr (GATHER) { _Pragma("unroll") for (int i_ = 0; i_ < 2; ++i_) { gC0[i_] = gN0[i_]; gC1[i_] = gN1[i_]; } }
        if constexpr (ALIGN_EPI) { if (wr == 1) PG8_BAR; }
    }
    PG8_WAIT_V(0);
    if constexpr (!ALIGN_EPI) { if (wr == 0) PG8_BAR; }
    PG8_BAR;
    if constexpr (Epi::AFTER_DRAIN) { E.fused(acc, cur, wr, wc, fr, fq, lds, wid, lane); S.done(cur); }
#undef PG8_SA
#undef PG8_SB
#undef PG8_STAGE
#undef PG8_STAGE_A
#undef PG8_GOFF
#undef PG8_LDA
#undef PG8_LDB
#undef PG8_MMA
#undef PG8_MMA16
#undef PG8_MMA8
#undef PG8_LDA8
#undef PG8_LDB8
#undef PG8_LDAX
#undef PG8_LDBX
#undef PG8_WAIT_V
#undef PG8_WAIT_L
#undef PG8_BAR
#undef PG8_SCHED
}
}

#ifndef MK_PER_PHASE
#define MK_PER_PHASE 0
#endif
#ifndef PROBE_TWICE
#define PROBE_TWICE -1
#endif
#ifndef DBG_SEL
#define DBG_SEL 9
#endif
#ifndef DBG_MODE
#define DBG_MODE 0
#endif
#if 0
#endif

#define GAS __attribute__((address_space(1)))
#define LAS __attribute__((address_space(3)))
typedef unsigned short bf16;
typedef float f32x4 __attribute__((ext_vector_type(4)));
typedef short bf16x8 __attribute__((ext_vector_type(8)));
typedef unsigned u32x4 __attribute__((ext_vector_type(4)));
typedef unsigned u32x2 __attribute__((ext_vector_type(2)));

constexpr int NB = 2, SEQ = 16384, D = 1024, T = NB * SEQ, CTXL = 256, TC = NB * CTXL, TALL = T + TC;
constexpr int NPROJ = 3328, NPROJ_SRC = 3088;
constexpr int PC_Z = 1536, PC_U = 2048, PC_V = 2560, PC_BA = 3072;
constexpr int NH = 4, NE = 32, NCH = 260;
constexpr int MAXPAN = 544, MAXROWS = MAXPAN * 256;
constexpr float EPS = 1e-6f;
constexpr int NWAVES = 8, NTHR = 512;
constexpr int NPHASE = 12;
constexpr int CV_A0 = 0, CV_A1 = 5712, CV_B1 = CV_A1 + 5376, CV_C1 = CV_B1 + 2304, CV_D0 = NE * 768 - 3072;

constexpr size_t MiB = 1ull << 20;
constexpr size_t WS_CTL = 0, CTL_BYTES = 1 * MiB;
constexpr size_t WS_MOD = 1 * MiB;
constexpr size_t WS_WRT = 1 * MiB + 128 * 1024;
constexpr size_t WS_BGUP = 1 * MiB + 256 * 1024;
constexpr size_t WS_TKE = 2 * MiB, WS_TKRANK = 2 * MiB + 512 * 1024, WS_TKGATE = 3 * MiB, WS_TKROW = 3 * MiB + 512 * 1024;
constexpr size_t WS_ROWGATE = 4 * MiB;
constexpr size_t WS_WINT = 6 * MiB;
constexpr size_t WS_WOUTT = 13 * MiB;
constexpr size_t WS_WGUT = 16 * MiB;
constexpr size_t WS_WDT = 144 * MiB;
constexpr size_t WS_X1 = 208 * MiB;
constexpr size_t WS_MIX = WS_X1;
constexpr size_t WS_H2 = 336 * MiB;
constexpr size_t WS_R1 = 400 * MiB;
constexpr size_t WS_P = WS_R1, WS_ACT = WS_R1;
constexpr size_t WS_R2 = 672 * MiB;
constexpr size_t WS_HALL = WS_R2, WS_O = WS_R2;
constexpr size_t WS_PREP = WS_R2 + 65 * MiB;
constexpr size_t WS_R = WS_PREP;
constexpr size_t WS_VEC = WS_R2 + 261 * MiB;
constexpr size_t WS_ROWTOK = WS_R2;
constexpr size_t WS_XS = WS_R2, WS_Y = WS_R2;
constexpr size_t WS_END = 944 * MiB;
constexpr size_t PREP_UNIT = 98304;
constexpr int PO_KQ = 0, PO_KT = 32768, PO_V = 49152, PO_T = 65536, PO_A = 81920;
constexpr int CW_BAR = 4096, CW_GCNT = 8192;

constexpr int LDS_BYTES = 163840;
constexpr int LDS_TAB = 131072;
constexpr int LDS_GMAP = LDS_TAB + 4096;
constexpr int LDS_MISC = LDS_BYTES - 64;

#define LDS_WAIT() asm volatile("s_waitcnt lgkmcnt(0)" ::: "memory")
#define VM_WAIT() asm volatile("s_waitcnt vmcnt(0)" ::: "memory")

__device__ __forceinline__ float bf2f(unsigned b) { return __uint_as_float(b << 16); }
__device__ __forceinline__ float bflo(unsigned w) { return __uint_as_float(w << 16); }
__device__ __forceinline__ float bfhi(unsigned w) { return __uint_as_float(w & 0xffff0000u); }
typedef __bf16 bf16x2_t __attribute__((ext_vector_type(2)));
typedef float f32x2_t __attribute__((ext_vector_type(2)));
__device__ __forceinline__ unsigned pk2(float lo, float hi) { const f32x2_t f = {lo, hi}; const bf16x2_t v = __builtin_convertvector(f, bf16x2_t); return __builtin_bit_cast(unsigned, v); }
__device__ __forceinline__ float sat8(float x) { return __builtin_amdgcn_fmed3f(x, -448.f, 448.f); }
__device__ __forceinline__ unsigned pk_fp8x4(float a, float b, float c, float d) { a = sat8(a); b = sat8(b); c = sat8(c); d = sat8(d); int w = 0; w = __builtin_amdgcn_cvt_pk_fp8_f32(a, b, w, false); w = __builtin_amdgcn_cvt_pk_fp8_f32(c, d, w, true); return (unsigned)w; }
constexpr float W8_SCALE = 32.f, W8_INV = 1.f / 32.f;
__device__ __forceinline__ float frcp(float x) { return __builtin_amdgcn_rcpf(x); }
__device__ __forceinline__ float sigm(float x) { return frcp(1.f + __expf(-x)); }
__device__ __forceinline__ float silu_(float x) { return x * frcp(1.f + __expf(-x)); }
__device__ __forceinline__ float gelu_t(float x) { const float y = 0.7978845608028654f * (x + 0.044715f * x * x * x); const float t = 1.f - 2.f * frcp(__expf(2.f * y) + 1.f); return 0.5f * x * (1.f + t); }
#define DPP_MOV(v, ctrl) __builtin_bit_cast(float, __builtin_amdgcn_update_dpp(0, __builtin_bit_cast(int, (v)), (ctrl), 0xf, 0xf, true))
__device__ __forceinline__ float sum16(float v) { v += DPP_MOV(v, 0xB1); v += DPP_MOV(v, 0x4E); v += DPP_MOV(v, 0x124); v += DPP_MOV(v, 0x128); return v; }
__device__ __forceinline__ float wave_sum(float v) {
    v = sum16(v); const int iv = __builtin_bit_cast(int, v);
    return (__builtin_bit_cast(float, __builtin_amdgcn_readlane(iv, 0)) + __builtin_bit_cast(float, __builtin_amdgcn_readlane(iv, 16))) + (__builtin_bit_cast(float, __builtin_amdgcn_readlane(iv, 32)) + __builtin_bit_cast(float, __builtin_amdgcn_readlane(iv, 48)));
}
#define XB_TMO      128
#define XB_XCNT(j)  (256  + 64 * (j))
#define XB_XSUB(j)  (1280 + 64 * (j))
#define XB_XGEN(j)  (2304 + 64 * (j))
#define XB_TOP      3328
#define XB_TOPGEN   3392
#define XCD_BAR_WORDS 3456
#define XB_SPIN_CAP (1u << 18)
__device__ __forceinline__ unsigned xb_ld(unsigned* p)              { return __hip_atomic_load(p, __ATOMIC_RELAXED, __HIP_MEMORY_SCOPE_AGENT); }
__device__ __forceinline__ unsigned xb_add(unsigned* p, unsigned v) { return __hip_atomic_fetch_add(p, v, __ATOMIC_RELAXED, __HIP_MEMORY_SCOPE_AGENT); }
__device__ __forceinline__ unsigned xb_xcc_id() { return (unsigned)__builtin_amdgcn_s_getreg((3 << 11) | 20) & 0xFu; }
#define XB_SPIN(cond, bar) do { unsigned _sp = 0; while (cond) { __builtin_amdgcn_s_sleep(1); \
    if ((++_sp & 255u) == 0u) { if (xb_ld(&(bar)[XB_TMO])) break; if (_sp > XB_SPIN_CAP) { atomicAdd(&(bar)[XB_TMO], 1u); break; } } } } while (0)
struct XcdBarrier { unsigned* bar; unsigned x; volatile LAS unsigned* st; };
__device__ __forceinline__ XcdBarrier xcd_barrier_post(unsigned* bar, volatile LAS unsigned* st) {
    XcdBarrier b; b.bar = bar; b.x = xb_xcc_id(); b.st = st;
    if (threadIdx.x == 0) (void)xb_add(&bar[XB_XCNT(b.x)], 1u);
    return b;
}
__device__ __forceinline__ void xcd_barrier_complete(unsigned* bar, unsigned x, unsigned& nloc, unsigned& nx) {
    const unsigned G = gridDim.x * gridDim.y * gridDim.z;
    unsigned sum, cnt, mine, sp = 0u;
    for (;;) {
        sum = 0u; cnt = 0u; mine = 0u;
#pragma unroll
        for (unsigned j = 0; j < 16; ++j) { const unsigned c = xb_ld(&bar[XB_XCNT(j)]); sum += c; cnt += (c > 0u) ? 1u : 0u; mine = (j == x) ? c : mine; }
        if (sum == G) break;
        __builtin_amdgcn_s_sleep(1);
        if ((++sp & 255u) == 0u) { if (xb_ld(&bar[XB_TMO])) break; if (sp > XB_SPIN_CAP) { atomicAdd(&bar[XB_TMO], 1u); break; } }
    }
    nloc = mine > 0u ? mine : 1u; nx = cnt > 0u ? cnt : 1u;
}
__device__ __forceinline__ void xcd_barrier(const XcdBarrier& b) {
    asm volatile("s_waitcnt vmcnt(0)" ::: "memory");
    __syncthreads();
    if (threadIdx.x == 0) {
        unsigned* bar = b.bar;
        __builtin_amdgcn_s_waitcnt(0);
        unsigned nloc = b.st[0], nx = b.st[1];
        if (nloc == 0u) { xcd_barrier_complete(bar, b.x, nloc, nx); b.st[0] = nloc; b.st[1] = nx; }
        const unsigned old = xb_add(&bar[XB_XSUB(b.x)], 1u);
        const unsigned gen = old / nloc;
        if (old + 1u == (gen + 1u) * nloc) {
            __builtin_amdgcn_fence(__ATOMIC_RELEASE, "agent");
            asm volatile("s_waitcnt vmcnt(0)" ::: "memory");
            const unsigned og = xb_add(&bar[XB_TOP], 1u);
            const unsigned tg = og / nx;
            if (og + 1u == (tg + 1u) * nx) xb_add(&bar[XB_TOPGEN], 1u);
            else XB_SPIN(xb_ld(&bar[XB_TOPGEN]) == tg, bar);
            __builtin_amdgcn_fence(__ATOMIC_ACQUIRE, "agent");
            xb_add(&bar[XB_XGEN(b.x)], 1u);
            asm volatile("s_waitcnt vmcnt(0)" ::: "memory");
        } else {
            XB_SPIN(xb_ld(&bar[XB_XGEN(b.x)]) == gen, bar);
            __builtin_amdgcn_fence(__ATOMIC_ACQUIRE, "agent");
            asm volatile("s_waitcnt vmcnt(0)" ::: "memory");
        }
    }
    __syncthreads();
}

struct Fr {
    LAS unsigned char* lds; unsigned char* ws; const float* in[23]; float* out;
    int tid, lane, wave, wg, G;
};
#define WSP(T_, off) ((T_*)(F.ws + (off)))

struct MapId { __device__ __forceinline__ int operator()(int n) const { return n; } };
struct MapIn { __device__ __forceinline__ int operator()(int n) const { return n < 1536 ? n : (n < 1552 ? PC_BA + (n - 1536) : n - 16); } };
struct MapGu { __device__ __forceinline__ int operator()(int s) const { const int a = s >> 1; return 32 * (a >> 4) + 16 * (s & 1) + (a & 15); } };
template <class RM> __device__ __forceinline__ void tr_item(const float* W, int N, int k0, int n0, bf16* WT, RM rm, LAS float* scr, int lane) {
    const int cq = lane & 15, rq = lane >> 4;
#pragma unroll
    for (int i = 0; i < 16; ++i) { const int kk = 4 * i + rq, n = n0 + 4 * cq; f32x4 v = (f32x4){0.f, 0.f, 0.f, 0.f};
        if (n < N) v = *(const f32x4*)(W + (size_t)(k0 + kk) * N + n);
        *(LAS f32x4*)(scr + kk * 68 + 4 * cq) = v; }
    LDS_WAIT();
    const int c = lane & 7;
#pragma unroll
    for (int j = 0; j < 8; ++j) { const int n = 8 * j + (lane >> 3);
        if (n0 + n < N) { const LAS float* s = scr + (8 * c) * 68 + n;
            u32x4 o; o.x = pk2(s[0], s[68]); o.y = pk2(s[136], s[204]); o.z = pk2(s[272], s[340]); o.w = pk2(s[408], s[476]);
            *(u32x4*)(WT + (size_t)rm(n0 + n) * 1024 + k0 + 8 * c) = o; } }
    LDS_WAIT();
}
struct MapGu8 { __device__ __forceinline__ int operator()(int s) const { const int a = s >> 1, n = s & 1, pn = a >> 7, al = a & 127; return 256 * pn + 128 * ((al >> 2) & 1) + 32 * (al >> 5) + 16 * n + 4 * ((al >> 3) & 3) + (al & 3); } };
template <class RM> __device__ __forceinline__ void tr_item8(const float* W, int N, int k0, int n0, unsigned char* WT, RM rm, LAS float* scr, int lane) {
    const int cq = lane & 15, rq = lane >> 4;
#pragma unroll
    for (int i = 0; i < 16; ++i) { const int kk = 4 * i + rq, n = n0 + 4 * cq; *(LAS f32x4*)(scr + kk * 68 + 4 * cq) = *(const f32x4*)(W + (size_t)(k0 + kk) * N + n); }
    LDS_WAIT();
    const int c = lane & 7;
#pragma unroll
    for (int j = 0; j < 8; ++j) { const int n = 8 * j + (lane >> 3); const LAS float* sp = scr + (8 * c) * 68 + n;
        u32x2 o; o.x = pk_fp8x4(sp[0] * W8_SCALE, sp[68] * W8_SCALE, sp[136] * W8_SCALE, sp[204] * W8_SCALE); o.y = pk_fp8x4(sp[272] * W8_SCALE, sp[340] * W8_SCALE, sp[408] * W8_SCALE, sp[476] * W8_SCALE);
        *(u32x2*)(WT + (size_t)rm(n0 + n) * 1024 + k0 + 8 * c) = o; }
    LDS_WAIT();
}
__device__ __forceinline__ void p0_prologue(const Fr& F) {
    const float* c = F.in[1]; const float* cc = F.in[3]; const float* wada = F.in[4]; const float* bada = F.in[5];
    {
        LAS float* SIL = (LAS float*)F.lds; LAS float* RED = SIL + 3072; float* MOD = WSP(float, WS_MOD);
        for (int u = F.wg; u < 96; u += F.G) {
            for (int i = F.tid; i < 3072; i += NTHR) { const int r = i >> 10, k = i & 1023; const float x = r == 0 ? c[k] : (r == 1 ? c[1024 + k] : cc[k]); SIL[i] = silu_(x); }
            __syncthreads();
            const int n0 = u * 64, kb = F.wave * 128; float a0 = 0.f, a1 = 0.f, a2 = 0.f;
#pragma unroll 8
            for (int k = 0; k < 128; ++k) { const float w = wada[(size_t)(kb + k) * 6144 + n0 + F.lane]; a0 += SIL[kb + k] * w; a1 += SIL[1024 + kb + k] * w; a2 += SIL[2048 + kb + k] * w; }
            RED[(F.wave * 3 + 0) * 64 + F.lane] = a0; RED[(F.wave * 3 + 1) * 64 + F.lane] = a1; RED[(F.wave * 3 + 2) * 64 + F.lane] = a2;
            __syncthreads();
            if (F.tid < 192) { const int r = F.tid >> 6, l = F.tid & 63; float s = bada[n0 + l];
#pragma unroll
                for (int w = 0; w < 8; ++w) s += RED[(w * 3 + r) * 64 + l];
                MOD[r * 6144 + n0 + l] = s; }
            __syncthreads();
        }
    }
    {
        LAS float* scr = (LAS float*)(F.lds + F.wave * 17408);
        const int gw = F.wg * NWAVES + F.wave, NGW = F.G * NWAVES;
        constexpr int I_IN = 16 * 49, I_OUT = 16 * 16;
        for (int it = gw; it < I_IN + I_OUT; it += NGW) {
            int r = it;
            if (r < I_IN) { tr_item(F.in[7], NPROJ_SRC, (r / 49) * 64, (r % 49) * 64, WSP(bf16, WS_WINT), MapIn{}, scr, F.lane); continue; } r -= I_IN;
            tr_item(F.in[16], 1024, (r / 16) * 64, (r % 16) * 64, WSP(bf16, WS_WOUTT), MapId{}, scr, F.lane);
        }
    }
    {
        const int gt = F.wg * NTHR + F.tid, NGT = F.G * NTHR;
        float* WRT = WSP(float, WS_WRT); const float* rw = F.in[17];
        for (int i = gt; i < NE * 1024; i += NGT) { const int e = i >> 10, k = i & 1023; WRT[i] = rw[k * NE + e]; }
        float* BG = WSP(float, WS_BGUP); const float* bgu = F.in[20]; MapGu8 mg;
        for (int i = gt; i < NE * 2048; i += NGT) { const int e = i >> 11, s = i & 2047; BG[e * 2048 + mg(s)] = bgu[i]; }
        u32x4* z = (u32x4*)(WSP(bf16, WS_WINT) + (size_t)NPROJ_SRC * 1024);
        for (int i = gt; i < (NPROJ - NPROJ_SRC) * 1024 / 8; i += NGT) z[i] = (u32x4){0u, 0u, 0u, 0u};
    }
}

__device__ __forceinline__ void p4_convert(const Fr& F, int worker, int nworkers, int it_lo, int it_hi) {
    LAS float* scr = (LAS float*)(F.lds + F.wave * 17408);
    const int gw = worker * NWAVES + F.wave, NGW = nworkers * NWAVES;
    constexpr int I_GU = NE * 16 * 32, I_DN = NE * 16 * 16;
    for (int it = it_lo + gw; it < it_hi; it += NGW) {
        int r = it;
        if (r < I_GU) { const int e = r / 512, rr = r % 512; tr_item8(F.in[19] + (size_t)e * 1024 * 2048, 2048, (rr / 32) * 64, (rr % 32) * 64, WSP(unsigned char, WS_WGUT) + (size_t)e * 2048 * 1024, MapGu8{}, scr, F.lane); continue; } r -= I_GU;
        { const int e = r / 256, rr = r % 256; tr_item8(F.in[21] + (size_t)e * 1024 * 1024, 1024, (rr / 16) * 64, (rr % 16) * 64, WSP(unsigned char, WS_WDT) + (size_t)e * 1024 * 1024, MapId{}, scr, F.lane); }
    }
}
__device__ __forceinline__ void p1_norm(const Fr& F) {
    const float* x = F.in[0]; const float* ctx = F.in[2]; const float* ng = F.in[6]; const float* MOD = WSP(float, WS_MOD); bf16* H = WSP(bf16, WS_HALL);
    const int gw = F.wg * NWAVES + F.wave, NGW = F.G * NWAVES, lane = F.lane;
    for (int blk = gw; blk < TALL / 4; blk += NGW) {
        const int r0 = blk * 4; const float* xb = r0 < T ? x + (size_t)r0 * D : ctx + (size_t)(r0 - T) * D; const int mi = r0 < T ? (r0 >> 14) : 2;
        const float* m0 = MOD + mi * 6144; const float* m1 = m0 + 1024;
        f32x4 sc[4], sh[4];
#pragma unroll
        for (int j = 0; j < 4; ++j) { const int k = 256 * j + 4 * lane; sc[j] = *(const f32x4*)(ng + k) * (*(const f32x4*)(m1 + k) + 1.f); sh[j] = *(const f32x4*)(m0 + k); }
        f32x4 cur[4], nxt[4];
#pragma unroll
        for (int j = 0; j < 4; ++j) cur[j] = *(const f32x4*)(xb + 256 * j + 4 * lane);
#pragma clang loop unroll(disable)
        for (int i = 0; i < 4; ++i) {
            const int in = i + 1 < 4 ? i + 1 : i;
#pragma unroll
            for (int j = 0; j < 4; ++j) nxt[j] = *(const f32x4*)(xb + (size_t)in * D + 256 * j + 4 * lane);
            float ss = 0.f;
#pragma unroll
            for (int j = 0; j < 4; ++j) ss += (cur[j].x * cur[j].x + cur[j].y * cur[j].y) + (cur[j].z * cur[j].z + cur[j].w * cur[j].w);
            const float rstd = rsqrtf(wave_sum(ss) * (1.f / D) + EPS);
#pragma unroll
            for (int j = 0; j < 4; ++j) { const f32x4 h = cur[j] * rstd * sc[j] + sh[j];
                u32x2 o; o.x = pk2(h.x, h.y); o.y = pk2(h.z, h.w); *(u32x2*)(H + (size_t)(r0 + i) * D + 256 * j + 4 * lane) = o; cur[j] = nxt[j]; }
        }
    }
}

__device__ __forceinline__ void p3_prep(const Fr& F) {
    const bf16* P = WSP(bf16, WS_P); const float* convw = F.in[8]; const float* alog = F.in[9]; const float* dtb = F.in[10];
    LAS bf16* QL = (LAS bf16*)F.lds; LAS bf16* KL = QL + 64 * 136; LAS bf16* VL = KL + 64 * 136;
    LAS float* AM = (LAS float*)(F.lds + 52224); LAS float* XM = AM + 2 * 64 * 65; LAS bf16* AT = (LAS bf16*)(F.lds + 118784);
    LAS float* TMPW = (LAS float*)(F.lds + 137216); LAS float* GV = (LAS float*)(F.lds + 139392);
    for (int u = F.wg; u < NB * NCH * NH; u += F.G) {
        int tid = F.tid; asm volatile("" : "+v"(tid));
        const int lane = tid & 63, wave = __builtin_amdgcn_readfirstlane(tid >> 6), l16 = lane & 15, q4 = lane >> 4;
        const int b = u / (NCH * NH), rem = u % (NCH * NH), cn = rem >> 2, h = rem & 3;
        int rowbase, lo, hi;
        if (cn < 4) { lo = T + b * CTXL; hi = lo + CTXL; rowbase = lo + cn * 64; } else { rowbase = b * SEQ + (cn - 4) * 64; lo = rowbase; hi = rowbase + 64; }
        unsigned char* pu = F.ws + WS_PREP + (size_t)u * PREP_UNIT; float* vec = WSP(float, WS_VEC) + (size_t)u * 512;
        u32x4 xc[6], xn[6]; f32x4 cwc[6], cwn[6];
#define P3_LOAD(XD, WD, part_) do { const int cg_ = tid & 15, col_ = (part_) * 512 + h * 128 + cg_ * 8; \
            _Pragma("unroll") for (int sub_ = 0; sub_ < 2; ++sub_) { const int row_ = rowbase + (sub_ << 5) + (tid >> 4); const u32x4 zero_ = (u32x4){0u, 0u, 0u, 0u}; \
                XD[sub_ * 3 + 1] = *(const u32x4*)(P + (size_t)row_ * NPROJ + col_); XD[sub_ * 3 + 0] = zero_; XD[sub_ * 3 + 2] = zero_; \
                if (row_ - 1 >= lo) XD[sub_ * 3 + 0] = *(const u32x4*)(P + (size_t)(row_ - 1) * NPROJ + col_); \
                if (row_ + 1 < hi) XD[sub_ * 3 + 2] = *(const u32x4*)(P + (size_t)(row_ + 1) * NPROJ + col_); } \
            _Pragma("unroll") for (int hh_ = 0; hh_ < 2; ++hh_) { WD[hh_ * 3 + 0] = *(const f32x4*)(convw + col_ + 4 * hh_); WD[hh_ * 3 + 1] = *(const f32x4*)(convw + 1536 + col_ + 4 * hh_); WD[hh_ * 3 + 2] = *(const f32x4*)(convw + 3072 + col_ + 4 * hh_); } } while (0)
        P3_LOAD(xc, cwc, 0);
#pragma unroll
        for (int part = 0; part < 3; ++part) {
            const int cg = tid & 15;
            if (part < 2) P3_LOAD(xn, cwn, part + 1);
#pragma unroll
            for (int sub = 0; sub < 2; ++sub) {
                const int i = (sub << 5) + (tid >> 4);
                const u32x4 xm = xc[sub * 3 + 0], x0 = xc[sub * 3 + 1], xp = xc[sub * 3 + 2];
                float val[8];
#pragma unroll
                for (int hh = 0; hh < 2; ++hh) {
                    const f32x4 w0 = cwc[hh * 3 + 0], w1 = cwc[hh * 3 + 1], w2 = cwc[hh * 3 + 2];
                    const unsigned m0 = hh ? xm.z : xm.x, m1 = hh ? xm.w : xm.y, c0 = hh ? x0.z : x0.x, c1 = hh ? x0.w : x0.y, p0 = hh ? xp.z : xp.x, p1 = hh ? xp.w : xp.y;
                    val[4 * hh + 0] = w0.x * bflo(m0) + w1.x * bflo(c0) + w2.x * bflo(p0);
                    val[4 * hh + 1] = w0.y * bfhi(m0) + w1.y * bfhi(c0) + w2.y * bfhi(p0);
                    val[4 * hh + 2] = w0.z * bflo(m1) + w1.z * bflo(c1) + w2.z * bflo(p1);
                    val[4 * hh + 3] = w0.w * bfhi(m1) + w1.w * bfhi(c1) + w2.w * bfhi(p1);
                }
                float ss = 0.f;
#pragma unroll
                for (int e = 0; e < 8; ++e) { val[e] = silu_(val[e]); ss += val[e] * val[e]; }
                if (part < 2) { ss = sum16(ss); const float sc = rsqrtf(ss + EPS) * (part == 0 ? 0.08838834764831845f : 1.f);
#pragma unroll
                    for (int e = 0; e < 8; ++e) val[e] *= sc; }
                u32x4 w; w.x = pk2(val[0], val[1]); w.y = pk2(val[2], val[3]); w.z = pk2(val[4], val[5]); w.w = pk2(val[6], val[7]);
                LAS bf16* dst = part == 0 ? QL : (part == 1 ? KL : VL);
                *(LAS u32x4*)(dst + i * 136 + cg * 8) = w;
                if (part < 2) { const int rb = (part == 0 ? 4 : 0) + (i >> 4), ks = cg >> 2, ln = (i & 15) + 16 * (cg & 3);
                    *(u32x4*)(pu + PO_KQ + ((rb * 4 + ks) * 64 + ln) * 16) = w; }
            }
#pragma unroll
            for (int e = 0; e < 6; ++e) { cwc[e] = cwn[e]; xc[e] = xn[e]; }
        }
#undef P3_LOAD
        if (wave < 2) {
            const int d = wave, row = rowbase + lane;
            const float bb = bf2f(P[(size_t)row * NPROJ + PC_BA + d * 4 + h]), aa = bf2f(P[(size_t)row * NPROJ + PC_BA + 8 + d * 4 + h]);
            const float beta = sigm(bb), xx = aa + dtb[d * 4 + h];
            const float sp = xx > 20.f ? xx : log1pf(expf(xx));
            float Gc = -expf(alog[d * 4 + h]) * sp;
#pragma unroll
            for (int o = 1; o < 64; o <<= 1) { const float up = __shfl_up(Gc, o), dn = __shfl_down(Gc, o);
                if (d == 0) { if (lane >= o) Gc += up; } else { if (lane + o < 64) Gc += dn; } }
            const float glast = __shfl(Gc, d == 0 ? 63 : 0);
            GV[d * 64 + lane] = Gc; GV[128 + d * 64 + lane] = beta;
            float* vd = vec + d * 256;
            vd[lane] = expf(Gc); vd[64 + lane] = beta; vd[128 + lane] = expf(glast - Gc); vd[192 + lane] = expf(glast);
        }
        __syncthreads();
#pragma unroll
        for (int jj = 0; jj < 4; ++jj) {
            const int job = wave * 4 + jj, mat = job >> 4, ti = (job >> 2) & 3, tj = job & 3;
            const LAS bf16* Ap = (mat == 0 ? KL : QL) + (ti * 16 + l16) * 136 + q4 * 8;
            const LAS bf16* Bp = KL + (tj * 16 + l16) * 136 + q4 * 8;
            f32x4 acc = (f32x4){0.f, 0.f, 0.f, 0.f};
#pragma unroll
            for (int ks = 0; ks < 4; ++ks) acc = __builtin_amdgcn_mfma_f32_16x16x32_bf16(*(const LAS bf16x8*)(Ap + ks * 32), *(const LAS bf16x8*)(Bp + ks * 32), acc, 0, 0, 0);
            const int j = tj * 16 + l16;
#pragma unroll
            for (int d = 0; d < 2; ++d) {
                const float Gj = GV[d * 64 + j];
#pragma unroll
                for (int r = 0; r < 4; ++r) { const int i = ti * 16 + 4 * q4 + r; const float Gi = GV[d * 64 + i];
                    const float dec = __expf(fminf(Gi - Gj, 0.f));
                    if (mat == 0) { const bool ok = d == 0 ? (j < i) : (j > i); const float v = ok ? GV[128 + d * 64 + i] * acc[r] * dec : 0.f;
                        const int ii = d == 0 ? i : 63 - i, jx = d == 0 ? j : 63 - j; AM[d * 4160 + ii * 65 + jx] = v; }
                    else { const bool ok = d == 0 ? (j <= i) : (j >= i); const float v = ok ? acc[r] * dec : 0.f; AT[d * 4608 + i * 72 + j] = (bf16)(pk2(v, 0.f) & 0xffffu); }
                }
            }
        }
        __syncthreads();
        if (wave < 2) {
            const int d = wave; LAS float* A = AM + d * 4160; LAS float* X = XM + d * 4160; LAS float* TW = TMPW + d * 272;
            for (int r = 0; r < 64; ++r) X[r * 65 + lane] = 0.f;
            LDS_WAIT();
            { const int blk = q4, c = l16; const LAS float* Ab = A + (blk * 16) * 65 + blk * 16; float xv[16];
#pragma unroll
                for (int r = 0; r < 16; ++r) { float s = (r == c) ? 1.f : 0.f;
#pragma unroll
                    for (int m = 0; m < r; ++m) s -= Ab[r * 65 + m] * xv[m];
                    xv[r] = s; }
#pragma unroll
                for (int r = 0; r < 16; ++r) X[(blk * 16 + r) * 65 + blk * 16 + c] = xv[r];
            }
            LDS_WAIT();
#pragma unroll
            for (int dd = 1; dd <= 3; ++dd)
#pragma unroll
                for (int a = dd; a <= 3; ++a) { const int bq = a - dd;
                    f32x4 acc = (f32x4){0.f, 0.f, 0.f, 0.f};
#pragma unroll
                    for (int cc2 = bq; cc2 < a; ++cc2)
#pragma unroll
                        for (int kk = 0; kk < 4; ++kk) { const float av = A[(a * 16 + l16) * 65 + cc2 * 16 + 4 * kk + q4], bv = X[(cc2 * 16 + 4 * kk + q4) * 65 + bq * 16 + l16];
                            acc = __builtin_amdgcn_mfma_f32_16x16x4f32(av, bv, acc, 0, 0, 0); }
#pragma unroll
                    for (int r = 0; r < 4; ++r) TW[(4 * q4 + r) * 17 + l16] = acc[r];
                    LDS_WAIT();
                    f32x4 acc2 = (f32x4){0.f, 0.f, 0.f, 0.f};
#pragma unroll
                    for (int kk = 0; kk < 4; ++kk) { const float av = X[(a * 16 + l16) * 65 + a * 16 + 4 * kk + q4], bv = TW[(4 * kk + q4) * 17 + l16];
                        acc2 = __builtin_amdgcn_mfma_f32_16x16x4f32(av, bv, acc2, 0, 0, 0); }
#pragma unroll
                    for (int r = 0; r < 4; ++r) X[(a * 16 + 4 * q4 + r) * 65 + bq * 16 + l16] = -acc2[r];
                    LDS_WAIT();
                }
        } else {
            const int t6 = tid - 128;
            for (int idx = t6; idx < 1024; idx += 384) { const int d = idx >> 9, e = idx & 511, rb = e >> 7, ks = (e >> 6) & 1, ln = e & 63, i = rb * 16 + (ln & 15), j0 = ks * 32 + (ln >> 4) * 8;
                *(u32x4*)(pu + PO_A + d * 8192 + e * 16) = *(const LAS u32x4*)(AT + d * 4608 + i * 72 + j0); }
            for (int e = t6; e < 1024; e += 384) { const int mb = e >> 7, ks = (e >> 6) & 1, ln = e & 63, m = mb * 16 + (ln & 15), kk0 = ks * 32 + (ln >> 4) * 8;
                unsigned short kv[8];
#pragma unroll
                for (int jj = 0; jj < 8; ++jj) kv[jj] = KL[(kk0 + jj) * 136 + m];
                u32x4 w; w.x = kv[0] | ((unsigned)kv[1] << 16); w.y = kv[2] | ((unsigned)kv[3] << 16); w.z = kv[4] | ((unsigned)kv[5] << 16); w.w = kv[6] | ((unsigned)kv[7] << 16);
                *(u32x4*)(pu + PO_KT + e * 16) = w; }
            for (int e = t6; e < 2048; e += 384) { const int nt = e >> 8, rb = (e >> 6) & 3, ln = e & 63, col = nt * 16 + (ln & 15), row0 = rb * 16 + 4 * (ln >> 4);
                const unsigned v0 = VL[(row0 + 0) * 136 + col], v1 = VL[(row0 + 1) * 136 + col], v2 = VL[(row0 + 2) * 136 + col], v3 = VL[(row0 + 3) * 136 + col];
                u32x2 w; w.x = v0 | (v1 << 16); w.y = v2 | (v3 << 16);
                *(u32x2*)(pu + PO_V + e * 8) = w; }
        }
        __syncthreads();
#pragma unroll
        for (int rep = 0; rep < 2; ++rep) { const int idx = rep * NTHR + tid, d = idx >> 9, e = idx & 511, rb = e >> 7, ks = (e >> 6) & 1, ln = e & 63, i = rb * 16 + (ln & 15), j0 = ks * 32 + (ln >> 4) * 8;
            float tv[8];
#pragma unroll
            for (int jj = 0; jj < 8; ++jj) tv[jj] = d == 0 ? XM[i * 65 + j0 + jj] : XM[4160 + (63 - i) * 65 + (63 - (j0 + jj))];
            u32x4 w; w.x = pk2(tv[0], tv[1]); w.y = pk2(tv[2], tv[3]); w.z = pk2(tv[4], tv[5]); w.w = pk2(tv[6], tv[7]);
            *(u32x4*)(pu + PO_T + d * 8192 + e * 16) = w;
        }
        __syncthreads();
    }
}

constexpr int SNT = 8;
constexpr size_t WS_SLOC = WS_R1 + 212 * MiB, WS_PMAT = WS_SLOC + 16 * MiB, WS_SST = WS_PMAT + 16 * MiB;
__device__ __forceinline__ int sb_lo(int j) { return j < 4 ? 17 * j : 68 + 16 * (j - 4); }
struct ScanRegs { bf16x8 kqA[4], kqB[4]; bf16x8 kt[2], ta[2]; f32x4 eg; float gl; u32x2 vv[SNT]; f32x4 be, kd; };
struct ScanAddr { const unsigned char* pu; const float* vd; };
__device__ __forceinline__ ScanAddr scan_addr(const unsigned char* ws, int d, int b, int h, int s) {
    const int cn = d == 0 ? s : (s < 4 ? 3 - s : 263 - s);
    const int u = (b * NCH + cn) * NH + h;
    ScanAddr a; a.pu = ws + WS_PREP + (size_t)u * PREP_UNIT; a.vd = (const float*)(ws + WS_VEC) + (size_t)u * 512 + d * 256; return a;
}
template <bool OUT> __device__ __forceinline__ void ld_kq(bf16x8 (&kq)[4], const ScanAddr& a, int w, int lane) {
    const int rb = OUT ? w : (w & 3);
#pragma unroll
    for (int ks = 0; ks < 4; ++ks) kq[ks] = *(const bf16x8*)(a.pu + PO_KQ + ((rb * 4 + ks) * 64 + lane) * 16);
}
template <bool HASV, bool OUT> __device__ __forceinline__ void ld_p1(ScanRegs& R, const ScanAddr& a, int w, int lane) {
    const int r0 = 16 * (w & 3) + 4 * (lane >> 4);
    R.eg = *(const f32x4*)(a.vd + r0); R.be = *(const f32x4*)(a.vd + 64 + r0);
    if (HASV) { const int nt0 = OUT ? 0 : 4 * (w >> 2);
#pragma unroll
        for (int i = 0; i < (OUT ? SNT : SNT / 2); ++i) R.vv[i] = *(const u32x2*)(a.pu + PO_V + (((nt0 + i) * 4 + (w & 3)) * 64 + lane) * 8); }
}
template <bool OUT> __device__ __forceinline__ void ld_ta(ScanRegs& R, const ScanAddr& a, int d, int w, int lane) {
    const int tao = ((OUT && w >= 4) ? PO_A : PO_T) + d * 8192;
#pragma unroll
    for (int ks = 0; ks < 2; ++ks) R.ta[ks] = *(const bf16x8*)(a.pu + tao + (((w & 3) * 2 + ks) * 64 + lane) * 16);
}
__device__ __forceinline__ void ld_p3(ScanRegs& R, const ScanAddr& a, int w, int lane) {
#pragma unroll
    for (int ks = 0; ks < 2; ++ks) R.kt[ks] = *(const bf16x8*)(a.pu + PO_KT + ((w * 2 + ks) * 64 + lane) * 16);
    R.gl = a.vd[192];
}
template <bool HASV, bool OUT, int PAR>
__device__ __forceinline__ void scan_step(ScanRegs& R, f32x4 (&S)[SNT], LAS bf16* ST, LAS bf16* TT, LAS bf16* VN, LAS bf16* VS, bf16* Od, int col0,
                                          const unsigned char* ws, int d, int b, int h, int s, int s1, int w, int lane) {
    constexpr int NTW = OUT ? SNT : SNT / 2;
    const int l16 = lane & 15, q4 = lane >> 4, rowo = 16 * (w & 3) + 4 * q4, nt0 = OUT ? 0 : 4 * (w >> 2);
    const bool kwave = !OUT || w < 4;
    const int sn1 = s + 1 < s1 ? s + 1 : s1 - 1, sn2 = s + 2 < s1 ? s + 2 : s1 - 1;
    const ScanAddr a1 = scan_addr(ws, d, b, h, sn1);
    bf16x8 (&kq)[4] = PAR ? R.kqB : R.kqA;
    bf16x8 fb[2][8];
    f32x4 a1v[NTW];
    {
#define RD1(c_) do { _Pragma("unroll") for (int i_ = 0; i_ < 8; ++i_) fb[(c_) & 1][i_] = *(const LAS bf16x8*)(ST + ((nt0 + 2 * (c_) + (i_ >> 2)) * 16 + l16) * 136 + (i_ & 3) * 32 + q4 * 8); } while (0)
        RD1(0);
#pragma unroll
        for (int c = 0; c < NTW / 2; ++c) {
            if (c + 1 < NTW / 2) RD1(c + 1);
            __builtin_amdgcn_sched_barrier(0);
#pragma unroll
            for (int j = 0; j < 2; ++j) { f32x4 acc = (f32x4){0.f, 0.f, 0.f, 0.f};
#pragma unroll
                for (int ks = 0; ks < 4; ++ks) acc = __builtin_amdgcn_mfma_f32_16x16x32_bf16(kq[ks], fb[c & 1][j * 4 + ks], acc, 0, 0, 0);
                a1v[2 * c + j] = acc; }
            __builtin_amdgcn_sched_barrier(0);
        }
#undef RD1
    }
    if (kwave) {
#pragma unroll
        for (int i = 0; i < NTW; ++i) { f32x4 t;
            if (HASV) { const f32x4 v = (f32x4){bflo(R.vv[i].x), bfhi(R.vv[i].x), bflo(R.vv[i].y), bfhi(R.vv[i].y)}; t = R.be * (v - R.eg * a1v[i]); }
            else t = R.be * (R.eg * a1v[i]) * -1.f;
            u32x2 pw; pw.x = pk2(t.x, t.y); pw.y = pk2(t.z, t.w); *(LAS u32x2*)(TT + ((nt0 + i) * 16 + l16) * 72 + rowo) = pw; }
    } else {
#pragma unroll
        for (int i = 0; i < NTW; ++i) a1v[i] = R.eg * a1v[i];
    }
    { const ScanAddr a2 = scan_addr(ws, d, b, h, sn2); ld_kq<OUT>(kq, a2, w, lane); ld_p1<HASV, OUT>(R, a1, w, lane); }
    __syncthreads();
#define RD2(BUF, t0_, c_) do { _Pragma("unroll") for (int i_ = 0; i_ < 8; ++i_) fb[(c_) & 1][i_] = *(const LAS bf16x8*)(BUF + (((t0_) + 4 * (c_) + (i_ >> 1)) * 16 + l16) * 72 + (i_ & 1) * 32 + q4 * 8); } while (0)
    if (kwave) {
        RD2(TT, nt0, 0);
#pragma unroll
        for (int c = 0; c < NTW / 4; ++c) {
            if (c + 1 < NTW / 4) RD2(TT, nt0, c + 1);
            __builtin_amdgcn_sched_barrier(0);
#pragma unroll
            for (int j = 0; j < 4; ++j) { const int nt = nt0 + 4 * c + j; f32x4 vn = (f32x4){0.f, 0.f, 0.f, 0.f};
#pragma unroll
                for (int ks = 0; ks < 2; ++ks) vn = __builtin_amdgcn_mfma_f32_16x16x32_bf16(R.ta[ks], fb[c & 1][j * 2 + ks], vn, 0, 0, 0);
                const f32x4 vs = R.kd * vn;
                u32x2 pw; pw.x = pk2(vn.x, vn.y); pw.y = pk2(vn.z, vn.w); *(LAS u32x2*)(VN + (nt * 16 + l16) * 72 + rowo) = pw;
                u32x2 ps; ps.x = pk2(vs.x, vs.y); ps.y = pk2(vs.z, vs.w); *(LAS u32x2*)(VS + (nt * 16 + l16) * 72 + rowo) = ps; }
            __builtin_amdgcn_sched_barrier(0);
        }
        ld_ta<OUT>(R, a1, d, w, lane); R.kd = *(const f32x4*)(a1.vd + 128 + rowo);
    }
    __syncthreads();
    if (!kwave) {
        RD2(VN, 0, 0);
#pragma unroll
        for (int c = 0; c < 2; ++c) {
            if (c + 1 < 2) RD2(VN, 0, c + 1);
            __builtin_amdgcn_sched_barrier(0);
#pragma unroll
            for (int j = 0; j < 4; ++j) { const int nt = 4 * c + j;
#pragma unroll
                for (int ks = 0; ks < 2; ++ks) a1v[nt < NTW ? nt : 0] = __builtin_amdgcn_mfma_f32_16x16x32_bf16(R.ta[ks], fb[c & 1][j * 2 + ks], a1v[nt < NTW ? nt : 0], 0, 0, 0); }
            __builtin_amdgcn_sched_barrier(0);
        }
        ld_ta<OUT>(R, a1, d, w, lane);
    }
    RD2(VS, 0, 0);
#pragma unroll
    for (int c = 0; c < 2; ++c) {
        if (c + 1 < 2) RD2(VS, 0, c + 1);
        __builtin_amdgcn_sched_barrier(0);
#pragma unroll
        for (int j = 0; j < 4; ++j) { const int nt = 4 * c + j; f32x4 sv = S[nt] * R.gl;
#pragma unroll
            for (int ks = 0; ks < 2; ++ks) sv = __builtin_amdgcn_mfma_f32_16x16x32_bf16(R.kt[ks], fb[c & 1][j * 2 + ks], sv, 0, 0, 0);
            S[nt] = sv;
            u32x2 pw; pw.x = pk2(sv.x, sv.y); pw.y = pk2(sv.z, sv.w); *(LAS u32x2*)(ST + (nt * 16 + l16) * 136 + 16 * w + 4 * q4) = pw; }
        __builtin_amdgcn_sched_barrier(0);
    }
#undef RD2
    ld_p3(R, a1, w, lane);
    if (OUT && w >= 4 && s >= 4) {
        const int n = d == 0 ? s - 4 : 259 - s, trow0 = b * SEQ + n * 64;
#pragma unroll
        for (int nt = 0; nt < NTW; ++nt)
#pragma unroll
            for (int r = 0; r < 4; ++r) Od[(size_t)(trow0 + rowo + r) * 512 + col0 + nt * 16 + l16] = (bf16)(pk2(a1v[nt][r], 0.f) & 0xffffu); }
    __syncthreads();
}
template <int KIND>
__device__ __forceinline__ void scan_run(const Fr& F, int chain, int j) {
    int tid_ = F.tid; asm volatile("" : "+v"(tid_));
    const int d = chain >> 3, b = (chain >> 2) & 1, h = chain & 3, w = __builtin_amdgcn_readfirstlane(tid_ >> 6), lane = tid_ & 63, l16 = lane & 15, q4 = lane >> 4;
    LAS bf16* ST = (LAS bf16*)F.lds; LAS bf16* TT = ST + SNT * 16 * 136; LAS bf16* VN = TT + SNT * 16 * 72; LAS bf16* VS = VN + SNT * 16 * 72;
    f32x4 S[SNT];
    const size_t sidx = ((size_t)chain * 16 + j) * 16384;
#pragma unroll
    for (int nt = 0; nt < SNT; ++nt) {
        if (KIND == 0) S[nt] = (f32x4){0.f, 0.f, 0.f, 0.f};
        else if (KIND == 1) { const int col = nt * 16 + l16;
#pragma unroll
            for (int r = 0; r < 4; ++r) S[nt][r] = (16 * w + 4 * q4 + r == col) ? 1.f : 0.f; }
        else S[nt] = j == 0 ? (f32x4){0.f, 0.f, 0.f, 0.f} : *(const f32x4*)(WSP(float, WS_SST) + sidx + ((nt * 8 + w) * 64 + lane) * 4);
        u32x2 pw; pw.x = pk2(S[nt].x, S[nt].y); pw.y = pk2(S[nt].z, S[nt].w); *(LAS u32x2*)(ST + (nt * 16 + l16) * 136 + 16 * w + 4 * q4) = pw; }
    __syncthreads();
    bf16* Od = WSP(bf16, WS_O) + (size_t)d * T * 512; const int col0 = h * 128;
    const int s0 = sb_lo(j), s1 = sb_lo(j + 1);
    ScanRegs R;
    { const ScanAddr a0 = scan_addr(F.ws, d, b, h, s0), a1 = scan_addr(F.ws, d, b, h, s0 + 1 < s1 ? s0 + 1 : s1 - 1);
        ld_kq<KIND == 2>(R.kqA, a0, w, lane); ld_p1<KIND != 1, KIND == 2>(R, a0, w, lane); ld_ta<KIND == 2>(R, a0, d, w, lane); R.kd = *(const f32x4*)(a0.vd + 128 + 16 * (w & 3) + 4 * q4); ld_p3(R, a0, w, lane);
        ld_kq<KIND == 2>(R.kqB, a1, w, lane); }
    for (int s = s0; s < s1; s += 2) {
        scan_step<KIND != 1, KIND == 2, 0>(R, S, ST, TT, VN, VS, Od, col0, F.ws, d, b, h, s, s1, w, lane);
        if (s + 1 < s1) scan_step<KIND != 1, KIND == 2, 1>(R, S, ST, TT, VN, VS, Od, col0, F.ws, d, b, h, s + 1, s1, w, lane);
    }
    if (KIND == 0) {
#pragma unroll
        for (int nt = 0; nt < SNT; ++nt) *(f32x4*)(WSP(float, WS_SLOC) + sidx + ((nt * 8 + w) * 64 + lane) * 4) = S[nt];
    } else if (KIND == 1) { bf16* Pm = WSP(bf16, WS_PMAT) + sidx;
#pragma unroll
        for (int nt = 0; nt < SNT; ++nt)
#pragma unroll
            for (int r = 0; r < 4; ++r) Pm[(16 * w + 4 * q4 + r) * 128 + nt * 16 + l16] = (bf16)(pk2(S[nt][r], 0.f) & 0xffffu);
    }
    __syncthreads();
}
__device__ __forceinline__ void scan_combine(const Fr& F, int cu) {
    const int chain = cu >> 3, nt = cu & 7, w = F.wave, lane = F.lane, l16 = lane & 15, q4 = lane >> 4;
    LAS bf16* ST = (LAS bf16*)F.lds;
    f32x4 S = (f32x4){0.f, 0.f, 0.f, 0.f};
    { u32x2 z; z.x = 0u; z.y = 0u; *(LAS u32x2*)(ST + l16 * 136 + 16 * w + 4 * q4) = z; }
    __syncthreads();
    bf16x8 pa[4]; f32x4 sl;
#define SC2_LOAD(j_) do { const size_t si_ = ((size_t)chain * 16 + (j_)) * 16384; const bf16* Pm_ = WSP(bf16, WS_PMAT) + si_; \
        _Pragma("unroll") for (int ks = 0; ks < 4; ++ks) pa[ks] = *(const bf16x8*)(Pm_ + (16 * w + l16) * 128 + ks * 32 + q4 * 8); \
        sl = *(const f32x4*)(WSP(float, WS_SLOC) + si_ + ((nt * 8 + w) * 64 + lane) * 4); } while (0)
    SC2_LOAD(0);
    for (int j = 0; j < 15; ++j) {
        f32x4 acc = sl;
#pragma unroll
        for (int ks = 0; ks < 4; ++ks) acc = __builtin_amdgcn_mfma_f32_16x16x32_bf16(pa[ks], *(const LAS bf16x8*)(ST + l16 * 136 + ks * 32 + q4 * 8), acc, 0, 0, 0);
        S = acc;
        if (j + 1 < 15) SC2_LOAD(j + 1);
        *(f32x4*)(WSP(float, WS_SST) + ((size_t)chain * 16 + j + 1) * 16384 + ((nt * 8 + w) * 64 + lane) * 4) = S;
        __syncthreads();
        { u32x2 pw; pw.x = pk2(S.x, S.y); pw.y = pk2(S.z, S.w); *(LAS u32x2*)(ST + l16 * 136 + 16 * w + 4 * q4) = pw; }
        __syncthreads();
    }
#undef SC2_LOAD
}
__device__ __forceinline__ void p4_sgu(const Fr& F, int worker, int nworkers, int u_lo, int u_hi) {
    const bf16* P = WSP(bf16, WS_P); bf16* MIX = WSP(bf16, WS_MIX);
    const float* lng = F.in[12]; const float* lnb = F.in[13]; const float* sw = F.in[14]; const float* sb = F.in[15];
    LAS bf16* VT = (LAS bf16*)F.lds;
    for (int u = u_lo + worker; u < u_hi; u += nworkers) {
        int tid = F.tid; asm volatile("" : "+v"(tid));
        const int lane = tid & 63, wave = __builtin_amdgcn_readfirstlane(tid >> 6), l16 = lane & 15, q4 = lane >> 4;
        const int g = u & 3, ch = u >> 2, row00 = ch * 128;
#pragma unroll
        for (int it = 0; it < 4; ++it) { const int item = it * NTHR + tid, cg = item & 15, row = item >> 4;
            const u32x4 xv = *(const u32x4*)(P + (size_t)(row00 + row) * NPROJ + PC_V + g * 128 + cg * 8);
            float v[8]; v[0] = bflo(xv.x); v[1] = bfhi(xv.x); v[2] = bflo(xv.y); v[3] = bfhi(xv.y); v[4] = bflo(xv.z); v[5] = bfhi(xv.z); v[6] = bflo(xv.w); v[7] = bfhi(xv.w);
            float s = 0.f;
#pragma unroll
            for (int e = 0; e < 8; ++e) { v[e] = gelu_t(v[e]); s += v[e]; }
            const float mean = sum16(s) * (1.f / 128.f); float q = 0.f;
#pragma unroll
            for (int e = 0; e < 8; ++e) { v[e] -= mean; q += v[e] * v[e]; }
            const float rstd = rsqrtf(sum16(q) * (1.f / 128.f) + EPS);
#pragma unroll
            for (int e = 0; e < 8; ++e) { const int c = cg * 8 + e; const float y = v[e] * rstd * lng[g * 128 + c] + lnb[g * 128 + c]; VT[c * 136 + ((((row >> 3) ^ cg) << 3) | (row & 7))] = (bf16)(pk2(y, 0.f) & 0xffffu); }
        }
        __syncthreads();
        bf16x8 wf[4];
#pragma unroll
        for (int ks = 0; ks < 4; ++ks) { const float* wp = sw + (size_t)g * 16384 + (wave * 16 + l16) * 128 + ks * 32 + q4 * 8; const f32x4 a = *(const f32x4*)wp, bq = *(const f32x4*)(wp + 4);
            u32x4 t; t.x = pk2(a.x, a.y); t.y = pk2(a.z, a.w); t.z = pk2(bq.x, bq.y); t.w = pk2(bq.z, bq.w); wf[ks] = __builtin_bit_cast(bf16x8, t); }
        const int prow = wave * 16 + l16; const float bs = sb[g * 128 + prow];
        u32x2 uq[8];
#pragma unroll
        for (int ct = 0; ct < 8; ++ct) uq[ct] = *(const u32x2*)(P + (size_t)(row00 + prow) * NPROJ + PC_U + g * 128 + ct * 16 + 4 * q4);
#pragma unroll
        for (int ct = 0; ct < 8; ++ct) { f32x4 acc = (f32x4){0.f, 0.f, 0.f, 0.f};
#pragma unroll
            for (int ks = 0; ks < 4; ++ks) acc = __builtin_amdgcn_mfma_f32_16x16x32_bf16(*(const LAS bf16x8*)(VT + (ct * 16 + l16) * 136 + (((ks * 4 + q4) ^ (ct * 2 + (l16 >> 3))) << 3)), wf[ks], acc, 0, 0, 0);
            const int c0 = ct * 16 + 4 * q4;
            const u32x2 uv = uq[ct];
            const float o0 = gelu_t(bflo(uv.x)) * (acc[0] + bs), o1 = gelu_t(bfhi(uv.x)) * (acc[1] + bs), o2 = gelu_t(bflo(uv.y)) * (acc[2] + bs), o3 = gelu_t(bfhi(uv.y)) * (acc[3] + bs);
            u32x2 w; w.x = pk2(o0, o1); w.y = pk2(o2, o3); if (DBG_MODE == 3) w = (u32x2){0u, 0u}; *(u32x2*)(MIX + (size_t)(row00 + prow) * D + 512 + g * 128 + c0) = w; }
        __syncthreads();
    }
}

__device__ __forceinline__ void p5_gdn_out(const Fr& F) {
    const bf16* P = WSP(bf16, WS_P); const bf16* O = WSP(bf16, WS_O); bf16* MIX = WSP(bf16, WS_MIX); const float* gng = F.in[11];
    const int gw = F.wg * NWAVES + F.wave, NGW = F.G * NWAVES, lane = F.lane;
    const f32x4 g0 = *(const f32x4*)(gng + (lane & 15) * 8), g1 = *(const f32x4*)(gng + (lane & 15) * 8 + 4);
    const float gg[8] = {g0.x, g0.y, g0.z, g0.w, g1.x, g1.y, g1.z, g1.w};
    for (int blk = gw; blk < T / 16; blk += NGW) {
        const int t0 = blk * 16;
        u32x4 a = *(const u32x4*)(O + (size_t)t0 * 512 + lane * 8), bq = *(const u32x4*)(O + (size_t)(T + t0) * 512 + lane * 8), z = *(const u32x4*)(P + (size_t)t0 * NPROJ + PC_Z + lane * 8);
#pragma clang loop unroll(disable)
        for (int i = 0; i < 16; ++i) {
            const int t = t0 + i, tn = t0 + (i + 1 < 16 ? i + 1 : i);
            const u32x4 an = *(const u32x4*)(O + (size_t)tn * 512 + lane * 8), bn = *(const u32x4*)(O + (size_t)(T + tn) * 512 + lane * 8), zn = *(const u32x4*)(P + (size_t)tn * NPROJ + PC_Z + lane * 8);
            float o[8]; o[0] = bflo(a.x) + bflo(bq.x); o[1] = bfhi(a.x) + bfhi(bq.x); o[2] = bflo(a.y) + bflo(bq.y); o[3] = bfhi(a.y) + bfhi(bq.y);
            o[4] = bflo(a.z) + bflo(bq.z); o[5] = bfhi(a.z) + bfhi(bq.z); o[6] = bflo(a.w) + bflo(bq.w); o[7] = bfhi(a.w) + bfhi(bq.w);
            float ss = 0.f;
#pragma unroll
            for (int e = 0; e < 8; ++e) ss += o[e] * o[e];
            const float rstd = rsqrtf(sum16(ss) * (1.f / 128.f) + EPS);
            const float zz[8] = {bflo(z.x), bfhi(z.x), bflo(z.y), bfhi(z.y), bflo(z.z), bfhi(z.z), bflo(z.w), bfhi(z.w)};
            float r[8];
#pragma unroll
            for (int e = 0; e < 8; ++e) r[e] = o[e] * rstd * gg[e] * silu_(zz[e]);
            u32x4 w; w.x = pk2(r[0], r[1]); w.y = pk2(r[2], r[3]); w.z = pk2(r[4], r[5]); w.w = pk2(r[6], r[7]);
            if (DBG_MODE == 2) w = (u32x4){0u, 0u, 0u, 0u};
            *(u32x4*)(MIX + (size_t)t * D + lane * 8) = w;
            a = an; bq = bn; z = zn;
        }
    }
}

__device__ __forceinline__ void p7_mid(const Fr& F) {
    const float* x = F.in[0]; const float* ng = F.in[6]; const float* MOD = WSP(float, WS_MOD); const bf16* R = WSP(bf16, WS_R); const float* rbias = F.in[18];
    bf16* X1 = WSP(bf16, WS_X1); unsigned char* H2 = WSP(unsigned char, WS_H2);
    LAS bf16* HI = (LAS bf16*)F.lds; LAS bf16* LO = HI + 16 * 1032; LAS float* PART = (LAS float*)(F.lds + 66048);
    LAS int* ENT_E = (LAS int*)(F.lds + 83968); LAS int* ENT_R = ENT_E + 1024; LAS int* CNT = ENT_R + 1024; LAS int* BASE = CNT + 32;
    const int tid = F.tid, lane = F.lane, wave = F.wave, l16 = lane & 15, q4 = lane >> 4;
    if (tid < 32) CNT[tid] = 0;
    { int* RT = WSP(int, WS_ROWTOK); const int per = (MAXROWS + F.G - 1) / F.G; for (int i = tid; i < per; i += NTHR) { const int r = F.wg * per + i; if (r < MAXROWS) RT[r] = 0; } }
    const int TPW = T / F.G, t0 = F.wg * TPW;
    LAS float* AV = (LAS float*)(F.lds + 92672); LAS float* BV = AV + 1024; LAS float* CV = BV + 1024;
    { const float* mb = MOD + (t0 >> 14) * 6144;
        for (int k = tid; k < 1024; k += NTHR) { AV[k] = mb[2048 + k] * ng[1024 + k]; BV[k] = ng[2048 + k] * (mb[4096 + k] + 1.f); CV[k] = mb[3072 + k]; } }
    const float my_rbias = rbias[tid & 31];
    bf16x8 wh[4][2], wl[4][2];
    { const float* WRT = WSP(float, WS_WRT);
#pragma unroll
        for (int ks = 0; ks < 4; ++ks)
#pragma unroll
            for (int nt = 0; nt < 2; ++nt) { const float* wp = WRT + (size_t)(nt * 16 + l16) * 1024 + wave * 128 + ks * 32 + q4 * 8; const f32x4 a = *(const f32x4*)wp, b = *(const f32x4*)(wp + 4);
                u32x4 h; h.x = pk2(a.x, a.y); h.y = pk2(a.z, a.w); h.z = pk2(b.x, b.y); h.w = pk2(b.z, b.w);
                u32x4 l; l.x = pk2(a.x - bflo(h.x), a.y - bfhi(h.x)); l.y = pk2(a.z - bflo(h.y), a.w - bfhi(h.y)); l.z = pk2(b.x - bflo(h.z), b.y - bfhi(h.z)); l.w = pk2(b.z - bflo(h.w), b.w - bfhi(h.w));
                wh[ks][nt] = __builtin_bit_cast(bf16x8, h); wl[ks][nt] = __builtin_bit_cast(bf16x8, l); } }
    __syncthreads();
    u32x2 rq[2][4]; f32x4 xq[2][4];
#define P7_LOAD(tile_) do { _Pragma("unroll") for (int sub_ = 0; sub_ < 2; ++sub_) { const int t_ = t0 + (tile_) * 16 + 2 * wave + sub_; \
        _Pragma("unroll") for (int j_ = 0; j_ < 4; ++j_) { rq[sub_][j_] = *(const u32x2*)(R + (size_t)t_ * D + 256 * j_ + 4 * lane); xq[sub_][j_] = *(const f32x4*)(x + (size_t)t_ * D + 256 * j_ + 4 * lane); } } } while (0)
    P7_LOAD(0);
    for (int tile = 0; tile < TPW / 16; ++tile) {
        f32x4 hq[2][4];
#pragma unroll
        for (int sub = 0; sub < 2; ++sub) {
            f32x4 rv[4]; float ss = 0.f;
#pragma unroll
            for (int j = 0; j < 4; ++j) { const u32x2 rw = rq[sub][j]; rv[j] = (f32x4){bflo(rw.x), bfhi(rw.x), bflo(rw.y), bfhi(rw.y)};
                ss += (rv[j].x * rv[j].x + rv[j].y * rv[j].y) + (rv[j].z * rv[j].z + rv[j].w * rv[j].w); }
            const float rstd1 = rsqrtf(wave_sum(ss) * (1.f / D) + EPS);
            f32x4 xv[4]; float s2 = 0.f;
#pragma unroll
            for (int j = 0; j < 4; ++j) { const int k = 256 * j + 4 * lane; const f32x4 av = *(const LAS f32x4*)(AV + k);
                xv[j] = xq[sub][j] + av * (rv[j] * rstd1);
                s2 += (xv[j].x * xv[j].x + xv[j].y * xv[j].y) + (xv[j].z * xv[j].z + xv[j].w * xv[j].w); }
            const float rstd2 = rsqrtf(wave_sum(s2) * (1.f / D) + EPS);
#pragma unroll
            for (int j = 0; j < 4; ++j) { const int k = 256 * j + 4 * lane; const f32x4 bv = *(const LAS f32x4*)(BV + k), cv = *(const LAS f32x4*)(CV + k);
                hq[sub][j] = xv[j] * rstd2 * bv + cv; xq[sub][j] = xv[j]; }
        }
#pragma unroll
        for (int sub = 0; sub < 2; ++sub) { const int tr = 2 * wave + sub, t = t0 + tile * 16 + tr;
#pragma unroll
            for (int j = 0; j < 4; ++j) { const int k = 256 * j + 4 * lane; const f32x4 hv = hq[sub][j];
                { u32x2 x1w; x1w.x = pk2(xq[sub][j].x, xq[sub][j].y); x1w.y = pk2(xq[sub][j].z, xq[sub][j].w); *(u32x2*)(X1 + (size_t)t * D + k) = x1w; }
                u32x2 o; o.x = pk2(hv.x, hv.y); o.y = pk2(hv.z, hv.w); *(unsigned*)(H2 + (size_t)t * D + k) = pk_fp8x4(hv.x, hv.y, hv.z, hv.w);
                u32x2 lo; lo.x = pk2(hv.x - bflo(o.x), hv.y - bfhi(o.x)); lo.y = pk2(hv.z - bflo(o.y), hv.w - bfhi(o.y));
                *(LAS u32x2*)(HI + tr * 1032 + k) = o; *(LAS u32x2*)(LO + tr * 1032 + k) = lo; } }
        if (tile + 1 < TPW / 16) P7_LOAD(tile + 1);
        __syncthreads();
        { f32x4 acc[2]; acc[0] = (f32x4){0.f, 0.f, 0.f, 0.f}; acc[1] = acc[0];
#pragma unroll
            for (int ks = 0; ks < 4; ++ks) { const int ko = l16 * 1032 + wave * 128 + ks * 32 + q4 * 8;
                const bf16x8 ah = *(const LAS bf16x8*)(HI + ko), al = *(const LAS bf16x8*)(LO + ko);
#pragma unroll
                for (int nt = 0; nt < 2; ++nt) { acc[nt] = __builtin_amdgcn_mfma_f32_16x16x32_bf16(ah, wh[ks][nt], acc[nt], 0, 0, 0);
                    acc[nt] = __builtin_amdgcn_mfma_f32_16x16x32_bf16(al, wh[ks][nt], acc[nt], 0, 0, 0);
                    acc[nt] = __builtin_amdgcn_mfma_f32_16x16x32_bf16(ah, wl[ks][nt], acc[nt], 0, 0, 0); } }
#pragma unroll
            for (int nt = 0; nt < 2; ++nt)
#pragma unroll
                for (int r = 0; r < 4; ++r) PART[(wave * 16 + 4 * q4 + r) * 33 + nt * 16 + l16] = acc[nt][r]; }
        __syncthreads();
        { const int tok = tid >> 5, me = tid & 31, t = t0 + tile * 16 + tok;
            float logit = my_rbias;
#pragma unroll
            for (int w = 0; w < 8; ++w) logit += PART[(w * 16 + tok) * 33 + me];
            float tv[4]; int ti[4];
#pragma unroll
            for (int k = 0; k < 4; ++k) { float bv = logit; int bi = me;
#define P7_AMAX(OV, OI) do { const float ov_ = (OV); const int oi_ = (OI); const bool tk_ = (ov_ > bv) | ((ov_ == bv) & (oi_ < bi)); bv = tk_ ? ov_ : bv; bi = tk_ ? oi_ : bi; } while (0)
                P7_AMAX(DPP_MOV(bv, 0xB1), __builtin_amdgcn_update_dpp(0, bi, 0xB1, 0xf, 0xf, true));
                P7_AMAX(DPP_MOV(bv, 0x4E), __builtin_amdgcn_update_dpp(0, bi, 0x4E, 0xf, 0xf, true));
                P7_AMAX(DPP_MOV(bv, 0x124), __builtin_amdgcn_update_dpp(0, bi, 0x124, 0xf, 0xf, true));
                P7_AMAX(DPP_MOV(bv, 0x128), __builtin_amdgcn_update_dpp(0, bi, 0x128, 0xf, 0xf, true));
                P7_AMAX(__shfl_xor(bv, 16), __shfl_xor(bi, 16));
#undef P7_AMAX
                tv[k] = bv; ti[k] = bi; if (me == bi) logit = -3.0e38f; }
            const float e1 = __expf(tv[1] - tv[0]), e2 = __expf(tv[2] - tv[0]), e3 = __expf(tv[3] - tv[0]), inv = 1.f / (1.f + e1 + e2 + e3);
            if (me == 0) { const float gt[4] = {inv, e1 * inv, e2 * inv, e3 * inv}; float* TG = WSP(float, WS_TKGATE); const int tl = tile * 16 + tok;
#pragma unroll
                for (int k = 0; k < 4; ++k) { const int rk = atomicAdd((int*)&CNT[ti[k]], 1); ENT_E[tl * 4 + k] = ti[k]; ENT_R[tl * 4 + k] = rk; TG[(size_t)t * 4 + k] = gt[k]; } }
        }
    }
#undef P7_LOAD
    __syncthreads();
    if (tid < 32) BASE[tid] = (int)__hip_atomic_fetch_add(WSP(unsigned, WS_CTL) + CW_GCNT + 64 * tid, (unsigned)CNT[tid], __ATOMIC_RELAXED, __HIP_MEMORY_SCOPE_AGENT);
    __syncthreads();
    int* TE = WSP(int, WS_TKE); int* TR = WSP(int, WS_TKRANK);
    for (int i = tid; i < TPW * 4; i += NTHR) { const int e = ENT_E[i]; TE[(size_t)t0 * 4 + i] = e; TR[(size_t)t0 * 4 + i] = BASE[e] + ENT_R[i]; }
}

__device__ __forceinline__ void moe_tables(const Fr& F) {
    LAS int* NPL = (LAS int*)(F.lds + LDS_TAB); LAS int* RB = NPL + 32; LAS int* NPAN = NPL + 64; LAS int* PEXP = NPL + 128;
    if (F.tid < 32) NPL[F.tid] = ((int)__hip_atomic_load(WSP(unsigned, WS_CTL) + CW_GCNT + 64 * F.tid, __ATOMIC_RELAXED, __HIP_MEMORY_SCOPE_AGENT) + 255) >> 8;
    __syncthreads();
    if (F.tid < 32) { int s = 0; for (int e = 0; e < F.tid; ++e) s += NPL[e]; RB[F.tid] = s * 256; if (F.tid == 31) NPAN[0] = s + NPL[31];
        const int np = NPL[F.tid]; for (int p = 0; p < np; ++p) if (s + p < MAXPAN) PEXP[s + p] = F.tid; }
    __syncthreads();
}
__device__ __forceinline__ void p8_permute(const Fr& F) {
    moe_tables(F);
    const LAS int* RB = (const LAS int*)(F.lds + LDS_TAB) + 32;
    const int* TE = WSP(int, WS_TKE); const int* TR = WSP(int, WS_TKRANK); const float* TG = WSP(float, WS_TKGATE); int* TROW = WSP(int, WS_TKROW); float* RG = WSP(float, WS_ROWGATE);
    int* RT = WSP(int, WS_ROWTOK);
    const int gw = F.wg * NWAVES + F.wave, NGW = F.G * NWAVES, lane = F.lane;
    for (int blk = gw; blk < T / 16; blk += NGW) {
        const size_t a0 = (size_t)blk * 64;
        const int e = TE[a0 + lane]; int row = RB[e] + TR[a0 + lane]; row = row < MAXROWS ? row : MAXROWS - 1;
        TROW[a0 + lane] = row; RG[row] = TG[a0 + lane]; RT[row] = blk * 16 + (lane >> 2);
    }
}
struct MoeOrder {
    int nM, nN, nwg, G, c; const LAS int* pexp;
    __device__ __forceinline__ void init(int nM_, int nN_, int G_, int c_, const LAS int* pexp_) { nM = nM_; nN = nN_; nwg = nM * nN; G = G_; c = c_; pexp = pexp_; }
    __device__ __forceinline__ bool next(int i, pg8::Unit& u) const {
        const long L = (long)i * G + c; if (L >= nwg) return false;
        int wgid = (int)L; { const int q = nwg / pg8::NXCD, r = nwg % pg8::NXCD, xcd = wgid % pg8::NXCD, off = wgid / pg8::NXCD; wgid = (xcd < r ? xcd * (q + 1) : r * (q + 1) + (xcd - r) * q) + off; }
        const int nig = pg8::WGM * nN, gid = wgid / nig, fm = gid * pg8::WGM, gsz = (nM - fm) < pg8::WGM ? (nM - fm) : pg8::WGM;
        u.pm = fm + ((wgid % nig) % gsz); u.pn = pexp[u.pm] * nN + (wgid % nig) / gsz; return true;
    }
    __device__ __forceinline__ void a_ready(const pg8::Unit&) const {}
    __device__ __forceinline__ void done(const pg8::Unit&) const {}
};
struct EpiStore {
    static constexpr bool PERM = true, AFTER_DRAIN = false;
    bf16* O; int ldc;
    __device__ __forceinline__ void operator()(const pg8::f32x4 (&acc)[2][2][4][2], const pg8::Unit& u, int wr, int wc, int fr, int fq) const {
        const int row0 = u.pm * 256 + wr * 64 + fr, col0 = u.pn * 256 + wc * 32 + 8 * fq;
#pragma unroll
        for (int ai = 0; ai < 2; ++ai)
#pragma unroll
            for (int m = 0; m < 4; ++m) { bf16* rowp = O + (size_t)(row0 + ai * 128 + m * 16) * ldc + col0;
#pragma unroll
                for (int bj = 0; bj < 2; ++bj) { const pg8::f32x4 v0 = acc[ai][bj][m][0], v1 = acc[ai][bj][m][1];
                    u32x4 w; w.x = pk2(v0[0], v0[1]); w.y = pk2(v0[2], v0[3]); w.z = pk2(v1[0], v1[1]); w.w = pk2(v1[2], v1[3]);
                    *(u32x4*)(rowp + bj * 128) = w; } }
    }
};
struct EpiSwiGLU {
    static constexpr bool PERM = false, AFTER_DRAIN = false;
    unsigned char* ACT; const float* bias;
    __device__ __forceinline__ void operator()(const pg8::f32x4 (&acc)[2][2][4][2], const pg8::Unit& u, int wr, int wc, int fr, int fq) const {
        const int e = u.pn >> 3, pnl = u.pn & 7, row0 = u.pm * 256 + wr * 64 + fr;
        const float* bb = bias + e * 2048 + pnl * 256 + wc * 32 + 4 * fq;
        pg8::f32x4 bg[2], bu[2];
#pragma unroll
        for (int bj = 0; bj < 2; ++bj) { bg[bj] = *(const pg8::f32x4*)(bb + bj * 128); bu[bj] = *(const pg8::f32x4*)(bb + bj * 128 + 16); }
#pragma unroll
        for (int ai = 0; ai < 2; ++ai)
#pragma unroll
            for (int m = 0; m < 4; ++m) { float a[8];
#pragma unroll
                for (int bj = 0; bj < 2; ++bj) { const pg8::f32x4 gv = acc[ai][bj][m][0] * W8_INV + bg[bj], uv = acc[ai][bj][m][1] * W8_INV + bu[bj];
#pragma unroll
                    for (int j = 0; j < 4; ++j) { const float gt = fminf(gv[j], 7.f), up = fminf(fmaxf(uv[j], -7.f), 7.f); a[4 * bj + j] = (up + 1.f) * gt * frcp(1.f + __expf(-1.702f * gt)); } }
                u32x2 w; w.x = pk_fp8x4(a[0], a[1], a[2], a[3]); w.y = pk_fp8x4(a[4], a[5], a[6], a[7]);
                *(u32x2*)(ACT + (size_t)(row0 + ai * 128 + m * 16) * D + pnl * 128 + wc * 32 + 8 * fq) = w; }
    }
};
constexpr float Y8_SCALE = 16.f, Y8_INV = 1.f / 16.f;
struct EpiDown {
    static constexpr bool PERM = true, AFTER_DRAIN = false;
    unsigned char* Y; const float* bias; const float* rowgate;
    __device__ __forceinline__ void operator()(const pg8::f32x4 (&acc)[2][2][4][2], const pg8::Unit& u, int wr, int wc, int fr, int fq) const {
        const int e = u.pn >> 2, pnl = u.pn & 3, row0 = u.pm * 256 + wr * 64 + fr, col0 = pnl * 256 + wc * 32 + 8 * fq;
        pg8::f32x4 bv[2][2];
#pragma unroll
        for (int bj = 0; bj < 2; ++bj)
#pragma unroll
            for (int n = 0; n < 2; ++n) bv[bj][n] = *(const pg8::f32x4*)(bias + e * 1024 + col0 + bj * 128 + 4 * n);
#pragma unroll
        for (int ai = 0; ai < 2; ++ai)
#pragma unroll
            for (int m = 0; m < 4; ++m) { const int row = row0 + ai * 128 + m * 16; const float gt = rowgate[row] * Y8_SCALE; unsigned char* rowp = Y + (size_t)row * D + col0;
#pragma unroll
                for (int bj = 0; bj < 2; ++bj) { const pg8::f32x4 v0 = (acc[ai][bj][m][0] * W8_INV + bv[bj][0]) * gt, v1 = (acc[ai][bj][m][1] * W8_INV + bv[bj][1]) * gt;
                    u32x2 w; w.x = pk_fp8x4(v0[0], v0[1], v0[2], v0[3]); w.y = pk_fp8x4(v1[0], v1[1], v1[2], v1[3]);
                    *(u32x2*)(rowp + bj * 128) = w; } }
    }
};
__device__ __forceinline__ void p11_final(const Fr& F) {
    const float* ng = F.in[6]; const float* MOD = WSP(float, WS_MOD); const bf16* X1 = WSP(bf16, WS_X1); const unsigned char* Y = WSP(unsigned char, WS_Y); const int* TROW = WSP(int, WS_TKROW);
    const int gw = F.wg * NWAVES + F.wave, NGW = F.G * NWAVES, lane = F.lane;
    typedef float f32x2_ __attribute__((ext_vector_type(2)));
    for (int blk = gw; blk < T / 16; blk += NGW) {
        const int t0 = blk * 16, b = t0 >> 14; const float* mb = MOD + b * 6144 + 5120;
        const int myrow = TROW[(size_t)t0 * 4 + lane];
        f32x4 gm[4];
#pragma unroll
        for (int j = 0; j < 4; ++j) { const int k = 256 * j + 4 * lane; gm[j] = *(const f32x4*)(ng + 3072 + k) * *(const f32x4*)(mb + k); }
        int yq0[4][4], yq1[4][4]; u32x2 xq0[4], xq1[4];
#define P11_LOAD(YQ, XQ, tk_) do { _Pragma("unroll") for (int k_ = 0; k_ < 4; ++k_) { const int row_ = __builtin_amdgcn_readlane(myrow, 4 * (tk_) + k_); \
            _Pragma("unroll") for (int j_ = 0; j_ < 4; ++j_) YQ[k_][j_] = *(const int*)(Y + (size_t)row_ * D + 256 * j_ + 4 * lane); } \
            _Pragma("unroll") for (int j_ = 0; j_ < 4; ++j_) XQ[j_] = *(const u32x2*)(X1 + (size_t)(t0 + (tk_)) * D + 256 * j_ + 4 * lane); } while (0)
#define P11_DO(YQ, XQ, tk_) do { f32x4 y[4]; \
            _Pragma("unroll") for (int j = 0; j < 4; ++j) y[j] = (f32x4){0.f, 0.f, 0.f, 0.f}; \
            _Pragma("unroll") for (int k = 0; k < 4; ++k) _Pragma("unroll") for (int j = 0; j < 4; ++j) { const int w = YQ[k][j]; const f32x2_ lo = __builtin_amdgcn_cvt_pk_f32_fp8(w, false), hi = __builtin_amdgcn_cvt_pk_f32_fp8(w, true); y[j] += (f32x4){lo.x, lo.y, hi.x, hi.y}; } \
            float ss = 0.f; \
            _Pragma("unroll") for (int j = 0; j < 4; ++j) { y[j] = y[j] * Y8_INV; ss += (y[j].x * y[j].x + y[j].y * y[j].y) + (y[j].z * y[j].z + y[j].w * y[j].w); } \
            const float rstd = rsqrtf(wave_sum(ss) * (1.f / D) + EPS); \
            _Pragma("unroll") for (int j = 0; j < 4; ++j) { const int k = 256 * j + 4 * lane; const u32x2 xw = XQ[j]; const f32x4 x1 = (f32x4){bflo(xw.x), bfhi(xw.x), bflo(xw.y), bfhi(xw.y)}; \
                *(f32x4*)(F.out + (size_t)(t0 + (tk_)) * D + k) = (DBG_MODE >= 1) ? x1 : x1 + gm[j] * (y[j] * rstd); } } while (0)
        P11_LOAD(yq0, xq0, 0);
#pragma clang loop unroll(disable)
        for (int tk = 0; tk < 16; tk += 2) {
            P11_LOAD(yq1, xq1, tk + 1);
            P11_DO(yq0, xq0, tk);
            if (tk + 2 < 16) P11_LOAD(yq0, xq0, tk + 2);
            P11_DO(yq1, xq1, tk + 1);
        }
#undef P11_DO
#undef P11_LOAD
    }
}

struct Args { const float* in[23]; float* out; unsigned char* ws; int ph_lo, ph_hi; };
__global__ void __launch_bounds__(NTHR, 2) mk_fwd(Args args) {
    extern __shared__ __attribute__((aligned(16))) unsigned char lds_raw[];
    Fr F; F.lds = (LAS unsigned char*)lds_raw; F.ws = args.ws; F.out = args.out;
#pragma unroll
    for (int i = 0; i < 23; ++i) F.in[i] = args.in[i];
    F.tid = threadIdx.x; F.lane = F.tid & 63; F.wave = __builtin_amdgcn_readfirstlane(F.tid >> 6); F.wg = blockIdx.x; F.G = gridDim.x;
    volatile LAS unsigned* MISC = (volatile LAS unsigned*)(F.lds + LDS_MISC);
    if (F.tid < 16) MISC[F.tid] = 0u;
    __syncthreads();
    const int lo = args.ph_lo, hi = args.ph_hi;
    XcdBarrier bar; bar.bar = WSP(unsigned, WS_CTL) + CW_BAR; bar.x = 0; bar.st = nullptr;
    if (hi - lo > 1) bar = xcd_barrier_post(WSP(unsigned, WS_CTL) + CW_BAR, MISC + 8);
#define IN(k) (lo <= (k) && (k) < hi)
#define SEAM(k) do { if (IN(k) && IN((k) + 1)) xcd_barrier(bar); } while (0)
#define PH0 { p0_prologue(F); }
#define PH1 { p1_norm(F); }
#define PH2 { pg8::Gemm g{WSP(bf16, WS_HALL), WSP(bf16, WS_WINT), TALL, NPROJ, D}; pg8::StaticOrder S; S.init(TALL, NPROJ, F.G, F.wg); \
        EpiStore E{WSP(bf16, WS_P), NPROJ}; pg8::gemm_phase<EpiStore, pg8::StaticOrder, true, true>(F.lds, g, S, E); \
        if (F.wg >= 154 && F.G == 256) p4_convert(F, F.wg - 154, 102, CV_A0, CV_A1); }
#define PH3 { p3_prep(F); if (F.wg >= 32 && F.G == 256) p4_convert(F, F.wg - 32, 224, CV_A1, CV_B1); }
#define PH4 {   \
        if (F.wg < 240) { scan_run<0>(F, F.wg / 15, F.wg % 15); scan_run<1>(F, F.wg / 15, F.wg % 15); } else if (F.G == 256) p4_convert(F, F.wg - 240, 16, CV_B1, CV_C1);        \
        xcd_barrier(bar); \
        if (F.wg < 128) scan_combine(F, F.wg); else { p4_sgu(F, F.wg - 128, F.G - 128, 0, 256); }        \
        xcd_barrier(bar); \
        if (F.wg < 256) scan_run<2>(F, F.wg >> 4, F.wg & 15); \
        p4_sgu(F, F.wg, F.G, 256, NB * 128 * 4); p4_convert(F, F.wg, F.G, F.G == 256 ? CV_C1 : 0, CV_D0); }
#define PH5 { p5_gdn_out(F); }
#define PH6 { pg8::Gemm g{WSP(bf16, WS_MIX), WSP(bf16, WS_WOUTT), T, D, D}; pg8::StaticOrder S; S.init(T, D, F.G, F.wg); \
        EpiStore E{WSP(bf16, WS_R), D}; pg8::gemm_phase<EpiStore, pg8::StaticOrder, true, true>(F.lds, g, S, E); }
#define PH7 { p7_mid(F); }
#define PH8 { p8_permute(F); }
#define PH9 { moe_tables(F); const LAS int* tab = (const LAS int*)(F.lds + LDS_TAB); const int npan = tab[64] < MAXPAN ? tab[64] : MAXPAN; \
        pg8::Gemm g{WSP(bf16, WS_H2), WSP(bf16, WS_WGUT), npan * 256, 2048, D / 2}; MoeOrder S; S.init(npan, 8, F.G, F.wg, tab + 128); \
        { LAS int* gm = (LAS int*)(F.lds + LDS_GMAP); const int* RT = WSP(int, WS_ROWTOK); pg8::Unit uu; \
            for (int i = 0; i < 17 && S.next(i, uu); ++i) if (F.tid < 256) gm[i * 256 + F.tid] = RT[uu.pm * 256 + F.tid]; \
            __syncthreads(); } \
        EpiSwiGLU E{WSP(unsigned char, WS_ACT), WSP(float, WS_BGUP)}; pg8::gemm_phase<EpiSwiGLU, MoeOrder, true, true, true, true>(F.lds, g, S, E, (const LAS int*)(F.lds + LDS_GMAP)); \
        { const int rem = (npan * 8) % F.G; if (rem == 0) p4_convert(F, F.wg, F.G, CV_D0, NE * 768); else if (F.wg >= rem) p4_convert(F, F.wg - rem, F.G - rem, CV_D0, NE * 768); } }
#define PH10 { moe_tables(F); const LAS int* tab = (const LAS int*)(F.lds + LDS_TAB); const int npan = tab[64] < MAXPAN ? tab[64] : MAXPAN; \
        pg8::Gemm g{WSP(bf16, WS_ACT), WSP(bf16, WS_WDT), npan * 256, 1024, D / 2}; MoeOrder S; S.init(npan, 4, F.G, F.wg, tab + 128); \
        EpiDown E{WSP(unsigned char, WS_Y), F.in[22], WSP(float, WS_ROWGATE)}; pg8::gemm_phase<EpiDown, MoeOrder, true, true, true>(F.lds, g, S, E); }
#define RUN(k, BODY) do { if (IN(k)) BODY if (PROBE_TWICE == (k) && IN(k)) { xcd_barrier(bar); BODY } } while (0)
    RUN(0, PH0); SEAM(0);
    RUN(1, PH1); SEAM(1);
    RUN(2, PH2); SEAM(2);
    RUN(3, PH3); SEAM(3);
    RUN(4, PH4);
    if (PROBE_TWICE == 46 && IN(4)) { xcd_barrier(bar); if (F.wg < 240) scan_run<0>(F, F.wg / 15, F.wg % 15); else if (F.wg < 256) scan_run<1>(F, (F.wg - 240) / 15, (F.wg - 240) % 15); if (F.wg < 224) scan_run<1>(F, (F.wg + 16) / 15, (F.wg + 16) % 15); }
    if (PROBE_TWICE == 47 && IN(4)) { xcd_barrier(bar); if (F.wg < 256) scan_run<2>(F, F.wg >> 4, F.wg & 15); }
    if (PROBE_TWICE == 48 && IN(4)) { xcd_barrier(bar); p4_convert(F, F.wg, F.G, CV_C1, CV_D0); }
    if (PROBE_TWICE == 49 && IN(4)) { xcd_barrier(bar); if (F.wg < 128) scan_combine(F, F.wg); }
    SEAM(4);
    RUN(5, PH5); SEAM(5);
    RUN(6, PH6); SEAM(6);
    RUN(7, PH7); SEAM(7);
    RUN(8, PH8); SEAM(8);
    RUN(9, PH9); SEAM(9);
    RUN(10, PH10); SEAM(10);
    if (IN(11)) {
        if (DBG_MODE == 10) { const unsigned short* src = (const unsigned short*)(F.ws + WS_PREP);
            for (size_t i = (size_t)F.wg * NTHR + F.tid; i < (size_t)T * D; i += (size_t)F.G * NTHR) { float v = bf2f(src[i * 3]); F.out[i] = (v == v && fabsf(v) < 1e30f) ? v : 0.f; } }
        else if (DBG_MODE == 11) { const unsigned short* src = (const unsigned short*)(F.ws + WS_O);
            for (size_t i = (size_t)F.wg * NTHR + F.tid; i < (size_t)T * D; i += (size_t)F.G * NTHR) { float v = bf2f(src[i]); F.out[i] = (v == v && fabsf(v) < 1e30f) ? v : 0.f; } }
        else { p11_final(F); if (PROBE_TWICE == 11) { xcd_barrier(bar); p11_final(F); } } }
#undef IN
#undef SEAM
}

extern "C" void kernel_launch(void* const* d_in, const int* in_sizes, int n_in, void* d_out, int out_size, void* d_ws, size_t ws_size, hipStream_t stream) {
    static int grid = 0;
    if (grid == 0) {
        if (n_in != 23 || out_size != T * D || ws_size < WS_END) { fprintf(stderr, "kernel_launch: unexpected problem (n_in %d, out %d, ws %zu)\n", n_in, out_size, ws_size); grid = -1; return; }
        int dev = 0, cus = 0;
        if (hipGetDevice(&dev) != hipSuccess || hipDeviceGetAttribute(&cus, hipDeviceAttributeMultiprocessorCount, dev) != hipSuccess) { grid = -1; return; }
        if (hipFuncSetAttribute((const void*)mk_fwd, hipFuncAttributeMaxDynamicSharedMemorySize, LDS_BYTES) != hipSuccess) { fprintf(stderr, "kernel_launch: hipFuncSetAttribute failed\n"); grid = -1; return; }
        int per_cu = 0;
        if (hipOccupancyMaxActiveBlocksPerMultiprocessor(&per_cu, (const void*)mk_fwd, NTHR, LDS_BYTES) != hipSuccess || per_cu < 1) fprintf(stderr, "kernel_launch: occupancy query says %d\n", per_cu);
        (void)hipGetLastError();
        grid = cus;
        if (T % grid != 0 || T / grid > 256 || (T / grid) % 16 != 0 || SEQ % (T / grid) != 0) { fprintf(stderr, "kernel_launch: grid %d unsupported\n", grid); grid = -1; return; }
    }
    if (grid < 0) return;
    (void)hipMemsetAsync((char*)d_ws + WS_CTL, 0, CTL_BYTES, stream);
    Args a{};
    for (int i = 0; i < 23; ++i) a.in[i] = (const float*)d_in[i];
    a.out = (float*)d_out; a.ws = (unsigned char*)d_ws;
#if MK_PER_PHASE
    for (int p = 0; p < NPHASE; ++p) { if (DBG_MODE >= 10 && p >= 5 && p <= 10) continue; a.ph_lo = p; a.ph_hi = p + 1; hipLaunchKernelGGL(mk_fwd, dim3(grid), dim3(NTHR), LDS_BYTES, stream, a); }
#else
    a.ph_lo = 0; a.ph_hi = NPHASE; hipLaunchKernelGGL(mk_fwd, dim3(grid), dim3(NTHR), LDS_BYTES, stream, a);
#endif
}
```

```cpp
#include <hip/hip_runtime.h>
#include <cstdio>
#include <cstdint>
namespace pg8 {
#define PG8_LAS __attribute__((address_space(3)))
typedef unsigned short bf16_t;
typedef short bf16x8 __attribute__((ext_vector_type(8)));
typedef float f32x4 __attribute__((ext_vector_type(4)));
typedef unsigned u32x4 __attribute__((ext_vector_type(4)));
constexpr int BM = 256, BK = 64, HALF = 128, HTB = HALF * BK * 2  , STAGE_BYTES = 8 * HTB, NXCD = 8, WGM = 8;

__host__ __device__ __forceinline__ int lds_byte(int r, int c) { const int st = (r >> 4) * 2 + (c >> 5), rr = r & 15, cc = c & 31, ob = rr * 64 + cc * 2; return st * 1024 + (ob ^ (((ob >> 9) & 1) << 5)); }
__host__ __device__ __forceinline__ void stage_rc(int b, int& R, int& C) { const int st = b / 1024, sb = b % 1024, swz = sb ^ (((sb >> 9) & 1) << 5); R = (st >> 1) * 16 + swz / 64; C = (st & 1) * 32 + (swz % 64) / 2; }
__host__ __device__ __forceinline__ int perm32(int rho) { const int n = rho >> 4, i = rho & 15; return 8 * (i >> 2) + 4 * n + (i & 3); }

struct Unit { int pm, pn; };
struct Gemm { const bf16_t* A; const bf16_t* Bt; int M, N, K; };

struct StaticOrder {
    int nM, nN, nwg, G, c;
    __host__ __device__ void init(int M, int N, int G_, int c_) { nM = M / BM; nN = N / BM; nwg = nM * nN; G = G_; c = c_; }
    __host__ __device__ bool next(int i, Unit& u) const {
        const long L = (long)i * G + c; if (L >= nwg) return false;
        int wgid = (int)L; { const int q = nwg / NXCD, r = nwg % NXCD, xcd = wgid % NXCD, off = wgid / NXCD; wgid = (xcd < r ? xcd * (q + 1) : r * (q + 1) + (xcd - r) * q) + off; }
        const int nig = WGM * nN, gid = wgid / nig, fm = gid * WGM, gsz = (nM - fm) < WGM ? (nM - fm) : WGM;
        u.pm = fm + ((wgid % nig) % gsz); u.pn = (wgid % nig) / gsz; return true;
    }
    __device__ __forceinline__ void a_ready(const Unit&) const {}
    __device__ __forceinline__ void done(const Unit&) const {}
};
__device__ __forceinline__ unsigned cvt_pk_bf16(float lo, float hi) { unsigned r; asm volatile("v_cvt_pk_bf16_f32 %0, %1, %2" : "=v"(r) : "v"(lo), "v"(hi)); return r; }
template <class Epi, class Sched, bool ALIGN_EPI = false, bool SP2 = false, bool FP8 = false, bool GATHER = false>
__device__ __forceinline__ void gemm_phase(PG8_LAS unsigned char* lds, const Gemm g, const Sched& S, const Epi& E, const PG8_LAS int* gmap = nullptr) {
    typedef int i32x8_ __attribute__((ext_vector_type(8))); typedef int i32x4_ __attribute__((ext_vector_type(4)));
    const int tid = threadIdx.x, wid = __builtin_amdgcn_readfirstlane(tid >> 6), lane = tid & 63, wr = wid >> 2, wc = wid & 3, fr = lane & 15, fq = lane >> 4;
    const int K = g.K, nt = K / BK;
    unsigned voffA[2], voffB[2];
    int gR[2]; unsigned gCb[2]; unsigned gC0[2], gC1[2], gN0[2], gN1[2];
#pragma unroll
    for (int i = 0; i < 2; ++i) { int R, C; stage_rc(tid * 16 + i * 8192, R, C); const int Rb = Epi::PERM ? ((R & ~31) + perm32(R & 31)) : R;
        voffA[i] = (unsigned)(R * K + C) * 2u; voffB[i] = (unsigned)(Rb * K + C) * 2u; gR[i] = R; gCb[i] = (unsigned)C * 2u; }
#define PG8_GOFF(D0, D1, ui_) do { _Pragma("unroll") for (int i_ = 0; i_ < 2; ++i_) { D0[i_] = (unsigned)gmap[(ui_) * 256 + gR[i_]] * (unsigned)(K * 2) + gCb[i_]; D1[i_] = (unsigned)gmap[(ui_) * 256 + 128 + gR[i_]] * (unsigned)(K * 2) + gCb[i_]; } } while (0)
#define PG8_STAGE_A(bufoff, gbase, h_, nx_) do { if constexpr (GATHER) { if (nx_) PG8_STAGE(bufoff, gbase, ((h_) ? gN1 : gN0)); else PG8_STAGE(bufoff, gbase, ((h_) ? gC1 : gC0)); } \
        else PG8_STAGE(bufoff, (gbase) + ((h_) ? hstep : 0), voffA); } while (0)
    const size_t kstep = (size_t)(BK * 2);
    const size_t hstep = (size_t)HALF * K * 2;
    const size_t tstep = 2 * hstep;
    const unsigned ldsw = (unsigned)wid * 1024u;
    const int aoff = lds_byte(wr * 64 + fr, fq * 8), boff = lds_byte(wc * 32 + fr, fq * 8);
#define PG8_SA(b, h) (((b) * 2 + (h)) * HTB)
#define PG8_SB(b, h) ((4 + (b) * 2 + (h)) * HTB)
#define PG8_STAGE(bufoff, gbase, voff) do { _Pragma("unroll") for (int _i = 0; _i < 2; ++_i) \
        __builtin_amdgcn_global_load_lds((const unsigned*)((const char*)(gbase) + (voff)[_i]), (PG8_LAS unsigned*)(lds + (bufoff) + ldsw + _i * 8192), 16, 0, 0); } while (0)
#define PG8_LDA(dst, b, h) do { _Pragma("unroll") for (int m = 0; m < 4; ++m) _Pragma("unroll") for (int k = 0; k < 2; ++k) dst[m][k] = *(const PG8_LAS bf16x8*)(lds + PG8_SA(b, h) + aoff + m * 2048 + k * 1024); } while (0)
#define PG8_LDB(dst, b, h) do { _Pragma("unroll") for (int n = 0; n < 2; ++n) _Pragma("unroll") for (int k = 0; k < 2; ++k) dst[n][k] = *(const PG8_LAS bf16x8*)(lds + PG8_SB(b, h) + boff + n * 2048 + k * 1024); } while (0)
#define PG8_MMA16(ai, bj, At, Bt) do { __builtin_amdgcn_s_setprio(1); _Pragma("unroll") for (int m = 0; m < 4; ++m) _Pragma("unroll") for (int n = 0; n < 2; ++n) _Pragma("unroll") for (int k = 0; k < 2; ++k) \
        acc[ai][bj][m][n] = __builtin_amdgcn_mfma_f32_16x16x32_bf16(Bt[n][k], At[m][k], acc[ai][bj][m][n], 0, 0, 0); __builtin_amdgcn_s_setprio(0); } while (0)
#define PG8_LDA8(dst, b, h) do { _Pragma("unroll") for (int m = 0; m < 4; ++m) { const i32x4_ lo_ = *(const PG8_LAS i32x4_*)(lds + PG8_SA(b, h) + aoff + m * 2048), hi_ = *(const PG8_LAS i32x4_*)(lds + PG8_SA(b, h) + aoff + m * 2048 + 1024); \
        dst[m] = __builtin_shufflevector(lo_, hi_, 0, 1, 2, 3, 4, 5, 6, 7); } } while (0)
#define PG8_LDB8(dst, b, h) do { _Pragma("unroll") for (int n = 0; n < 2; ++n) { const i32x4_ lo_ = *(const PG8_LAS i32x4_*)(lds + PG8_SB(b, h) + boff + n * 2048), hi_ = *(const PG8_LAS i32x4_*)(lds + PG8_SB(b, h) + boff + n * 2048 + 1024); \
        dst[n] = __builtin_shufflevector(lo_, hi_, 0, 1, 2, 3, 4, 5, 6, 7); } } while (0)
#define PG8_MMA8(ai, bj, At, Bt) do { __builtin_amdgcn_s_setprio(1); _Pragma("unroll") for (int m = 0; m < 4; ++m) _Pragma("unroll") for (int n = 0; n < 2; ++n) \
        asm volatile("v_mfma_f32_16x16x128_f8f6f4 %0, %1, %2, %0" : "+v"(acc[ai][bj][m][n]) : "v"(Bt[n]), "v"(At[m])); \
        __builtin_amdgcn_s_setprio(0); } while (0)
#define PG8_LDAX(dst, b, h) do { if constexpr (FP8) PG8_LDA8(dst##8, b, h); else PG8_LDA(dst, b, h); } while (0)
#define PG8_LDBX(dst, b, h) do { if constexpr (FP8) PG8_LDB8(dst##8, b, h); else PG8_LDB(dst, b, h); } while (0)
#define PG8_MMA(ai, bj, At, Bt) do { if constexpr (FP8) PG8_MMA8(ai, bj, At##8, Bt##8); else PG8_MMA16(ai, bj, At, Bt); } while (0)
#define PG8_WAIT_V(n) asm volatile("s_waitcnt vmcnt(" #n ")" ::: "memory")
#define PG8_WAIT_L(n) asm volatile("s_waitcnt lgkmcnt(" #n ")" ::: "memory")
#define PG8_BAR __builtin_amdgcn_s_barrier()
#define PG8_SCHED __builtin_amdgcn_sched_barrier(0)
    Unit cur, nxt; int ui = 0;
    if (!S.next(0, cur)) return;
    f32x4 acc[2][2][4][2];
#pragma unroll
    for (int a = 0; a < 2; ++a)
#pragma unroll
        for (int b = 0; b < 2; ++b)
#pragma unroll
            for (int m = 0; m < 4; ++m)
#pragma unroll
                for (int n = 0; n < 2; ++n) acc[a][b][m][n] = (f32x4){0.f, 0.f, 0.f, 0.f};
    bf16x8 At[4][2], B0[2][2], B1[2][2];
    i32x8_ At8[4], B08[2], B18[2]; int scale1 = 0x7f7f7f7f; asm volatile("" : "+v"(scale1));
    const char* cA = (const char*)g.A + (GATHER ? (size_t)0 : (size_t)cur.pm * tstep); const char* cB = (const char*)g.Bt + (size_t)cur.pn * tstep;
    if constexpr (GATHER) { PG8_GOFF(gC0, gC1, 0); }
    S.a_ready(cur);
    if constexpr (SP2) {
        PG8_STAGE(PG8_SB(0, 0), cB, voffB); PG8_STAGE(PG8_SB(0, 1), cB + hstep, voffB); PG8_STAGE_A(PG8_SA(0, 0), cA, 0, false); PG8_STAGE_A(PG8_SA(0, 1), cA, 1, false);
        if (wr == 1) PG8_BAR;
        PG8_WAIT_V(2); PG8_BAR;
        PG8_STAGE(PG8_SB(1, 0), cB + kstep, voffB); PG8_STAGE_A(PG8_SA(1, 0), cA + kstep, 0, false); PG8_STAGE(PG8_SB(1, 1), cB + hstep + kstep, voffB);
        PG8_WAIT_V(6); PG8_BAR;
    } else {
        PG8_STAGE(PG8_SB(0, 0), cB, voffB); PG8_STAGE(PG8_SA(0, 0), cA, voffA); PG8_STAGE(PG8_SB(0, 1), cB + hstep, voffB); PG8_STAGE(PG8_SA(0, 1), cA + hstep, voffA);
        if (wr == 1) PG8_BAR;
        PG8_WAIT_V(4); PG8_BAR;
        PG8_STAGE(PG8_SB(1, 0), cB + kstep, voffB); PG8_STAGE(PG8_SA(1, 0), cA + kstep, voffA); PG8_STAGE(PG8_SB(1, 1), cB + hstep + kstep, voffB);
        PG8_WAIT_V(6); PG8_BAR;
    }
    for (;;) {
        const bool has_next = S.next(ui + 1, nxt);
        const char* nA = (has_next && !GATHER) ? (const char*)g.A + (size_t)nxt.pm * tstep : cA; const char* nB = has_next ? (const char*)g.Bt + (size_t)nxt.pn * tstep : cB;
        if constexpr (GATHER) { if (has_next) { PG8_GOFF(gN0, gN1, ui + 1); } else { _Pragma("unroll") for (int i_ = 0; i_ < 2; ++i_) { gN0[i_] = gC0[i_]; gN1[i_] = gC1[i_]; } } }
#pragma clang loop unroll(disable)
        for (int t = 0; t < nt; t += 2) {
            const bool last = (t == nt - 2);
            const char* a1 = cA + (size_t)(t + 1) * kstep;
            const char* a2 = last ? nA : cA + (size_t)(t + 2) * kstep; const char* b2 = last ? nB : cB + (size_t)(t + 2) * kstep;
            const char* a3 = a2 + kstep; const char* b3 = b2 + kstep;
            if (last && has_next) S.a_ready(nxt);
            if constexpr (SP2) {
            PG8_LDBX(B0, 0, 0); PG8_LDBX(B1, 0, 1); PG8_SCHED; PG8_LDAX(At, 0, 0); PG8_STAGE_A(PG8_SA(1, 1), a1, 1, false);
            PG8_WAIT_V(8); PG8_WAIT_L(0); PG8_BAR; PG8_MMA(0, 0, At, B0); PG8_MMA(0, 1, At, B1); PG8_BAR; PG8_SCHED;
            PG8_LDAX(At, 0, 1); PG8_STAGE(PG8_SB(0, 0), b2, voffB); PG8_STAGE(PG8_SB(0, 1), b2 + hstep, voffB); PG8_STAGE_A(PG8_SA(0, 0), a2, 0, last);
            PG8_WAIT_V(8); PG8_WAIT_L(0); PG8_BAR; PG8_MMA(1, 0, At, B0); PG8_MMA(1, 1, At, B1); PG8_BAR; PG8_SCHED;
            PG8_LDBX(B0, 1, 0); PG8_LDBX(B1, 1, 1); PG8_SCHED; PG8_LDAX(At, 1, 0); PG8_STAGE_A(PG8_SA(0, 1), a2, 1, last);
            PG8_WAIT_V(8); PG8_WAIT_L(0); PG8_BAR; PG8_MMA(0, 0, At, B0); PG8_MMA(0, 1, At, B1); PG8_BAR; PG8_SCHED;
            PG8_LDAX(At, 1, 1); PG8_STAGE(PG8_SB(1, 0), b3, voffB); PG8_STAGE(PG8_SB(1, 1), b3 + hstep, voffB); PG8_STAGE_A(PG8_SA(1, 0), a3, 0, last);
            PG8_WAIT_V(8); PG8_WAIT_L(0); PG8_BAR; PG8_MMA(1, 0, At, B0); PG8_MMA(1, 1, At, B1); PG8_BAR; PG8_SCHED;
            } else {
            PG8_LDBX(B0, 0, 0); PG8_SCHED; PG8_LDAX(At, 0, 0); PG8_STAGE(PG8_SA(1, 1), a1 + hstep, voffA);
            PG8_WAIT_L(8); PG8_BAR; PG8_WAIT_L(0); PG8_MMA(0, 0, At, B0); PG8_BAR; PG8_SCHED;
            PG8_LDBX(B1, 0, 1); PG8_STAGE(PG8_SB(0, 0), b2, voffB);
            PG8_BAR; PG8_WAIT_L(0); PG8_MMA(0, 1, At, B1); PG8_BAR;
            PG8_LDAX(At, 0, 1); PG8_STAGE(PG8_SA(0, 0), a2, voffA);
            PG8_BAR; PG8_WAIT_L(0); PG8_MMA(1, 0, At, B0); PG8_BAR; PG8_SCHED;
            PG8_STAGE(PG8_SB(0, 1), b2 + hstep, voffB);
            PG8_WAIT_V(6); PG8_BAR; PG8_MMA(1, 1, At, B1); PG8_BAR;
            PG8_LDBX(B0, 1, 0); PG8_SCHED; PG8_LDAX(At, 1, 0); PG8_STAGE(PG8_SA(0, 1), a2 + hstep, voffA);
            PG8_WAIT_L(8); PG8_BAR; PG8_WAIT_L(0); PG8_MMA(0, 0, At, B0); PG8_BAR; PG8_SCHED;
            PG8_LDBX(B1, 1, 1); PG8_STAGE(PG8_SB(1, 0), b3, voffB);
            PG8_BAR; PG8_WAIT_L(0); PG8_MMA(0, 1, At, B1); PG8_BAR;
            PG8_LDAX(At, 1, 1); PG8_STAGE(PG8_SA(1, 0), a3, voffA);
            PG8_BAR; PG8_WAIT_L(0); PG8_MMA(1, 0, At, B0); PG8_BAR; PG8_SCHED;
            PG8_STAGE(PG8_SB(1, 1), b3 + hstep, voffB);
            PG8_WAIT_V(6); PG8_BAR; PG8_MMA(1, 1, At, B1); PG8_BAR;
            }
        }
        if constexpr (ALIGN_EPI) { if (wr == 0) PG8_BAR; }
        if constexpr (FP8) asm volatile("s_nop 15\n\ts_nop 15\n\ts_nop 15\n\ts_nop 15\n\ts_nop 15" ::: "memory");
        if constexpr (!Epi::AFTER_DRAIN) { Unit eu = cur; int fr_ = fr, fq_ = fq; asm volatile("" : "+v"(eu.pm), "+v"(eu.pn), "+v"(fr_), "+v"(fq_));
            E(acc, eu, wr, wc, fr_, fq_); S.done(cur); }
        if (!has_next) break;
#pragma unroll
        for (int a = 0; a < 2; ++a)
#pragma unroll
            for (int b = 0; b < 2; ++b)
#pragma unroll
                for (int m = 0; m < 4; ++m)
#pragma unroll
                    for (int n = 0; n < 2; ++n) acc[a][b][m][n] = (f32x4){0.f, 0.f, 0.f, 0.f};
        cur = nxt; cA = nA; cB = nB; ++ui;
        if constexpr (GATHER) { _Pragma("unroll") for (int i_ = 0; i_ < 2; ++i_) { gC0[i_] = gN0[i_]; gC1[i_] = gN1[i_]; } }
        if constexpr (ALIGN_EPI) { if (wr == 1) PG8_BAR; }
    }
    PG8_WAIT_V(0);
    if constexpr (!ALIGN_EPI) { if (wr == 0) PG8_BAR; }
    PG8_BAR;
    if constexpr (Epi::AFTER_DRAIN) { E.fused(acc, cur, wr, wc, fr, fq, lds, wid, lane); S.done(cur); }
#undef PG8_SA
#undef PG8_SB
#undef PG8_STAGE
#undef PG8_STAGE_A
#undef PG8_GOFF
#undef PG8_LDA
#undef PG8_LDB
#undef PG8_MMA
#undef PG8_MMA16
#undef PG8_MMA8
#undef PG8_LDA8
#undef PG8_LDB8
#undef PG8_LDAX
#undef PG8_LDBX
#undef PG8_WAIT_V
#undef PG8_WAIT_L
#undef PG8_BAR
#undef PG8_SCHED
}
}

#ifndef MK_PER_PHASE
#define MK_PER_PHASE 0
#endif
#ifndef PROBE_TWICE
#define PROBE_TWICE -1
#endif
#ifndef DBG_SEL
#define DBG_SEL 9
#endif
#ifndef DBG_MODE
#define DBG_MODE 0
#endif
#if 0
#endif

#define GAS __attribute__((address_space(1)))
#define LAS __attribute__((address_space(3)))
typedef unsigned short bf16;
typedef float f32x4 __attribute__((ext_vector_type(4)));
typedef short bf16x8 __attribute__((ext_vector_type(8)));
typedef unsigned u32x4 __attribute__((ext_vector_type(4)));
typedef unsigned u32x2 __attribute__((ext_vector_type(2)));

constexpr int NB = 2, SEQ = 16384, D = 1024, T = NB * SEQ, CTXL = 256, TC = NB * CTXL, TALL = T + TC;
constexpr int NPROJ = 3328, NPROJ_SRC = 3088;
constexpr int PC_Z = 1536, PC_U = 2048, PC_V = 2560, PC_BA = 3072;
constexpr int NH = 4, NE = 32, NCH = 260;
constexpr int MAXPAN = 544, MAXROWS = MAXPAN * 256;
constexpr float EPS = 1e-6f;
constexpr int NWAVES = 8, NTHR = 512;
constexpr int NPHASE = 12;
constexpr int CV_A0 = 0, CV_A1 = 5712, CV_B1 = CV_A1 + 5376, CV_C1 = CV_B1 + 2304, CV_D0 = NE * 768 - 3072;

constexpr size_t MiB = 1ull << 20;
constexpr size_t WS_CTL = 0, CTL_BYTES = 1 * MiB;
constexpr size_t WS_MOD = 1 * MiB;
constexpr size_t WS_WRT = 1 * MiB + 128 * 1024;
constexpr size_t WS_BGUP = 1 * MiB + 256 * 1024;
constexpr size_t WS_TKE = 2 * MiB, WS_TKRANK = 2 * MiB + 512 * 1024, WS_TKGATE = 3 * MiB, WS_TKROW = 3 * MiB + 512 * 1024;
constexpr size_t WS_ROWGATE = 4 * MiB;
constexpr size_t WS_WINT = 6 * MiB;
constexpr size_t WS_WOUTT = 13 * MiB;
constexpr size_t WS_WGUT = 16 * MiB;
constexpr size_t WS_WDT = 144 * MiB;
constexpr size_t WS_X1 = 208 * MiB;
constexpr size_t WS_MIX = WS_X1;
constexpr size_t WS_H2 = 336 * MiB;
constexpr size_t WS_R1 = 400 * MiB;
constexpr size_t WS_P = WS_R1, WS_ACT = WS_R1;
constexpr size_t WS_R2 = 672 * MiB;
constexpr size_t WS_HALL = WS_R2, WS_O = WS_R2;
constexpr size_t WS_PREP = WS_R2 + 65 * MiB;
constexpr size_t WS_R = WS_PREP;
constexpr size_t WS_VEC = WS_R2 + 261 * MiB;
constexpr size_t WS_ROWTOK = WS_R2;
constexpr size_t WS_XS = WS_R2, WS_Y = WS_R2;
constexpr size_t WS_END = 944 * MiB;
constexpr size_t PREP_UNIT = 98304;
constexpr int PO_KQ = 0, PO_KT = 32768, PO_V = 49152, PO_T = 65536, PO_A = 81920;
constexpr int CW_BAR = 4096, CW_GCNT = 8192;

constexpr int LDS_BYTES = 163840;
constexpr int LDS_TAB = 131072;
constexpr int LDS_GMAP = LDS_TAB + 4096;
constexpr int LDS_MISC = LDS_BYTES - 64;

#define LDS_WAIT() asm volatile("s_waitcnt lgkmcnt(0)" ::: "memory")
#define VM_WAIT() asm volatile("s_waitcnt vmcnt(0)" ::: "memory")

__device__ __forceinline__ float bf2f(unsigned b) { return __uint_as_float(b << 16); }
__device__ __forceinline__ float bflo(unsigned w) { return __uint_as_float(w << 16); }
__device__ __forceinline__ float bfhi(unsigned w) { return __uint_as_float(w & 0xffff0000u); }
typedef __bf16 bf16x2_t __attribute__((ext_vector_type(2)));
typedef float f32x2_t __attribute__((ext_vector_type(2)));
__device__ __forceinline__ unsigned pk2(float lo, float hi) { const f32x2_t f = {lo, hi}; const bf16x2_t v = __builtin_convertvector(f, bf16x2_t); return __builtin_bit_cast(unsigned, v); }
__device__ __forceinline__ float sat8(float x) { return __builtin_amdgcn_fmed3f(x, -448.f, 448.f); }
__device__ __forceinline__ unsigned pk_fp8x4(float a, float b, float c, float d) { a = sat8(a); b = sat8(b); c = sat8(c); d = sat8(d); int w = 0; w = __builtin_amdgcn_cvt_pk_fp8_f32(a, b, w, false); w = __builtin_amdgcn_cvt_pk_fp8_f32(c, d, w, true); return (unsigned)w; }
constexpr float W8_SCALE = 32.f, W8_INV = 1.f / 32.f;
__device__ __forceinline__ float frcp(float x) { return __builtin_amdgcn_rcpf(x); }
__device__ __forceinline__ float sigm(float x) { return frcp(1.f + __expf(-x)); }
__device__ __forceinline__ float silu_(float x) { return x * frcp(1.f + __expf(-x)); }
__device__ __forceinline__ float gelu_t(float x) { const float y = 0.7978845608028654f * (x + 0.044715f * x * x * x); const float t = 1.f - 2.f * frcp(__expf(2.f * y) + 1.f); return 0.5f * x * (1.f + t); }
#define DPP_MOV(v, ctrl) __builtin_bit_cast(float, __builtin_amdgcn_update_dpp(0, __builtin_bit_cast(int, (v)), (ctrl), 0xf, 0xf, true))
__device__ __forceinline__ float sum16(float v) { v += DPP_MOV(v, 0xB1); v += DPP_MOV(v, 0x4E); v += DPP_MOV(v, 0x124); v += DPP_MOV(v, 0x128); return v; }
__device__ __forceinline__ float wave_sum(float v) {
    v = sum16(v); const int iv = __builtin_bit_cast(int, v);
    return (__builtin_bit_cast(float, __builtin_amdgcn_readlane(iv, 0)) + __builtin_bit_cast(float, __builtin_amdgcn_readlane(iv, 16))) + (__builtin_bit_cast(float, __builtin_amdgcn_readlane(iv, 32)) + __builtin_bit_cast(float, __builtin_amdgcn_readlane(iv, 48)));
}
#define XB_TMO      128
#define XB_XCNT(j)  (256  + 64 * (j))
#define XB_XSUB(j)  (1280 + 64 * (j))
#define XB_XGEN(j)  (2304 + 64 * (j))
#define XB_TOP      3328
#define XB_TOPGEN   3392
#define XCD_BAR_WORDS 3456
#define XB_SPIN_CAP (1u << 18)
__device__ __forceinline__ unsigned xb_ld(unsigned* p)              { return __hip_atomic_load(p, __ATOMIC_RELAXED, __HIP_MEMORY_SCOPE_AGENT); }
__device__ __forceinline__ unsigned xb_add(unsigned* p, unsigned v) { return __hip_atomic_fetch_add(p, v, __ATOMIC_RELAXED, __HIP_MEMORY_SCOPE_AGENT); }
__device__ __forceinline__ unsigned xb_xcc_id() { return (unsigned)__builtin_amdgcn_s_getreg((3 << 11) | 20) & 0xFu; }
#define XB_SPIN(cond, bar) do { unsigned _sp = 0; while (cond) { __builtin_amdgcn_s_sleep(1); \
    if ((++_sp & 255u) == 0u) { if (xb_ld(&(bar)[XB_TMO])) break; if (_sp > XB_SPIN_CAP) { atomicAdd(&(bar)[XB_TMO], 1u); break; } } } } while (0)
struct XcdBarrier { unsigned* bar; unsigned x; volatile LAS unsigned* st; };
__device__ __forceinline__ XcdBarrier xcd_barrier_post(unsigned* bar, volatile LAS unsigned* st) {
    XcdBarrier b; b.bar = bar; b.x = xb_xcc_id(); b.st = st;
    if (threadIdx.x == 0) (void)xb_add(&bar[XB_XCNT(b.x)], 1u);
    return b;
}
__device__ __forceinline__ void xcd_barrier_complete(unsigned* bar, unsigned x, unsigned& nloc, unsigned& nx) {
    const unsigned G = gridDim.x * gridDim.y * gridDim.z;
    unsigned sum, cnt, mine, sp = 0u;
    for (;;) {
        sum = 0u; cnt = 0u; mine = 0u;
#pragma unroll
        for (unsigned j = 0; j < 16; ++j) { const unsigned c = xb_ld(&bar[XB_XCNT(j)]); sum += c; cnt += (c > 0u) ? 1u : 0u; mine = (j == x) ? c : mine; }
        if (sum == G) break;
        __builtin_amdgcn_s_sleep(1);
        if ((++sp & 255u) == 0u) { if (xb_ld(&bar[XB_TMO])) break; if (sp > XB_SPIN_CAP) { atomicAdd(&bar[XB_TMO], 1u); break; } }
    }
    nloc = mine > 0u ? mine : 1u; nx = cnt > 0u ? cnt : 1u;
}
__device__ __forceinline__ void xcd_barrier(const XcdBarrier& b) {
    asm volatile("s_waitcnt vmcnt(0)" ::: "memory");
    __syncthreads();
    if (threadIdx.x == 0) {
        unsigned* bar = b.bar;
        __builtin_amdgcn_s_waitcnt(0);
        unsigned nloc = b.st[0], nx = b.st[1];
        if (nloc == 0u) { xcd_barrier_complete(bar, b.x, nloc, nx); b.st[0] = nloc; b.st[1] = nx; }
        const unsigned old = xb_add(&bar[XB_XSUB(b.x)], 1u);
        const unsigned gen = old / nloc;
        if (old + 1u == (gen + 1u) * nloc) {
            __builtin_amdgcn_fence(__ATOMIC_RELEASE, "agent");
            asm volatile("s_waitcnt vmcnt(0)" ::: "memory");
            const unsigned og = xb_add(&bar[XB_TOP], 1u);
            const unsigned tg = og / nx;
            if (og + 1u == (tg + 1u) * nx) xb_add(&bar[XB_TOPGEN], 1u);
            else XB_SPIN(xb_ld(&bar[XB_TOPGEN]) == tg, bar);
            __builtin_amdgcn_fence(__ATOMIC_ACQUIRE, "agent");
            xb_add(&bar[XB_XGEN(b.x)], 1u);
            asm volatile("s_waitcnt vmcnt(0)" ::: "memory");
        } else {
            XB_SPIN(xb_ld(&bar[XB_XGEN(b.x)]) == gen, bar);
            __builtin_amdgcn_fence(__ATOMIC_ACQUIRE, "agent");
            asm volatile("s_waitcnt vmcnt(0)" ::: "memory");
        }
    }
    __syncthreads();
}

struct Fr {
    LAS unsigned char* lds; unsigned char* ws; const float* in[23]; float* out;
    int tid, lane, wave, wg, G;
};
#define WSP(T_, off) ((T_*)(F.ws + (off)))

struct MapId { __device__ __forceinline__ int operator()(int n) const { return n; } };
struct MapIn { __device__ __forceinline__ int operator()(int n) const { return n < 1536 ? n : (n < 1552 ? PC_BA + (n - 1536) : n - 16); } };
struct MapGu { __device__ __forceinline__ int operator()(int s) const { const int a = s >> 1; return 32 * (a >> 4) + 16 * (s & 1) + (a & 15); } };
template <class RM> __device__ __forceinline__ void tr_item(const float* W, int N, int k0, int n0, bf16* WT, RM rm, LAS float* scr, int lane) {
    const int cq = lane & 15, rq = lane >> 4;
#pragma unroll
    for (int i = 0; i < 16; ++i) { const int kk = 4 * i + rq, n = n0 + 4 * cq; f32x4 v = (f32x4){0.f, 0.f, 0.f, 0.f};
        if (n < N) v = *(const f32x4*)(W + (size_t)(k0 + kk) * N + n);
        *(LAS f32x4*)(scr + kk * 68 + 4 * cq) = v; }
    LDS_WAIT();
    const int c = lane & 7;
#pragma unroll
    for (int j = 0; j < 8; ++j) { const int n = 8 * j + (lane >> 3);
        if (n0 + n < N) { const LAS float* s = scr + (8 * c) * 68 + n;
            u32x4 o; o.x = pk2(s[0], s[68]); o.y = pk2(s[136], s[204]); o.z = pk2(s[272], s[340]); o.w = pk2(s[408], s[476]);
            *(u32x4*)(WT + (size_t)rm(n0 + n) * 1024 + k0 + 8 * c) = o; } }
    LDS_WAIT();
}
struct MapGu8 { __device__ __forceinline__ int operator()(int s) const { const int a = s >> 1, n = s & 1, pn = a >> 7, al = a & 127; return 256 * pn + 128 * ((al >> 2) & 1) + 32 * (al >> 5) + 16 * n + 4 * ((al >> 3) & 3) + (al & 3); } };
struct MapDn8 { __device__ __forceinline__ int operator()(int o) const { const int pn = o >> 8, ol = o & 255; return 256 * pn + 128 * ((ol >> 3) & 1) + 32 * (ol >> 6) + 8 * ((ol >> 4) & 3) + (ol & 7); } };
template <class RM> __device__ __forceinline__ void tr_item8(const float* W, int N, int k0, int n0, unsigned char* WT, RM rm, LAS float* scr, int lane) {
    const int cq = lane & 15, rq = lane >> 4;
#pragma unroll
    for (int i = 0; i < 16; ++i) { const int kk = 4 * i + rq, n = n0 + 4 * cq; *(LAS f32x4*)(scr + kk * 68 + 4 * cq) = *(const f32x4*)(W + (size_t)(k0 + kk) * N + n); }
    LDS_WAIT();
    const int c = lane & 7;
#pragma unroll
    for (int j = 0; j < 8; ++j) { const int n = 8 * j + (lane >> 3); const LAS float* sp = scr + (8 * c) * 68 + n;
        u32x2 o; o.x = pk_fp8x4(sp[0] * W8_SCALE, sp[68] * W8_SCALE, sp[136] * W8_SCALE, sp[204] * W8_SCALE); o.y = pk_fp8x4(sp[272] * W8_SCALE, sp[340] * W8_SCALE, sp[408] * W8_SCALE, sp[476] * W8_SCALE);
        *(u32x2*)(WT + (size_t)rm(n0 + n) * 1024 + k0 + 8 * c) = o; }
    LDS_WAIT();
}
__device__ __forceinline__ void p0_prologue(const Fr& F) {
    const float* c = F.in[1]; const float* cc = F.in[3]; const float* wada = F.in[4]; const float* bada = F.in[5];
    {
        LAS float* SIL = (LAS float*)F.lds; LAS float* RED = SIL + 3072; float* MOD = WSP(float, WS_MOD);
        for (int u = F.wg; u < 96; u += F.G) {
            for (int i = F.tid; i < 3072; i += NTHR) { const int r = i >> 10, k = i & 1023; const float x = r == 0 ? c[k] : (r == 1 ? c[1024 + k] : cc[k]); SIL[i] = silu_(x); }
            __syncthreads();
            const int n0 = u * 64, kb = F.wave * 128; float a0 = 0.f, a1 = 0.f, a2 = 0.f;
#pragma unroll 8
            for (int k = 0; k < 128; ++k) { const float w = wada[(size_t)(kb + k) * 6144 + n0 + F.lane]; a0 += SIL[kb + k] * w; a1 += SIL[1024 + kb + k] * w; a2 += SIL[2048 + kb + k] * w; }
            RED[(F.wave * 3 + 0) * 64 + F.lane] = a0; RED[(F.wave * 3 + 1) * 64 + F.lane] = a1; RED[(F.wave * 3 + 2) * 64 + F.lane] = a2;
            __syncthreads();
            if (F.tid < 192) { const int r = F.tid >> 6, l = F.tid & 63; float s = bada[n0 + l];
#pragma unroll
                for (int w = 0; w < 8; ++w) s += RED[(w * 3 + r) * 64 + l];
                MOD[r * 6144 + n0 + l] = s; }
            __syncthreads();
        }
    }
    {
        LAS float* scr = (LAS float*)(F.lds + F.wave * 17408);
        const int gw = F.wg * NWAVES + F.wave, NGW = F.G * NWAVES;
        constexpr int I_IN = 16 * 49, I_OUT = 16 * 16;
        for (int it = gw; it < I_IN + I_OUT; it += NGW) {
            int r = it;
            if (r < I_IN) { tr_item(F.in[7], NPROJ_SRC, (r / 49) * 64, (r % 49) * 64, WSP(bf16, WS_WINT), MapIn{}, scr, F.lane); continue; } r -= I_IN;
            tr_item(F.in[16], 1024, (r / 16) * 64, (r % 16) * 64, WSP(bf16, WS_WOUTT), MapId{}, scr, F.lane);
        }
    }
    {
        const int gt = F.wg * NTHR + F.tid, NGT = F.G * NTHR;
        float* WRT = WSP(float, WS_WRT); const float* rw = F.in[17];
        for (int i = gt; i < NE * 1024; i += NGT) { const int e = i >> 10, k = i & 1023; WRT[i] = rw[k * NE + e]; }
        float* BG = WSP(float, WS_BGUP); const float* bgu = F.in[20]; MapGu8 mg;
        for (int i = gt; i < NE * 2048; i += NGT) { const int e = i >> 11, s = i & 2047; BG[e * 2048 + mg(s)] = bgu[i]; }
        u32x4* z = (u32x4*)(WSP(bf16, WS_WINT) + (size_t)NPROJ_SRC * 1024);
        for (int i = gt; i < (NPROJ - NPROJ_SRC) * 1024 / 8; i += NGT) z[i] = (u32x4){0u, 0u, 0u, 0u};
    }
}

__device__ __forceinline__ void p4_convert(const Fr& F, int worker, int nworkers, int it_lo, int it_hi) {
    LAS float* scr = (LAS float*)(F.lds + F.wave * 17408);
    const int gw = worker * NWAVES + F.wave, NGW = nworkers * NWAVES;
    constexpr int I_GU = NE * 16 * 32, I_DN = NE * 16 * 16;
    for (int it = it_lo + gw; it < it_hi; it += NGW) {
        int r = it;
        if (r < I_GU) { const int e = r / 512, rr = r % 512; tr_item8(F.in[19] + (size_t)e * 1024 * 2048, 2048, (rr / 32) * 64, (rr % 32) * 64, WSP(unsigned char, WS_WGUT) + (size_t)e * 2048 * 1024, MapGu8{}, scr, F.lane); continue; } r -= I_GU;
        { const int e = r / 256, rr = r % 256; tr_item8(F.in[21] + (size_t)e * 1024 * 1024, 1024, (rr / 16) * 64, (rr % 16) * 64, WSP(unsigned char, WS_WDT) + (size_t)e * 1024 * 1024, MapDn8{}, scr, F.lane); }
    }
}
__device__ __forceinline__ void p1_norm(const Fr& F) {
    const float* x = F.in[0]; const float* ctx = F.in[2]; const float* ng = F.in[6]; const float* MOD = WSP(float, WS_MOD); bf16* H = WSP(bf16, WS_HALL);
    const int gw = F.wg * NWAVES + F.wave, NGW = F.G * NWAVES, lane = F.lane;
    for (int blk = gw; blk < TALL / 4; blk += NGW) {
        const int r0 = blk * 4; const float* xb = r0 < T ? x + (size_t)r0 * D : ctx + (size_t)(r0 - T) * D; const int mi = r0 < T ? (r0 >> 14) : 2;
        const float* m0 = MOD + mi * 6144; const float* m1 = m0 + 1024;
        f32x4 sc[4], sh[4];
#pragma unroll
        for (int j = 0; j < 4; ++j) { const int k = 256 * j + 4 * lane; sc[j] = *(const f32x4*)(ng + k) * (*(const f32x4*)(m1 + k) + 1.f); sh[j] = *(const f32x4*)(m0 + k); }
        f32x4 cur[4], nxt[4];
#pragma unroll
        for (int j = 0; j < 4; ++j) cur[j] = *(const f32x4*)(xb + 256 * j + 4 * lane);
#pragma clang loop unroll(disable)
        for (int i = 0; i < 4; ++i) {
            const int in = i + 1 < 4 ? i + 1 : i;
#pragma unroll
            for (int j = 0; j < 4; ++j) nxt[j] = *(const f32x4*)(xb + (size_t)in * D + 256 * j + 4 * lane);
            float ss = 0.f;
#pragma unroll
            for (int j = 0; j < 4; ++j) ss += (cur[j].x * cur[j].x + cur[j].y * cur[j].y) + (cur[j].z * cur[j].z + cur[j].w * cur[j].w);
            const float rstd = rsqrtf(wave_sum(ss) * (1.f / D) + EPS);
#pragma unroll
            for (int j = 0; j < 4; ++j) { const f32x4 h = cur[j] * rstd * sc[j] + sh[j];
                u32x2 o; o.x = pk2(h.x, h.y); o.y = pk2(h.z, h.w); *(u32x2*)(H + (size_t)(r0 + i) * D + 256 * j + 4 * lane) = o; cur[j] = nxt[j]; }
        }
    }
}

__device__ __forceinline__ void p3_prep(const Fr& F) {
    const bf16* P = WSP(bf16, WS_P); const float* convw = F.in[8]; const float* alog = F.in[9]; const float* dtb = F.in[10];
    LAS bf16* QL = (LAS bf16*)F.lds; LAS bf16* KL = QL + 64 * 136; LAS bf16* VL = KL + 64 * 136;
    LAS float* AM = (LAS float*)(F.lds + 52224); LAS float* XM = AM + 2 * 64 * 65; LAS bf16* AT = (LAS bf16*)(F.lds + 118784);
    LAS float* TMPW = (LAS float*)(F.lds + 137216); LAS float* GV = (LAS float*)(F.lds + 139392);
    for (int u = F.wg; u < NB * NCH * NH; u += F.G) {
        int tid = F.tid; asm volatile("" : "+v"(tid));
        const int lane = tid & 63, wave = __builtin_amdgcn_readfirstlane(tid >> 6), l16 = lane & 15, q4 = lane >> 4;
        const int b = u / (NCH * NH), rem = u % (NCH * NH), cn = rem >> 2, h = rem & 3;
        int rowbase, lo, hi;
        if (cn < 4) { lo = T + b * CTXL; hi = lo + CTXL; rowbase = lo + cn * 64; } else { rowbase = b * SEQ + (cn - 4) * 64; lo = rowbase; hi = rowbase + 64; }
        unsigned char* pu = F.ws + WS_PREP + (size_t)u * PREP_UNIT; float* vec = WSP(float, WS_VEC) + (size_t)u * 512;
        u32x4 xc[6], xn[6]; f32x4 cwc[6], cwn[6];
#define P3_LOAD(XD, WD, part_) do { const int cg_ = tid & 15, col_ = (part_) * 512 + h * 128 + cg_ * 8; \
            _Pragma("unroll") for (int sub_ = 0; sub_ < 2; ++sub_) { const int row_ = rowbase + (sub_ << 5) + (tid >> 4); const u32x4 zero_ = (u32x4){0u, 0u, 0u, 0u}; \
                XD[sub_ * 3 + 1] = *(const u32x4*)(P + (size_t)row_ * NPROJ + col_); XD[sub_ * 3 + 0] = zero_; XD[sub_ * 3 + 2] = zero_; \
                if (row_ - 1 >= lo) XD[sub_ * 3 + 0] = *(const u32x4*)(P + (size_t)(row_ - 1) * NPROJ + col_); \
                if (row_ + 1 < hi) XD[sub_ * 3 + 2] = *(const u32x4*)(P + (size_t)(row_ + 1) * NPROJ + col_); } \
            _Pragma("unroll") for (int hh_ = 0; hh_ < 2; ++hh_) { WD[hh_ * 3 + 0] = *(const f32x4*)(convw + col_ + 4 * hh_); WD[hh_ * 3 + 1] = *(const f32x4*)(convw + 1536 + col_ + 4 * hh_); WD[hh_ * 3 + 2] = *(const f32x4*)(convw + 3072 + col_ + 4 * hh_); } } while (0)
        P3_LOAD(xc, cwc, 0);
#pragma unroll
        for (int part = 0; part < 3; ++part) {
            const int cg = tid & 15;
            if (part < 2) P3_LOAD(xn, cwn, part + 1);
#pragma unroll
            for (int sub = 0; sub < 2; ++sub) {
                const int i = (sub << 5) + (tid >> 4);
                const u32x4 xm = xc[sub * 3 + 0], x0 = xc[sub * 3 + 1], xp = xc[sub * 3 + 2];
                float val[8];
#pragma unroll
                for (int hh = 0; hh < 2; ++hh) {
                    const f32x4 w0 = cwc[hh * 3 + 0], w1 = cwc[hh * 3 + 1], w2 = cwc[hh * 3 + 2];
                    const unsigned m0 = hh ? xm.z : xm.x, m1 = hh ? xm.w : xm.y, c0 = hh ? x0.z : x0.x, c1 = hh ? x0.w : x0.y, p0 = hh ? xp.z : xp.x, p1 = hh ? xp.w : xp.y;
                    val[4 * hh + 0] = w0.x * bflo(m0) + w1.x * bflo(c0) + w2.x * bflo(p0);
                    val[4 * hh + 1] = w0.y * bfhi(m0) + w1.y * bfhi(c0) + w2.y * bfhi(p0);
                    val[4 * hh + 2] = w0.z * bflo(m1) + w1.z * bflo(c1) + w2.z * bflo(p1);
                    val[4 * hh + 3] = w0.w * bfhi(m1) + w1.w * bfhi(c1) + w2.w * bfhi(p1);
                }
                float ss = 0.f;
#pragma unroll
                for (int e = 0; e < 8; ++e) { val[e] = silu_(val[e]); ss += val[e] * val[e]; }
                if (part < 2) { ss = sum16(ss); const float sc = rsqrtf(ss + EPS) * (part == 0 ? 0.08838834764831845f : 1.f);
#pragma unroll
                    for (int e = 0; e < 8; ++e) val[e] *= sc; }
                u32x4 w; w.x = pk2(val[0], val[1]); w.y = pk2(val[2], val[3]); w.z = pk2(val[4], val[5]); w.w = pk2(val[6], val[7]);
                LAS bf16* dst = part == 0 ? QL : (part == 1 ? KL : VL);
                *(LAS u32x4*)(dst + i * 136 + cg * 8) = w;
                if (part < 2) { const int rb = (part == 0 ? 4 : 0) + (i >> 4), ks = cg >> 2, ln = (i & 15) + 16 * (cg & 3);
                    *(u32x4*)(pu + PO_KQ + ((rb * 4 + ks) * 64 + ln) * 16) = w; }
            }
#pragma unroll
            for (int e = 0; e < 6; ++e) { cwc[e] = cwn[e]; xc[e] = xn[e]; }
        }
#undef P3_LOAD
        if (wave < 2) {
            const int d = wave, row = rowbase + lane;
            const float bb = bf2f(P[(size_t)row * NPROJ + PC_BA + d * 4 + h]), aa = bf2f(P[(size_t)row * NPROJ + PC_BA + 8 + d * 4 + h]);
            const float beta = sigm(bb), xx = aa + dtb[d * 4 + h];
            const float sp = xx > 20.f ? xx : log1pf(expf(xx));
            float Gc = -expf(alog[d * 4 + h]) * sp;
#pragma unroll
            for (int o = 1; o < 64; o <<= 1) { const float up = __shfl_up(Gc, o), dn = __shfl_down(Gc, o);
                if (d == 0) { if (lane >= o) Gc += up; } else { if (lane + o < 64) Gc += dn; } }
            const float glast = __shfl(Gc, d == 0 ? 63 : 0);
            GV[d * 64 + lane] = Gc; GV[128 + d * 64 + lane] = beta;
            float* vd = vec + d * 256;
            vd[lane] = expf(Gc); vd[64 + lane] = beta; vd[128 + lane] = expf(glast - Gc); vd[192 + lane] = expf(glast);
        }
        __syncthreads();
#pragma unroll
        for (int jj = 0; jj < 4; ++jj) {
            const int job = wave * 4 + jj, mat = job >> 4, ti = (job >> 2) & 3, tj = job & 3;
            const LAS bf16* Ap = (mat == 0 ? KL : QL) + (ti * 16 + l16) * 136 + q4 * 8;
            const LAS bf16* Bp = KL + (tj * 16 + l16) * 136 + q4 * 8;
            f32x4 acc = (f32x4){0.f, 0.f, 0.f, 0.f};
#pragma unroll
            for (int ks = 0; ks < 4; ++ks) acc = __builtin_amdgcn_mfma_f32_16x16x32_bf16(*(const LAS bf16x8*)(Ap + ks * 32), *(const LAS bf16x8*)(Bp + ks * 32), acc, 0, 0, 0);
            const int j = tj * 16 + l16;
#pragma unroll
            for (int d = 0; d < 2; ++d) {
                const float Gj = GV[d * 64 + j];
#pragma unroll
                for (int r = 0; r < 4; ++r) { const int i = ti * 16 + 4 * q4 + r; const float Gi = GV[d * 64 + i];
                    const float dec = __expf(fminf(Gi - Gj, 0.f));
                    if (mat == 0) { const bool ok = d == 0 ? (j < i) : (j > i); const float v = ok ? GV[128 + d * 64 + i] * acc[r] * dec : 0.f;
                        const int ii = d == 0 ? i : 63 - i, jx = d == 0 ? j : 63 - j; AM[d * 4160 + ii * 65 + jx] = v; }
                    else { const bool ok = d == 0 ? (j <= i) : (j >= i); const float v = ok ? acc[r] * dec : 0.f; AT[d * 4608 + i * 72 + j] = (bf16)(pk2(v, 0.f) & 0xffffu); }
                }
            }
        }
        __syncthreads();
        if (wave < 2) {
            const int d = wave; LAS float* A = AM + d * 4160; LAS float* X = XM + d * 4160; LAS float* TW = TMPW + d * 272;
            for (int r = 0; r < 64; ++r) X[r * 65 + lane] = 0.f;
            LDS_WAIT();
            { const int blk = q4, c = l16; const LAS float* Ab = A + (blk * 16) * 65 + blk * 16; float xv[16];
#pragma unroll
                for (int r = 0; r < 16; ++r) { float s = (r == c) ? 1.f : 0.f;
#pragma unroll
                    for (int m = 0; m < r; ++m) s -= Ab[r * 65 + m] * xv[m];
                    xv[r] = s; }
#pragma unroll
                for (int r = 0; r < 16; ++r) X[(blk * 16 + r) * 65 + blk * 16 + c] = xv[r];
            }
            LDS_WAIT();
#pragma unroll
            for (int dd = 1; dd <= 3; ++dd)
#pragma unroll
                for (int a = dd; a <= 3; ++a) { const int bq = a - dd;
                    f32x4 acc = (f32x4){0.f, 0.f, 0.f, 0.f};
#pragma unroll
                    for (int cc2 = bq; cc2 < a; ++cc2)
#pragma unroll
                        for (int kk = 0; kk < 4; ++kk) { const float av = A[(a * 16 + l16) * 65 + cc2 * 16 + 4 * kk + q4], bv = X[(cc2 * 16 + 4 * kk + q4) * 65 + bq * 16 + l16];
                            acc = __builtin_amdgcn_mfma_f32_16x16x4f32(av, bv, acc, 0, 0, 0); }
#pragma unroll
                    for (int r = 0; r < 4; ++r) TW[(4 * q4 + r) * 17 + l16] = acc[r];
                    LDS_WAIT();
                    f32x4 acc2 = (f32x4){0.f, 0.f, 0.f, 0.f};
#pragma unroll
                    for (int kk = 0; kk < 4; ++kk) { const float av = X[(a * 16 + l16) * 65 + a * 16 + 4 * kk + q4], bv = TW[(4 * kk + q4) * 17 + l16];
                        acc2 = __builtin_amdgcn_mfma_f32_16x16x4f32(av, bv, acc2, 0, 0, 0); }
#pragma unroll
                    for (int r = 0; r < 4; ++r) X[(a * 16 + 4 * q4 + r) * 65 + bq * 16 + l16] = -acc2[r];
                    LDS_WAIT();
                }
        } else {
            const int t6 = tid - 128;
            for (int idx = t6; idx < 1024; idx += 384) { const int d = idx >> 9, e = idx & 511, rb = e >> 7, ks = (e >> 6) & 1, ln = e & 63, i = rb * 16 + (ln & 15), j0 = ks * 32 + (ln >> 4) * 8;
                *(u32x4*)(pu + PO_A + d * 8192 + e * 16) = *(const LAS u32x4*)(AT + d * 4608 + i * 72 + j0); }
            for (int e = t6; e < 1024; e += 384) { const int mb = e >> 7, ks = (e >> 6) & 1, ln = e & 63, m = mb * 16 + (ln & 15), kk0 = ks * 32 + (ln >> 4) * 8;
                unsigned short kv[8];
#pragma unroll
                for (int jj = 0; jj < 8; ++jj) kv[jj] = KL[(kk0 + jj) * 136 + m];
                u32x4 w; w.x = kv[0] | ((unsigned)kv[1] << 16); w.y = kv[2] | ((unsigned)kv[3] << 16); w.z = kv[4] | ((unsigned)kv[5] << 16); w.w = kv[6] | ((unsigned)kv[7] << 16);
                *(u32x4*)(pu + PO_KT + e * 16) = w; }
            for (int e = t6; e < 2048; e += 384) { const int nt = e >> 8, rb = (e >> 6) & 3, ln = e & 63, col = nt * 16 + (ln & 15), row0 = rb * 16 + 4 * (ln >> 4);
                const unsigned v0 = VL[(row0 + 0) * 136 + col], v1 = VL[(row0 + 1) * 136 + col], v2 = VL[(row0 + 2) * 136 + col], v3 = VL[(row0 + 3) * 136 + col];
                u32x2 w; w.x = v0 | (v1 << 16); w.y = v2 | (v3 << 16);
                *(u32x2*)(pu + PO_V + e * 8) = w; }
        }
        __syncthreads();
#pragma unroll
        for (int rep = 0; rep < 2; ++rep) { const int idx = rep * NTHR + tid, d = idx >> 9, e = idx & 511, rb = e >> 7, ks = (e >> 6) & 1, ln = e & 63, i = rb * 16 + (ln & 15), j0 = ks * 32 + (ln >> 4) * 8;
            float tv[8];
#pragma unroll
            for (int jj = 0; jj < 8; ++jj) tv[jj] = d == 0 ? XM[i * 65 + j0 + jj] : XM[4160 + (63 - i) * 65 + (63 - (j0 + jj))];
            u32x4 w; w.x = pk2(tv[0], tv[1]); w.y = pk2(tv[2], tv[3]); w.z = pk2(tv[4], tv[5]); w.w = pk2(tv[6], tv[7]);
            *(u32x4*)(pu + PO_T + d * 8192 + e * 16) = w;
        }
        __syncthreads();
    }
}

constexpr int SNT = 8;
constexpr size_t WS_SLOC = WS_R1 + 212 * MiB, WS_PMAT = WS_SLOC + 16 * MiB, WS_SST = WS_PMAT + 16 * MiB;
__device__ __forceinline__ int sb_lo(int j) { return j < 4 ? 17 * j : 68 + 16 * (j - 4); }
struct ScanRegs { bf16x8 kqA[4], kqB[4]; bf16x8 kt[2], ta[2]; f32x4 eg; float gl; u32x2 vv[SNT]; f32x4 be, kd; };
struct ScanAddr { const unsigned char* pu; const float* vd; };
__device__ __forceinline__ ScanAddr scan_addr(const unsigned char* ws, int d, int b, int h, int s) {
    const int cn = d == 0 ? s : (s < 4 ? 3 - s : 263 - s);
    const int u = (b * NCH + cn) * NH + h;
    ScanAddr a; a.pu = ws + WS_PREP + (size_t)u * PREP_UNIT; a.vd = (const float*)(ws + WS_VEC) + (size_t)u * 512 + d * 256; return a;
}
template <bool OUT> __device__ __forceinline__ void ld_kq(bf16x8 (&kq)[4], const ScanAddr& a, int w, int lane) {
    const int rb = OUT ? w : (w & 3);
#pragma unroll
    for (int ks = 0; ks < 4; ++ks) kq[ks] = *(const bf16x8*)(a.pu + PO_KQ + ((rb * 4 + ks) * 64 + lane) * 16);
}
template <bool HASV, bool OUT> __device__ __forceinline__ void ld_p1(ScanRegs& R, const ScanAddr& a, int w, int lane) {
    const int r0 = 16 * (w & 3) + 4 * (lane >> 4);
    R.eg = *(const f32x4*)(a.vd + r0); R.be = *(const f32x4*)(a.vd + 64 + r0);
    if (HASV) { const int nt0 = OUT ? 0 : 4 * (w >> 2);
#pragma unroll
        for (int i = 0; i < (OUT ? SNT : SNT / 2); ++i) R.vv[i] = *(const u32x2*)(a.pu + PO_V + (((nt0 + i) * 4 + (w & 3)) * 64 + lane) * 8); }
}
template <bool OUT> __device__ __forceinline__ void ld_ta(ScanRegs& R, const ScanAddr& a, int d, int w, int lane) {
    const int tao = ((OUT && w >= 4) ? PO_A : PO_T) + d * 8192;
#pragma unroll
    for (int ks = 0; ks < 2; ++ks) R.ta[ks] = *(const bf16x8*)(a.pu + tao + (((w & 3) * 2 + ks) * 64 + lane) * 16);
}
__device__ __forceinline__ void ld_p3(ScanRegs& R, const ScanAddr& a, int w, int lane) {
#pragma unroll
    for (int ks = 0; ks < 2; ++ks) R.kt[ks] = *(const bf16x8*)(a.pu + PO_KT + ((w * 2 + ks) * 64 + lane) * 16);
    R.gl = a.vd[192];
}
template <bool HASV, bool OUT, int PAR>
__device__ __forceinline__ void scan_step(ScanRegs& R, f32x4 (&S)[SNT], LAS bf16* ST, LAS bf16* TT, LAS bf16* VN, LAS bf16* VS, bf16* Od, int col0,
                                          const unsigned char* ws, int d, int b, int h, int s, int s1, int w, int lane) {
    constexpr int NTW = OUT ? SNT : SNT / 2;
    const int l16 = lane & 15, q4 = lane >> 4, rowo = 16 * (w & 3) + 4 * q4, nt0 = OUT ? 0 : 4 * (w >> 2);
    const bool kwave = !OUT || w < 4;
    const int sn1 = s + 1 < s1 ? s + 1 : s1 - 1, sn2 = s + 2 < s1 ? s + 2 : s1 - 1;
    const ScanAddr a1 = scan_addr(ws, d, b, h, sn1);
    bf16x8 (&kq)[4] = PAR ? R.kqB : R.kqA;
    bf16x8 fb[2][8];
    f32x4 a1v[NTW];
    {
#define RD1(c_) do { _Pragma("unroll") for (int i_ = 0; i_ < 8; ++i_) fb[(c_) & 1][i_] = *(const LAS bf16x8*)(ST + ((nt0 + 2 * (c_) + (i_ >> 2)) * 16 + l16) * 136 + (i_ & 3) * 32 + q4 * 8); } while (0)
        RD1(0);
#pragma unroll
        for (int c = 0; c < NTW / 2; ++c) {
            if (c + 1 < NTW / 2) RD1(c + 1);
            __builtin_amdgcn_sched_barrier(0);
#pragma unroll
            for (int j = 0; j < 2; ++j) { f32x4 acc = (f32x4){0.f, 0.f, 0.f, 0.f};
#pragma unroll
                for (int ks = 0; ks < 4; ++ks) acc = __builtin_amdgcn_mfma_f32_16x16x32_bf16(kq[ks], fb[c & 1][j * 4 + ks], acc, 0, 0, 0);
                a1v[2 * c + j] = acc; }
            __builtin_amdgcn_sched_barrier(0);
        }
#undef RD1
    }
    if (kwave) {
#pragma unroll
        for (int i = 0; i < NTW; ++i) { f32x4 t;
            if (HASV) { const f32x4 v = (f32x4){bflo(R.vv[i].x), bfhi(R.vv[i].x), bflo(R.vv[i].y), bfhi(R.vv[i].y)}; t = R.be * (v - R.eg * a1v[i]); }
            else t = R.be * (R.eg * a1v[i]) * -1.f;
            u32x2 pw; pw.x = pk2(t.x, t.y); pw.y = pk2(t.z, t.w); *(LAS u32x2*)(TT + ((nt0 + i) * 16 + l16) * 72 + rowo) = pw; }
    } else {
#pragma unroll
        for (int i = 0; i < NTW; ++i) a1v[i] = R.eg * a1v[i];
    }
    { const ScanAddr a2 = scan_addr(ws, d, b, h, sn2); ld_kq<OUT>(kq, a2, w, lane); ld_p1<HASV, OUT>(R, a1, w, lane); }
    __syncthreads();
#define RD2(BUF, t0_, c_) do { _Pragma("unroll") for (int i_ = 0; i_ < 8; ++i_) fb[(c_) & 1][i_] = *(const LAS bf16x8*)(BUF + (((t0_) + 4 * (c_) + (i_ >> 1)) * 16 + l16) * 72 + (i_ & 1) * 32 + q4 * 8); } while (0)
    if (kwave) {
        RD2(TT, nt0, 0);
#pragma unroll
        for (int c = 0; c < NTW / 4; ++c) {
            if (c + 1 < NTW / 4) RD2(TT, nt0, c + 1);
            __builtin_amdgcn_sched_barrier(0);
#pragma unroll
            for (int j = 0; j < 4; ++j) { const int nt = nt0 + 4 * c + j; f32x4 vn = (f32x4){0.f, 0.f, 0.f, 0.f};
#pragma unroll
                for (int ks = 0; ks < 2; ++ks) vn = __builtin_amdgcn_mfma_f32_16x16x32_bf16(R.ta[ks], fb[c & 1][j * 2 + ks], vn, 0, 0, 0);
                const f32x4 vs = R.kd * vn;
                u32x2 pw; pw.x = pk2(vn.x, vn.y); pw.y = pk2(vn.z, vn.w); *(LAS u32x2*)(VN + (nt * 16 + l16) * 72 + rowo) = pw;
                u32x2 ps; ps.x = pk2(vs.x, vs.y); ps.y = pk2(vs.z, vs.w); *(LAS u32x2*)(VS + (nt * 16 + l16) * 72 + rowo) = ps; }
            __builtin_amdgcn_sched_barrier(0);
        }
        ld_ta<OUT>(R, a1, d, w, lane); R.kd = *(const f32x4*)(a1.vd + 128 + rowo);
    }
    __syncthreads();
    if (!kwave) {
        RD2(VN, 0, 0);
#pragma unroll
        for (int c = 0; c < 2; ++c) {
            if (c + 1 < 2) RD2(VN, 0, c + 1);
            __builtin_amdgcn_sched_barrier(0);
#pragma unroll
            for (int j = 0; j < 4; ++j) { const int nt = 4 * c + j;
#pragma unroll
                for (int ks = 0; ks < 2; ++ks) a1v[nt < NTW ? nt : 0] = __builtin_amdgcn_mfma_f32_16x16x32_bf16(R.ta[ks], fb[c & 1][j * 2 + ks], a1v[nt < NTW ? nt : 0], 0, 0, 0); }
            __builtin_amdgcn_sched_barrier(0);
        }
        ld_ta<OUT>(R, a1, d, w, lane);
    }
    RD2(VS, 0, 0);
#pragma unroll
    for (int c = 0; c < 2; ++c) {
        if (c + 1 < 2) RD2(VS, 0, c + 1);
        __builtin_amdgcn_sched_barrier(0);
#pragma unroll
        for (int j = 0; j < 4; ++j) { const int nt = 4 * c + j; f32x4 sv = S[nt] * R.gl;
#pragma unroll
            for (int ks = 0; ks < 2; ++ks) sv = __builtin_amdgcn_mfma_f32_16x16x32_bf16(R.kt[ks], fb[c & 1][j * 2 + ks], sv, 0, 0, 0);
            S[nt] = sv;
            u32x2 pw; pw.x = pk2(sv.x, sv.y); pw.y = pk2(sv.z, sv.w); *(LAS u32x2*)(ST + (nt * 16 + l16) * 136 + 16 * w + 4 * q4) = pw; }
        __builtin_amdgcn_sched_barrier(0);
    }
#undef RD2
    ld_p3(R, a1, w, lane);
    if (OUT && w >= 4 && s >= 4) {
        const int n = d == 0 ? s - 4 : 259 - s, trow0 = b * SEQ + n * 64;
#pragma unroll
        for (int nt = 0; nt < NTW; ++nt)
#pragma unroll
            for (int r = 0; r < 4; ++r) Od[(size_t)(trow0 + rowo + r) * 512 + col0 + nt * 16 + l16] = (bf16)(pk2(a1v[nt][r], 0.f) & 0xffffu); }
    __syncthreads();
}
template <int KIND>
__device__ __forceinline__ void scan_run(const Fr& F, int chain, int j) {
    int tid_ = F.tid; asm volatile("" : "+v"(tid_));
    const int d = chain >> 3, b = (chain >> 2) & 1, h = chain & 3, w = __builtin_amdgcn_readfirstlane(tid_ >> 6), lane = tid_ & 63, l16 = lane & 15, q4 = lane >> 4;
    LAS bf16* ST = (LAS bf16*)F.lds; LAS bf16* TT = ST + SNT * 16 * 136; LAS bf16* VN = TT + SNT * 16 * 72; LAS bf16* VS = VN + SNT * 16 * 72;
    f32x4 S[SNT];
    const size_t sidx = ((size_t)chain * 16 + j) * 16384;
#pragma unroll
    for (int nt = 0; nt < SNT; ++nt) {
        if (KIND == 0) S[nt] = (f32x4){0.f, 0.f, 0.f, 0.f};
        else if (KIND == 1) { const int col = nt * 16 + l16;
#pragma unroll
            for (int r = 0; r < 4; ++r) S[nt][r] = (16 * w + 4 * q4 + r == col) ? 1.f : 0.f; }
        else S[nt] = j == 0 ? (f32x4){0.f, 0.f, 0.f, 0.f} : *(const f32x4*)(WSP(float, WS_SST) + sidx + ((nt * 8 + w) * 64 + lane) * 4);
        u32x2 pw; pw.x = pk2(S[nt].x, S[nt].y); pw.y = pk2(S[nt].z, S[nt].w); *(LAS u32x2*)(ST + (nt * 16 + l16) * 136 + 16 * w + 4 * q4) = pw; }
    __syncthreads();
    bf16* Od = WSP(bf16, WS_O) + (size_t)d * T * 512; const int col0 = h * 128;
    const int s0 = sb_lo(j), s1 = sb_lo(j + 1);
    ScanRegs R;
    { const ScanAddr a0 = scan_addr(F.ws, d, b, h, s0), a1 = scan_addr(F.ws, d, b, h, s0 + 1 < s1 ? s0 + 1 : s1 - 1);
        ld_kq<KIND == 2>(R.kqA, a0, w, lane); ld_p1<KIND != 1, KIND == 2>(R, a0, w, lane); ld_ta<KIND == 2>(R, a0, d, w, lane); R.kd = *(const f32x4*)(a0.vd + 128 + 16 * (w & 3) + 4 * q4); ld_p3(R, a0, w, lane);
        ld_kq<KIND == 2>(R.kqB, a1, w, lane); }
    for (int s = s0; s < s1; s += 2) {
        scan_step<KIND != 1, KIND == 2, 0>(R, S, ST, TT, VN, VS, Od, col0, F.ws, d, b, h, s, s1, w, lane);
        if (s + 1 < s1) scan_step<KIND != 1, KIND == 2, 1>(R, S, ST, TT, VN, VS, Od, col0, F.ws, d, b, h, s + 1, s1, w, lane);
    }
    if (KIND == 0) {
#pragma unroll
        for (int nt = 0; nt < SNT; ++nt) *(f32x4*)(WSP(float, WS_SLOC) + sidx + ((nt * 8 + w) * 64 + lane) * 4) = S[nt];
    } else if (KIND == 1) { bf16* Pm = WSP(bf16, WS_PMAT) + sidx;
#pragma unroll
        for (int nt = 0; nt < SNT; ++nt)
#pragma unroll
            for (int r = 0; r < 4; ++r) Pm[(16 * w + 4 * q4 + r) * 128 + nt * 16 + l16] = (bf16)(pk2(S[nt][r], 0.f) & 0xffffu);
    }
    __syncthreads();
}
__device__ __forceinline__ void scan_combine(const Fr& F, int cu) {
    const int chain = cu >> 3, nt = cu & 7, w = F.wave, lane = F.lane, l16 = lane & 15, q4 = lane >> 4;
    LAS bf16* ST = (LAS bf16*)F.lds;
    f32x4 S = (f32x4){0.f, 0.f, 0.f, 0.f};
    { u32x2 z; z.x = 0u; z.y = 0u; *(LAS u32x2*)(ST + l16 * 136 + 16 * w + 4 * q4) = z; }
    __syncthreads();
    bf16x8 pa[4]; f32x4 sl;
#define SC2_LOAD(j_) do { const size_t si_ = ((size_t)chain * 16 + (j_)) * 16384; const bf16* Pm_ = WSP(bf16, WS_PMAT) + si_; \
        _Pragma("unroll") for (int ks = 0; ks < 4; ++ks) pa[ks] = *(const bf16x8*)(Pm_ + (16 * w + l16) * 128 + ks * 32 + q4 * 8); \
        sl = *(const f32x4*)(WSP(float, WS_SLOC) + si_ + ((nt * 8 + w) * 64 + lane) * 4); } while (0)
    SC2_LOAD(0);
    for (int j = 0; j < 15; ++j) {
        f32x4 acc = sl;
#pragma unroll
        for (int ks = 0; ks < 4; ++ks) acc = __builtin_amdgcn_mfma_f32_16x16x32_bf16(pa[ks], *(const LAS bf16x8*)(ST + l16 * 136 + ks * 32 + q4 * 8), acc, 0, 0, 0);
        S = acc;
        if (j + 1 < 15) SC2_LOAD(j + 1);
        *(f32x4*)(WSP(float, WS_SST) + ((size_t)chain * 16 + j + 1) * 16384 + ((nt * 8 + w) * 64 + lane) * 4) = S;
        __syncthreads();
        { u32x2 pw; pw.x = pk2(S.x, S.y); pw.y = pk2(S.z, S.w); *(LAS u32x2*)(ST + l16 * 136 + 16 * w + 4 * q4) = pw; }
        __syncthreads();
    }
#undef SC2_LOAD
}
__device__ __forceinline__ void p4_sgu(const Fr& F, int worker, int nworkers, int u_lo, int u_hi) {
    const bf16* P = WSP(bf16, WS_P); bf16* MIX = WSP(bf16, WS_MIX);
    const float* lng = F.in[12]; const float* lnb = F.in[13]; const float* sw = F.in[14]; const float* sb = F.in[15];
    LAS bf16* VT = (LAS bf16*)F.lds;
    for (int u = u_lo + worker; u < u_hi; u += nworkers) {
        int tid = F.tid; asm volatile("" : "+v"(tid));
        const int lane = tid & 63, wave = __builtin_amdgcn_readfirstlane(tid >> 6), l16 = lane & 15, q4 = lane >> 4;
        const int g = u & 3, ch = u >> 2, row00 = ch * 128;
#pragma unroll
        for (int it = 0; it < 4; ++it) { const int item = it * NTHR + tid, cg = item & 15, row = item >> 4;
            const u32x4 xv = *(const u32x4*)(P + (size_t)(row00 + row) * NPROJ + PC_V + g * 128 + cg * 8);
            float v[8]; v[0] = bflo(xv.x); v[1] = bfhi(xv.x); v[2] = bflo(xv.y); v[3] = bfhi(xv.y); v[4] = bflo(xv.z); v[5] = bfhi(xv.z); v[6] = bflo(xv.w); v[7] = bfhi(xv.w);
            float s = 0.f;
#pragma unroll
            for (int e = 0; e < 8; ++e) { v[e] = gelu_t(v[e]); s += v[e]; }
            const float mean = sum16(s) * (1.f / 128.f); float q = 0.f;
#pragma unroll
            for (int e = 0; e < 8; ++e) { v[e] -= mean; q += v[e] * v[e]; }
            const float rstd = rsqrtf(sum16(q) * (1.f / 128.f) + EPS);
#pragma unroll
            for (int e = 0; e < 8; ++e) { const int c = cg * 8 + e; const float y = v[e] * rstd * lng[g * 128 + c] + lnb[g * 128 + c]; VT[c * 136 + ((((row >> 3) ^ cg) << 3) | (row & 7))] = (bf16)(pk2(y, 0.f) & 0xffffu); }
        }
        __syncthreads();
        bf16x8 wf[4];
#pragma unroll
        for (int ks = 0; ks < 4; ++ks) { const float* wp = sw + (size_t)g * 16384 + (wave * 16 + l16) * 128 + ks * 32 + q4 * 8; const f32x4 a = *(const f32x4*)wp, bq = *(const f32x4*)(wp + 4);
            u32x4 t; t.x = pk2(a.x, a.y); t.y = pk2(a.z, a.w); t.z = pk2(bq.x, bq.y); t.w = pk2(bq.z, bq.w); wf[ks] = __builtin_bit_cast(bf16x8, t); }
        const int prow = wave * 16 + l16; const float bs = sb[g * 128 + prow];
        u32x2 uq[8];
#pragma unroll
        for (int ct = 0; ct < 8; ++ct) uq[ct] = *(const u32x2*)(P + (size_t)(row00 + prow) * NPROJ + PC_U + g * 128 + ct * 16 + 4 * q4);
#pragma unroll
        for (int ct = 0; ct < 8; ++ct) { f32x4 acc = (f32x4){0.f, 0.f, 0.f, 0.f};
#pragma unroll
            for (int ks = 0; ks < 4; ++ks) acc = __builtin_amdgcn_mfma_f32_16x16x32_bf16(*(const LAS bf16x8*)(VT + (ct * 16 + l16) * 136 + (((ks * 4 + q4) ^ (ct * 2 + (l16 >> 3))) << 3)), wf[ks], acc, 0, 0, 0);
            const int c0 = ct * 16 + 4 * q4;
            const u32x2 uv = uq[ct];
            const float o0 = gelu_t(bflo(uv.x)) * (acc[0] + bs), o1 = gelu_t(bfhi(uv.x)) * (acc[1] + bs), o2 = gelu_t(bflo(uv.y)) * (acc[2] + bs), o3 = gelu_t(bfhi(uv.y)) * (acc[3] + bs);
            u32x2 w; w.x = pk2(o0, o1); w.y = pk2(o2, o3); if (DBG_MODE == 3) w = (u32x2){0u, 0u}; *(u32x2*)(MIX + (size_t)(row00 + prow) * D + 512 + g * 128 + c0) = w; }
        __syncthreads();
    }
}

__device__ __forceinline__ void p5_gdn_out(const Fr& F) {
    const bf16* P = WSP(bf16, WS_P); const bf16* O = WSP(bf16, WS_O); bf16* MIX = WSP(bf16, WS_MIX); const float* gng = F.in[11];
    const int gw = F.wg * NWAVES + F.wave, NGW = F.G * NWAVES, lane = F.lane;
    const f32x4 g0 = *(const f32x4*)(gng + (lane & 15) * 8), g1 = *(const f32x4*)(gng + (lane & 15) * 8 + 4);
    const float gg[8] = {g0.x, g0.y, g0.z, g0.w, g1.x, g1.y, g1.z, g1.w};
    for (int blk = gw; blk < T / 16; blk += NGW) {
        const int t0 = blk * 16;
        u32x4 a = *(const u32x4*)(O + (size_t)t0 * 512 + lane * 8), bq = *(const u32x4*)(O + (size_t)(T + t0) * 512 + lane * 8), z = *(const u32x4*)(P + (size_t)t0 * NPROJ + PC_Z + lane * 8);
#pragma clang loop unroll(disable)
        for (int i = 0; i < 16; ++i) {
            const int t = t0 + i, tn = t0 + (i + 1 < 16 ? i + 1 : i);
            const u32x4 an = *(const u32x4*)(O + (size_t)tn * 512 + lane * 8), bn = *(const u32x4*)(O + (size_t)(T + tn) * 512 + lane * 8), zn = *(const u32x4*)(P + (size_t)tn * NPROJ + PC_Z + lane * 8);
            float o[8]; o[0] = bflo(a.x) + bflo(bq.x); o[1] = bfhi(a.x) + bfhi(bq.x); o[2] = bflo(a.y) + bflo(bq.y); o[3] = bfhi(a.y) + bfhi(bq.y);
            o[4] = bflo(a.z) + bflo(bq.z); o[5] = bfhi(a.z) + bfhi(bq.z); o[6] = bflo(a.w) + bflo(bq.w); o[7] = bfhi(a.w) + bfhi(bq.w);
            float ss = 0.f;
#pragma unroll
            for (int e = 0; e < 8; ++e) ss += o[e] * o[e];
            const float rstd = rsqrtf(sum16(ss) * (1.f / 128.f) + EPS);
            const float zz[8] = {bflo(z.x), bfhi(z.x), bflo(z.y), bfhi(z.y), bflo(z.z), bfhi(z.z), bflo(z.w), bfhi(z.w)};
            float r[8];
#pragma unroll
            for (int e = 0; e < 8; ++e) r[e] = o[e] * rstd * gg[e] * silu_(zz[e]);
            u32x4 w; w.x = pk2(r[0], r[1]); w.y = pk2(r[2], r[3]); w.z = pk2(r[4], r[5]); w.w = pk2(r[6], r[7]);
            if (DBG_MODE == 2) w = (u32x4){0u, 0u, 0u, 0u};
            *(u32x4*)(MIX + (size_t)t * D + lane * 8) = w;
            a = an; bq = bn; z = zn;
        }
    }
}

__device__ __forceinline__ void p7_mid(const Fr& F) {
    const float* x = F.in[0]; const float* ng = F.in[6]; const float* MOD = WSP(float, WS_MOD); const bf16* R = WSP(bf16, WS_R); const float* rbias = F.in[18];
    bf16* X1 = WSP(bf16, WS_X1); unsigned char* H2 = WSP(unsigned char, WS_H2);
    LAS bf16* HI = (LAS bf16*)F.lds; LAS bf16* LO = HI + 16 * 1032; LAS float* PART = (LAS float*)(F.lds + 66048);
    LAS int* ENT_E = (LAS int*)(F.lds + 83968); LAS int* ENT_R = ENT_E + 1024; LAS int* CNT = ENT_R + 1024; LAS int* BASE = CNT + 32;
    const int tid = F.tid, lane = F.lane, wave = F.wave, l16 = lane & 15, q4 = lane >> 4;
    if (tid < 32) CNT[tid] = 0;
    { int* RT = WSP(int, WS_ROWTOK); const int per = (MAXROWS + F.G - 1) / F.G; for (int i = tid; i < per; i += NTHR) { const int r = F.wg * per + i; if (r < MAXROWS) RT[r] = 0; } }
    const int TPW = T / F.G, t0 = F.wg * TPW;
    LAS float* AV = (LAS float*)(F.lds + 92672); LAS float* BV = AV + 1024; LAS float* CV = BV + 1024;
    { const float* mb = MOD + (t0 >> 14) * 6144;
        for (int k = tid; k < 1024; k += NTHR) { AV[k] = mb[2048 + k] * ng[1024 + k]; BV[k] = ng[2048 + k] * (mb[4096 + k] + 1.f); CV[k] = mb[3072 + k]; } }
    const float my_rbias = rbias[tid & 31];
    bf16x8 wh[4][2], wl[4][2];
    { const float* WRT = WSP(float, WS_WRT);
#pragma unroll
        for (int ks = 0; ks < 4; ++ks)
#pragma unroll
            for (int nt = 0; nt < 2; ++nt) { const float* wp = WRT + (size_t)(nt * 16 + l16) * 1024 + wave * 128 + ks * 32 + q4 * 8; const f32x4 a = *(const f32x4*)wp, b = *(const f32x4*)(wp + 4);
                u32x4 h; h.x = pk2(a.x, a.y); h.y = pk2(a.z, a.w); h.z = pk2(b.x, b.y); h.w = pk2(b.z, b.w);
                u32x4 l; l.x = pk2(a.x - bflo(h.x), a.y - bfhi(h.x)); l.y = pk2(a.z - bflo(h.y), a.w - bfhi(h.y)); l.z = pk2(b.x - bflo(h.z), b.y - bfhi(h.z)); l.w = pk2(b.z - bflo(h.w), b.w - bfhi(h.w));
                wh[ks][nt] = __builtin_bit_cast(bf16x8, h); wl[ks][nt] = __builtin_bit_cast(bf16x8, l); } }
    __syncthreads();
    u32x2 rq[2][4]; f32x4 xq[2][4];
#define P7_LOAD(tile_) do { _Pragma("unroll") for (int sub_ = 0; sub_ < 2; ++sub_) { const int t_ = t0 + (tile_) * 16 + 2 * wave + sub_; \
        _Pragma("unroll") for (int j_ = 0; j_ < 4; ++j_) { rq[sub_][j_] = *(const u32x2*)(R + (size_t)t_ * D + 256 * j_ + 4 * lane); xq[sub_][j_] = *(const f32x4*)(x + (size_t)t_ * D + 256 * j_ + 4 * lane); } } } while (0)
    P7_LOAD(0);
    for (int tile = 0; tile < TPW / 16; ++tile) {
        f32x4 hq[2][4];
#pragma unroll
        for (int sub = 0; sub < 2; ++sub) {
            f32x4 rv[4]; float ss = 0.f;
#pragma unroll
            for (int j = 0; j < 4; ++j) { const u32x2 rw = rq[sub][j]; rv[j] = (f32x4){bflo(rw.x), bfhi(rw.x), bflo(rw.y), bfhi(rw.y)};
                ss += (rv[j].x * rv[j].x + rv[j].y * rv[j].y) + (rv[j].z * rv[j].z + rv[j].w * rv[j].w); }
            const float rstd1 = rsqrtf(wave_sum(ss) * (1.f / D) + EPS);
            f32x4 xv[4]; float s2 = 0.f;
#pragma unroll
            for (int j = 0; j < 4; ++j) { const int k = 256 * j + 4 * lane; const f32x4 av = *(const LAS f32x4*)(AV + k);
                xv[j] = xq[sub][j] + av * (rv[j] * rstd1);
                s2 += (xv[j].x * xv[j].x + xv[j].y * xv[j].y) + (xv[j].z * xv[j].z + xv[j].w * xv[j].w); }
            const float rstd2 = rsqrtf(wave_sum(s2) * (1.f / D) + EPS);
#pragma unroll
            for (int j = 0; j < 4; ++j) { const int k = 256 * j + 4 * lane; const f32x4 bv = *(const LAS f32x4*)(BV + k), cv = *(const LAS f32x4*)(CV + k);
                hq[sub][j] = xv[j] * rstd2 * bv + cv; xq[sub][j] = xv[j]; }
        }
#pragma unroll
        for (int sub = 0; sub < 2; ++sub) { const int tr = 2 * wave + sub, t = t0 + tile * 16 + tr;
#pragma unroll
            for (int j = 0; j < 4; ++j) { const int k = 256 * j + 4 * lane; const f32x4 hv = hq[sub][j];
                { u32x2 x1w; x1w.x = pk2(xq[sub][j].x, xq[sub][j].y); x1w.y = pk2(xq[sub][j].z, xq[sub][j].w); *(u32x2*)(X1 + (size_t)t * D + k) = x1w; }
                u32x2 o; o.x = pk2(hv.x, hv.y); o.y = pk2(hv.z, hv.w); *(unsigned*)(H2 + (size_t)t * D + k) = pk_fp8x4(hv.x, hv.y, hv.z, hv.w);
                u32x2 lo; lo.x = pk2(hv.x - bflo(o.x), hv.y - bfhi(o.x)); lo.y = pk2(hv.z - bflo(o.y), hv.w - bfhi(o.y));
                *(LAS u32x2*)(HI + tr * 1032 + k) = o; *(LAS u32x2*)(LO + tr * 1032 + k) = lo; } }
        if (tile + 1 < TPW / 16) P7_LOAD(tile + 1);
        __syncthreads();
        { f32x4 acc[2]; acc[0] = (f32x4){0.f, 0.f, 0.f, 0.f}; acc[1] = acc[0];
#pragma unroll
            for (int ks = 0; ks < 4; ++ks) { const int ko = l16 * 1032 + wave * 128 + ks * 32 + q4 * 8;
                const bf16x8 ah = *(const LAS bf16x8*)(HI + ko), al = *(const LAS bf16x8*)(LO + ko);
#pragma unroll
                for (int nt = 0; nt < 2; ++nt) { acc[nt] = __builtin_amdgcn_mfma_f32_16x16x32_bf16(ah, wh[ks][nt], acc[nt], 0, 0, 0);
                    acc[nt] = __builtin_amdgcn_mfma_f32_16x16x32_bf16(al, wh[ks][nt], acc[nt], 0, 0, 0);
                    acc[nt] = __builtin_amdgcn_mfma_f32_16x16x32_bf16(ah, wl[ks][nt], acc[nt], 0, 0, 0); } }
#pragma unroll
            for (int nt = 0; nt < 2; ++nt)
#pragma unroll
                for (int r = 0; r < 4; ++r) PART[(wave * 16 + 4 * q4 + r) * 33 + nt * 16 + l16] = acc[nt][r]; }
        __syncthreads();
        { const int tok = tid >> 5, me = tid & 31, t = t0 + tile * 16 + tok;
            float logit = my_rbias;
#pragma unroll
            for (int w = 0; w < 8; ++w) logit += PART[(w * 16 + tok) * 33 + me];
            float tv[4]; int ti[4];
#pragma unroll
            for (int k = 0; k < 4; ++k) { float bv = logit; int bi = me;
#define P7_AMAX(OV, OI) do { const float ov_ = (OV); const int oi_ = (OI); const bool tk_ = (ov_ > bv) | ((ov_ == bv) & (oi_ < bi)); bv = tk_ ? ov_ : bv; bi = tk_ ? oi_ : bi; } while (0)
                P7_AMAX(DPP_MOV(bv, 0xB1), __builtin_amdgcn_update_dpp(0, bi, 0xB1, 0xf, 0xf, true));
                P7_AMAX(DPP_MOV(bv, 0x4E), __builtin_amdgcn_update_dpp(0, bi, 0x4E, 0xf, 0xf, true));
                P7_AMAX(DPP_MOV(bv, 0x124), __builtin_amdgcn_update_dpp(0, bi, 0x124, 0xf, 0xf, true));
                P7_AMAX(DPP_MOV(bv, 0x128), __builtin_amdgcn_update_dpp(0, bi, 0x128, 0xf, 0xf, true));
                P7_AMAX(__shfl_xor(bv, 16), __shfl_xor(bi, 16));
#undef P7_AMAX
                tv[k] = bv; ti[k] = bi; if (me == bi) logit = -3.0e38f; }
            const float e1 = __expf(tv[1] - tv[0]), e2 = __expf(tv[2] - tv[0]), e3 = __expf(tv[3] - tv[0]), inv = 1.f / (1.f + e1 + e2 + e3);
            if (me == 0) { const float gt[4] = {inv, e1 * inv, e2 * inv, e3 * inv}; float* TG = WSP(float, WS_TKGATE); const int tl = tile * 16 + tok;
#pragma unroll
                for (int k = 0; k < 4; ++k) { const int rk = atomicAdd((int*)&CNT[ti[k]], 1); ENT_E[tl * 4 + k] = ti[k]; ENT_R[tl * 4 + k] = rk; TG[(size_t)t * 4 + k] = gt[k]; } }
        }
    }
#undef P7_LOAD
    __syncthreads();
    if (tid < 32) BASE[tid] = (int)__hip_atomic_fetch_add(WSP(unsigned, WS_CTL) + CW_GCNT + 64 * tid, (unsigned)CNT[tid], __ATOMIC_RELAXED, __HIP_MEMORY_SCOPE_AGENT);
    __syncthreads();
    int* TE = WSP(int, WS_TKE); int* TR = WSP(int, WS_TKRANK);
    for (int i = tid; i < TPW * 4; i += NTHR) { const int e = ENT_E[i]; TE[(size_t)t0 * 4 + i] = e; TR[(size_t)t0 * 4 + i] = BASE[e] + ENT_R[i]; }
}

__device__ __forceinline__ void moe_tables(const Fr& F) {
    LAS int* NPL = (LAS int*)(F.lds + LDS_TAB); LAS int* RB = NPL + 32; LAS int* NPAN = NPL + 64; LAS int* PEXP = NPL + 128;
    if (F.tid < 32) NPL[F.tid] = ((int)__hip_atomic_load(WSP(unsigned, WS_CTL) + CW_GCNT + 64 * F.tid, __ATOMIC_RELAXED, __HIP_MEMORY_SCOPE_AGENT) + 255) >> 8;
    __syncthreads();
    if (F.tid < 32) { int s = 0; for (int e = 0; e < F.tid; ++e) s += NPL[e]; RB[F.tid] = s * 256; if (F.tid == 31) NPAN[0] = s + NPL[31];
        const int np = NPL[F.tid]; for (int p = 0; p < np; ++p) if (s + p < MAXPAN) PEXP[s + p] = F.tid; }
    __syncthreads();
}
__device__ __forceinline__ void p8_permute(const Fr& F) {
    moe_tables(F);
    const LAS int* RB = (const LAS int*)(F.lds + LDS_TAB) + 32;
    const int* TE = WSP(int, WS_TKE); const int* TR = WSP(int, WS_TKRANK); const float* TG = WSP(float, WS_TKGATE); int* TROW = WSP(int, WS_TKROW); float* RG = WSP(float, WS_ROWGATE);
    int* RT = WSP(int, WS_ROWTOK);
    const int gw = F.wg * NWAVES + F.wave, NGW = F.G * NWAVES, lane = F.lane;
    for (int blk = gw; blk < T / 16; blk += NGW) {
        const size_t a0 = (size_t)blk * 64;
        const int e = TE[a0 + lane]; int row = RB[e] + TR[a0 + lane]; row = row < MAXROWS ? row : MAXROWS - 1;
        TROW[a0 + lane] = row; RG[row] = TG[a0 + lane]; RT[row] = blk * 16 + (lane >> 2);
    }
}
struct MoeOrder {
    int nM, nN, nwg, G, c; const LAS int* pexp;
    __device__ __forceinline__ void init(int nM_, int nN_, int G_, int c_, const LAS int* pexp_) { nM = nM_; nN = nN_; nwg = nM * nN; G = G_; c = c_; pexp = pexp_; }
    __device__ __forceinline__ bool next(int i, pg8::Unit& u) const {
        const long L = (long)i * G + c; if (L >= nwg) return false;
        int wgid = (int)L; { const int q = nwg / pg8::NXCD, r = nwg % pg8::NXCD, xcd = wgid % pg8::NXCD, off = wgid / pg8::NXCD; wgid = (xcd < r ? xcd * (q + 1) : r * (q + 1) + (xcd - r) * q) + off; }
        const int nig = pg8::WGM * nN, gid = wgid / nig, fm = gid * pg8::WGM, gsz = (nM - fm) < pg8::WGM ? (nM - fm) : pg8::WGM;
        u.pm = fm + ((wgid % nig) % gsz); u.pn = pexp[u.pm] * nN + (wgid % nig) / gsz; return true;
    }
    __device__ __forceinline__ void a_ready(const pg8::Unit&) const {}
    __device__ __forceinline__ void done(const pg8::Unit&) const {}
};
struct EpiStore {
    static constexpr bool PERM = true, AFTER_DRAIN = false;
    bf16* O; int ldc;
    __device__ __forceinline__ void operator()(const pg8::f32x4 (&acc)[2][2][4][2], const pg8::Unit& u, int wr, int wc, int fr, int fq) const {
        const int row0 = u.pm * 256 + wr * 64 + fr, col0 = u.pn * 256 + wc * 32 + 8 * fq;
#pragma unroll
        for (int ai = 0; ai < 2; ++ai)
#pragma unroll
            for (int m = 0; m < 4; ++m) { bf16* rowp = O + (size_t)(row0 + ai * 128 + m * 16) * ldc + col0;
#pragma unroll
                for (int bj = 0; bj < 2; ++bj) { const pg8::f32x4 v0 = acc[ai][bj][m][0], v1 = acc[ai][bj][m][1];
                    u32x4 w; w.x = pk2(v0[0], v0[1]); w.y = pk2(v0[2], v0[3]); w.z = pk2(v1[0], v1[1]); w.w = pk2(v1[2], v1[3]);
                    *(u32x4*)(rowp + bj * 128) = w; } }
    }
};
template <int EMODE = 0>
struct EpiSwiGLUT {
    static constexpr bool PERM = false, AFTER_DRAIN = false;
    unsigned char* ACT; const float* bias;
    __device__ __forceinline__ void operator()(const pg8::f32x4 (&acc)[2][2][4][2], const pg8::Unit& u, int wr, int wc, int fr, int fq) const {
        if (EMODE == 3) return;
        const int e = u.pn >> 3, pnl = u.pn & 7, row0 = u.pm * 256 + wr * 64 + fr;
        const float* bb = bias + e * 2048 + pnl * 256 + wc * 32 + 4 * fq;
        pg8::f32x4 bg[2], bu[2];
#pragma unroll
        for (int bj = 0; bj < 2; ++bj) { bg[bj] = *(const pg8::f32x4*)(bb + bj * 128); bu[bj] = *(const pg8::f32x4*)(bb + bj * 128 + 16); }
#pragma unroll
        for (int ai = 0; ai < 2; ++ai)
#pragma unroll
            for (int m = 0; m < 4; ++m) { float a[8];
#pragma unroll
                for (int bj = 0; bj < 2; ++bj) { const pg8::f32x4 gv = acc[ai][bj][m][0] * W8_INV + bg[bj], uv = acc[ai][bj][m][1] * W8_INV + bu[bj];
#pragma unroll
                    for (int j = 0; j < 4; ++j) { const float gt = fminf(gv[j], 7.f), up = fminf(fmaxf(uv[j], -7.f), 7.f); a[4 * bj + j] = (up + 1.f) * gt * frcp(1.f + __expf(-1.702f * gt)); } }
                u32x2 w; w.x = pk_fp8x4(a[0], a[1], a[2], a[3]); w.y = pk_fp8x4(a[4], a[5], a[6], a[7]);
                *(u32x2*)(ACT + (size_t)(row0 + ai * 128 + m * 16) * D + pnl * 128 + wc * 32 + 8 * fq) = w; }
    }
};
typedef EpiSwiGLUT<0> EpiSwiGLU;
constexpr float Y8_SCALE = 16.f, Y8_INV = 1.f / 16.f;
template <int EMODE = 0>
struct EpiDownT {
    static constexpr bool PERM = true, AFTER_DRAIN = false;
    unsigned char* Y; const float* bias; const float* rowgate;
    __device__ __forceinline__ void operator()(const pg8::f32x4 (&acc)[2][2][4][2], const pg8::Unit& u, int wr, int wc, int fr, int fq) const {
        if (EMODE == 3) return;
        const int e = u.pn >> 2, pnl = u.pn & 3, row0 = u.pm * 256 + wr * 64 + fr, col0 = pnl * 256 + wc * 64 + 16 * fq;
        pg8::f32x4 bv[2][2];
#pragma unroll
        for (int bj = 0; bj < 2; ++bj)
#pragma unroll
            for (int n = 0; n < 2; ++n) bv[bj][n] = *(const pg8::f32x4*)(bias + e * 1024 + col0 + 8 * bj + 4 * n);
#pragma unroll
        for (int ai = 0; ai < 2; ++ai)
#pragma unroll
            for (int m = 0; m < 4; ++m) { const int row = row0 + ai * 128 + m * 16; const float gt = (EMODE == 1 ? 0.37f : rowgate[row]) * Y8_SCALE; unsigned char* rowp = Y + (size_t)row * D + col0;
                u32x4 w;
                { const pg8::f32x4 v0 = (acc[ai][0][m][0] * W8_INV + bv[0][0]) * gt, v1 = (acc[ai][0][m][1] * W8_INV + bv[0][1]) * gt; w.x = pk_fp8x4(v0[0], v0[1], v0[2], v0[3]); w.y = pk_fp8x4(v1[0], v1[1], v1[2], v1[3]); }
                { const pg8::f32x4 v0 = (acc[ai][1][m][0] * W8_INV + bv[1][0]) * gt, v1 = (acc[ai][1][m][1] * W8_INV + bv[1][1]) * gt; w.z = pk_fp8x4(v0[0], v0[1], v0[2], v0[3]); w.w = pk_fp8x4(v1[0], v1[1], v1[2], v1[3]); }
                *(u32x4*)rowp = w; }
    }
};
typedef EpiDownT<0> EpiDown;
__device__ __forceinline__ void p11_final(const Fr& F) {
    const float* ng = F.in[6]; const float* MOD = WSP(float, WS_MOD); const bf16* X1 = WSP(bf16, WS_X1); const unsigned char* Y = WSP(unsigned char, WS_Y); const int* TROW = WSP(int, WS_TKROW);
    const int gw = F.wg * NWAVES + F.wave, NGW = F.G * NWAVES, lane = F.lane;
    typedef float f32x2_ __attribute__((ext_vector_type(2)));
    for (int blk = gw; blk < T / 16; blk += NGW) {
        const int t0 = blk * 16, b = t0 >> 14; const float* mb = MOD + b * 6144 + 5120;
        const int myrow = TROW[(size_t)t0 * 4 + lane];
        f32x4 gm[4];
#pragma unroll
        for (int j = 0; j < 4; ++j) { const int k = 256 * j + 4 * lane; gm[j] = *(const f32x4*)(ng + 3072 + k) * *(const f32x4*)(mb + k); }
        int yq0[4][4], yq1[4][4]; u32x2 xq0[4], xq1[4];
#define P11_LOAD(YQ, XQ, tk_) do { _Pragma("unroll") for (int k_ = 0; k_ < 4; ++k_) { const int row_ = __builtin_amdgcn_readlane(myrow, 4 * (tk_) + k_); \
            _Pragma("unroll") for (int j_ = 0; j_ < 4; ++j_) YQ[k_][j_] = *(const int*)(Y + (size_t)row_ * D + 256 * j_ + 4 * lane); } \
            _Pragma("unroll") for (int j_ = 0; j_ < 4; ++j_) XQ[j_] = *(const u32x2*)(X1 + (size_t)(t0 + (tk_)) * D + 256 * j_ + 4 * lane); } while (0)
#define P11_DO(YQ, XQ, tk_) do { f32x4 y[4]; \
            _Pragma("unroll") for (int j = 0; j < 4; ++j) y[j] = (f32x4){0.f, 0.f, 0.f, 0.f}; \
            _Pragma("unroll") for (int k = 0; k < 4; ++k) _Pragma("unroll") for (int j = 0; j < 4; ++j) { const int w = YQ[k][j]; const f32x2_ lo = __builtin_amdgcn_cvt_pk_f32_fp8(w, false), hi = __builtin_amdgcn_cvt_pk_f32_fp8(w, true); y[j] += (f32x4){lo.x, lo.y, hi.x, hi.y}; } \
            float ss = 0.f; \
            _Pragma("unroll") for (int j = 0; j < 4; ++j) { y[j] = y[j] * Y8_INV; ss += (y[j].x * y[j].x + y[j].y * y[j].y) + (y[j].z * y[j].z + y[j].w * y[j].w); } \
            const float rstd = rsqrtf(wave_sum(ss) * (1.f / D) + EPS); \
            _Pragma("unroll") for (int j = 0; j < 4; ++j) { const int k = 256 * j + 4 * lane; const u32x2 xw = XQ[j]; const f32x4 x1 = (f32x4){bflo(xw.x), bfhi(xw.x), bflo(xw.y), bfhi(xw.y)}; \
                *(f32x4*)(F.out + (size_t)(t0 + (tk_)) * D + k) = (DBG_MODE >= 1) ? x1 : x1 + gm[j] * (y[j] * rstd); } } while (0)
        P11_LOAD(yq0, xq0, 0);
#pragma clang loop unroll(disable)
        for (int tk = 0; tk < 16; tk += 2) {
            P11_LOAD(yq1, xq1, tk + 1);
            P11_DO(yq0, xq0, tk);
            if (tk + 2 < 16) P11_LOAD(yq0, xq0, tk + 2);
            P11_DO(yq1, xq1, tk + 1);
        }
#undef P11_DO
#undef P11_LOAD
    }
}

struct Args { const float* in[23]; float* out; unsigned char* ws; int ph_lo, ph_hi; };
__global__ void __launch_bounds__(NTHR, 2) mk_fwd(Args args) {
    extern __shared__ __attribute__((aligned(16))) unsigned char lds_raw[];
    Fr F; F.lds = (LAS unsigned char*)lds_raw; F.ws = args.ws; F.out = args.out;
#pragma unroll
    for (int i = 0; i < 23; ++i) F.in[i] = args.in[i];
    F.tid = threadIdx.x; F.lane = F.tid & 63; F.wave = __builtin_amdgcn_readfirstlane(F.tid >> 6); F.wg = blockIdx.x; F.G = gridDim.x;
    volatile LAS unsigned* MISC = (volatile LAS unsigned*)(F.lds + LDS_MISC);
    if (F.tid < 16) MISC[F.tid] = 0u;
    __syncthreads();
    const int lo = args.ph_lo, hi = args.ph_hi;
    XcdBarrier bar; bar.bar = WSP(unsigned, WS_CTL) + CW_BAR; bar.x = 0; bar.st = nullptr;
    if (hi - lo > 1) bar = xcd_barrier_post(WSP(unsigned, WS_CTL) + CW_BAR, MISC + 8);
#define IN(k) (lo <= (k) && (k) < hi)
#define SEAM(k) do { if (IN(k) && IN((k) + 1)) xcd_barrier(bar); } while (0)
#define PH0 { p0_prologue(F); }
#define PH1 { p1_norm(F); }
#define PH2 { pg8::Gemm g{WSP(bf16, WS_HALL), WSP(bf16, WS_WINT), TALL, NPROJ, D}; pg8::StaticOrder S; S.init(TALL, NPROJ, F.G, F.wg); \
        EpiStore E{WSP(bf16, WS_P), NPROJ}; pg8::gemm_phase<EpiStore, pg8::StaticOrder, true, true>(F.lds, g, S, E); \
        if (F.wg >= 154 && F.G == 256) p4_convert(F, F.wg - 154, 102, CV_A0, CV_A1); }
#define PH3 { p3_prep(F); if (F.wg >= 32 && F.G == 256) p4_convert(F, F.wg - 32, 224, CV_A1, CV_B1); }
#define PH4 {   \
        if (F.wg < 240) { scan_run<0>(F, F.wg / 15, F.wg % 15); scan_run<1>(F, F.wg / 15, F.wg % 15); } else if (F.G == 256) p4_convert(F, F.wg - 240, 16, CV_B1, CV_C1);        \
        xcd_barrier(bar); \
        if (F.wg < 128) scan_combine(F, F.wg); else { p4_sgu(F, F.wg - 128, F.G - 128, 0, 256); }        \
        xcd_barrier(bar); \
        if (F.wg < 256) scan_run<2>(F, F.wg >> 4, F.wg & 15); \
        p4_sgu(F, F.wg, F.G, 256, NB * 128 * 4); p4_convert(F, F.wg, F.G, F.G == 256 ? CV_C1 : 0, CV_D0); }
#define PH5 { p5_gdn_out(F); }
#define PH6 { pg8::Gemm g{WSP(bf16, WS_MIX), WSP(bf16, WS_WOUTT), T, D, D}; pg8::StaticOrder S; S.init(T, D, F.G, F.wg); \
        EpiStore E{WSP(bf16, WS_R), D}; pg8::gemm_phase<EpiStore, pg8::StaticOrder, true, true>(F.lds, g, S, E); }
#define PH7 { p7_mid(F); }
#define PH8 { p8_permute(F); }
#define PH9 { moe_tables(F); const LAS int* tab = (const LAS int*)(F.lds + LDS_TAB); const int npan = tab[64] < MAXPAN ? tab[64] : MAXPAN; \
        pg8::Gemm g{WSP(bf16, WS_H2), WSP(bf16, WS_WGUT), npan * 256, 2048, D / 2}; MoeOrder S; S.init(npan, 8, F.G, F.wg, tab + 128); \
        { LAS int* gm = (LAS int*)(F.lds + LDS_GMAP); const int* RT = WSP(int, WS_ROWTOK); pg8::Unit uu; \
            for (int i = 0; i < 17 && S.next(i, uu); ++i) if (F.tid < 256) gm[i * 256 + F.tid] = RT[uu.pm * 256 + F.tid]; \
            __syncthreads(); } \
        EpiSwiGLU E{WSP(unsigned char, WS_ACT), WSP(float, WS_BGUP)}; pg8::gemm_phase<EpiSwiGLU, MoeOrder, true, true, true, true>(F.lds, g, S, E, (const LAS int*)(F.lds + LDS_GMAP)); \
        { const int rem = (npan * 8) % F.G; if (rem == 0) p4_convert(F, F.wg, F.G, CV_D0, NE * 768); else if (F.wg >= rem) p4_convert(F, F.wg - rem, F.G - rem, CV_D0, NE * 768); } }
#define PH10 { moe_tables(F); const LAS int* tab = (const LAS int*)(F.lds + LDS_TAB); const int npan = tab[64] < MAXPAN ? tab[64] : MAXPAN; \
        pg8::Gemm g{WSP(bf16, WS_ACT), WSP(bf16, WS_WDT), npan * 256, 1024, D / 2}; MoeOrder S; S.init(npan, 4, F.G, F.wg, tab + 128); \
        EpiDown E{WSP(unsigned char, WS_Y), F.in[22], WSP(float, WS_ROWGATE)}; pg8::gemm_phase<EpiDown, MoeOrder, true, true, true>(F.lds, g, S, E); }
#define RUN(k, BODY) do { if (IN(k)) BODY if (PROBE_TWICE == (k) && IN(k)) { xcd_barrier(bar); BODY } } while (0)
    RUN(0, PH0); SEAM(0);
    RUN(1, PH1); SEAM(1);
    RUN(2, PH2); SEAM(2);
    RUN(3, PH3); SEAM(3);
    RUN(4, PH4);
    if (PROBE_TWICE == 46 && IN(4)) { xcd_barrier(bar); if (F.wg < 240) scan_run<0>(F, F.wg / 15, F.wg % 15); else if (F.wg < 256) scan_run<1>(F, (F.wg - 240) / 15, (F.wg - 240) % 15); if (F.wg < 224) scan_run<1>(F, (F.wg + 16) / 15, (F.wg + 16) % 15); }
    if (PROBE_TWICE == 47 && IN(4)) { xcd_barrier(bar); if (F.wg < 256) scan_run<2>(F, F.wg >> 4, F.wg & 15); }
    if (PROBE_TWICE == 48 && IN(4)) { xcd_barrier(bar); p4_convert(F, F.wg, F.G, CV_C1, CV_D0); }
    if (PROBE_TWICE == 49 && IN(4)) { xcd_barrier(bar); if (F.wg < 128) scan_combine(F, F.wg); }
    SEAM(4);
    RUN(5, PH5); SEAM(5);
    RUN(6, PH6); SEAM(6);
    RUN(7, PH7); SEAM(7);
    RUN(8, PH8); SEAM(8);
    RUN(9, PH9);
#define PH9X(EM) { moe_tables(F); const LAS int* tab = (const LAS int*)(F.lds + LDS_TAB); const int npan = tab[64] < MAXPAN ? tab[64] : MAXPAN; \
        pg8::Gemm g{WSP(bf16, WS_H2), WSP(bf16, WS_WGUT), npan * 256, 2048, D / 2}; MoeOrder S; S.init(npan, 8, F.G, F.wg, tab + 128); \
        { LAS int* gm = (LAS int*)(F.lds + LDS_GMAP); const int* RT = WSP(int, WS_ROWTOK); pg8::Unit uu; \
            for (int i = 0; i < 17 && S.next(i, uu); ++i) if (F.tid < 256) gm[i * 256 + F.tid] = RT[uu.pm * 256 + F.tid]; \
            __syncthreads(); } \
        EpiSwiGLUT<EM> E{WSP(unsigned char, WS_Y), WSP(float, WS_BGUP)}; pg8::gemm_phase<EpiSwiGLUT<EM>, MoeOrder, true, true, true, true>(F.lds, g, S, E, (const LAS int*)(F.lds + LDS_GMAP)); }
    if (PROBE_TWICE == 90 && IN(9)) { xcd_barrier(bar); PH9X(0) }
    if (PROBE_TWICE == 93 && IN(9)) { xcd_barrier(bar); PH9X(3) }
    SEAM(9);
    RUN(10, PH10);
#define PH10X(EM) { moe_tables(F); const LAS int* tab = (const LAS int*)(F.lds + LDS_TAB); const int npan = tab[64] < MAXPAN ? tab[64] : MAXPAN; \
        pg8::Gemm g{WSP(bf16, WS_ACT), WSP(bf16, WS_WDT), npan * 256, 1024, D / 2}; MoeOrder S; S.init(npan, 4, F.G, F.wg, tab + 128); \
        EpiDownT<EM> E{WSP(unsigned char, WS_R1) + 136 * MiB, F.in[22], WSP(float, WS_ROWGATE)}; pg8::gemm_phase<EpiDownT<EM>, MoeOrder, true, true, true>(F.lds, g, S, E); }
    if (PROBE_TWICE == 100 && IN(10)) { xcd_barrier(bar); PH10X(0) }
    if (PROBE_TWICE == 101 && IN(10)) { xcd_barrier(bar); PH10X(1) }
    if (PROBE_TWICE == 103 && IN(10)) { xcd_barrier(bar); PH10X(3) }
    if (PROBE_TWICE == 104 && IN(10)) { xcd_barrier(bar); moe_tables(F); const LAS int* tab = (const LAS int*)(F.lds + LDS_TAB); const int npan = tab[64] < MAXPAN ? tab[64] : MAXPAN;
        pg8::Gemm g{WSP(bf16, WS_ACT), WSP(bf16, WS_WDT), npan * 256, 1024, D}; MoeOrder S; S.init(npan / 2, 4, F.G, F.wg, tab + 128);
        EpiDownT<3> E{WSP(unsigned char, WS_R1) + 136 * MiB, F.in[22], WSP(float, WS_ROWGATE)}; pg8::gemm_phase<EpiDownT<3>, MoeOrder, true, true, true>(F.lds, g, S, E); }
    SEAM(10);
    if (IN(11)) {
        if (DBG_MODE == 10) { const unsigned short* src = (const unsigned short*)(F.ws + WS_PREP);
            for (size_t i = (size_t)F.wg * NTHR + F.tid; i < (size_t)T * D; i += (size_t)F.G * NTHR) { float v = bf2f(src[i * 3]); F.out[i] = (v == v && fabsf(v) < 1e30f) ? v : 0.f; } }
        else if (DBG_MODE == 11) { const unsigned short* src = (const unsigned short*)(F.ws + WS_O);
            for (size_t i = (size_t)F.wg * NTHR + F.tid; i < (size_t)T * D; i += (size_t)F.G * NTHR) { float v = bf2f(src[i]); F.out[i] = (v == v && fabsf(v) < 1e30f) ? v : 0.f; } }
        else { p11_final(F); if (PROBE_TWICE == 11) { xcd_barrier(bar); p11_final(F); } } }
#undef IN
#undef SEAM
}

extern "C" void kernel_launch(void* const* d_in, const int* in_sizes, int n_in, void* d_out, int out_size, void* d_ws, size_t ws_size, hipStream_t stream) {
    static int grid = 0;
    if (grid == 0) {
        if (n_in != 23 || out_size != T * D || ws_size < WS_END) { fprintf(stderr, "kernel_launch: unexpected problem (n_in %d, out %d, ws %zu)\n", n_in, out_size, ws_size); grid = -1; return; }
        int dev = 0, cus = 0;
        if (hipGetDevice(&dev) != hipSuccess || hipDeviceGetAttribute(&cus, hipDeviceAttributeMultiprocessorCount, dev) != hipSuccess) { grid = -1; return; }
        if (hipFuncSetAttribute((const void*)mk_fwd, hipFuncAttributeMaxDynamicSharedMemorySize, LDS_BYTES) != hipSuccess) { fprintf(stderr, "kernel_launch: hipFuncSetAttribute failed\n"); grid = -1; return; }
        int per_cu = 0;
        if (hipOccupancyMaxActiveBlocksPerMultiprocessor(&per_cu, (const void*)mk_fwd, NTHR, LDS_BYTES) != hipSuccess || per_cu < 1) fprintf(stderr, "kernel_launch: occupancy query says %d\n", per_cu);
        (void)hipGetLastError();
        grid = cus;
        if (T % grid != 0 || T / grid > 256 || (T / grid) % 16 != 0 || SEQ % (T / grid) != 0) { fprintf(stderr, "kernel_launch: grid %d unsupported\n", grid); grid = -1; return; }
    }
    if (grid < 0) return;
    (void)hipMemsetAsync((char*)d_ws + WS_CTL, 0, CTL_BYTES, stream);
    Args a{};
    for (int i = 0; i < 23; ++i) a.in[i] = (const float*)d_in[i];
    a.out = (float*)d_out; a.ws = (unsigned char*)d_ws;
#if MK_PER_PHASE
    for (int p = 0; p < NPHASE; ++p) { if (DBG_MODE >= 10 && p >= 5 && p <= 10) continue; a.ph_lo = p; a.ph_hi = p + 1; hipLaunchKernelGGL(mk_fwd, dim3(grid), dim3(NTHR), LDS_BYTES, stream, a); }
#else
    a.ph_lo = 0; a.ph_hi = NPHASE; hipLaunchKernelGGL(mk_fwd, dim3(grid), dim3(NTHR), LDS_BYTES, stream, a);
#endif
}
```

```cpp
#include <hip/hip_runtime.h>
#include <cstdio>
#include <cstdint>
namespace pg8 {
#define PG8_LAS __attribute__((address_space(3)))
typedef unsigned short bf16_t;
typedef short bf16x8 __attribute__((ext_vector_type(8)));
typedef float f32x4 __attribute__((ext_vector_type(4)));
typedef unsigned u32x4 __attribute__((ext_vector_type(4)));
constexpr int BM = 256, BK = 64, HALF = 128, HTB = HALF * BK * 2  , STAGE_BYTES = 8 * HTB, NXCD = 8, WGM = 8;

__host__ __device__ __forceinline__ int lds_byte(int r, int c) { const int st = (r >> 4) * 2 + (c >> 5), rr = r & 15, cc = c & 31, ob = rr * 64 + cc * 2; return st * 1024 + (ob ^ (((ob >> 9) & 1) << 5)); }
__host__ __device__ __forceinline__ void stage_rc(int b, int& R, int& C) { const int st = b / 1024, sb = b % 1024, swz = sb ^ (((sb >> 9) & 1) << 5); R = (st >> 1) * 16 + swz / 64; C = (st & 1) * 32 + (swz % 64) / 2; }
__host__ __device__ __forceinline__ int perm32(int rho) { const int n = rho >> 4, i = rho & 15; return 8 * (i >> 2) + 4 * n + (i & 3); }

struct Unit { int pm, pn; };
struct Gemm { const bf16_t* A; const bf16_t* Bt; int M, N, K; };

struct StaticOrder {
    int nM, nN, nwg, G, c;
    __host__ __device__ void init(int M, int N, int G_, int c_) { nM = M / BM; nN = N / BM; nwg = nM * nN; G = G_; c = c_; }
    __host__ __device__ bool next(int i, Unit& u) const {
        const long L = (long)i * G + c; if (L >= nwg) return false;
        int wgid = (int)L; { const int q = nwg / NXCD, r = nwg % NXCD, xcd = wgid % NXCD, off = wgid / NXCD; wgid = (xcd < r ? xcd * (q + 1) : r * (q + 1) + (xcd - r) * q) + off; }
        const int nig = WGM * nN, gid = wgid / nig, fm = gid * WGM, gsz = (nM - fm) < WGM ? (nM - fm) : WGM;
        u.pm = fm + ((wgid % nig) % gsz); u.pn = (wgid % nig) / gsz; return true;
    }
    __device__ __forceinline__ void a_ready(const Unit&) const {}
    __device__ __forceinline__ void done(const Unit&) const {}
};
__device__ __forceinline__ unsigned cvt_pk_bf16(float lo, float hi) { unsigned r; asm volatile("v_cvt_pk_bf16_f32 %0, %1, %2" : "=v"(r) : "v"(lo), "v"(hi)); return r; }
template <class Epi, class Sched, bool ALIGN_EPI = false, bool SP2 = false, bool FP8 = false, bool GATHER = false>
__device__ __forceinline__ void gemm_phase(PG8_LAS unsigned char* lds, const Gemm g, const Sched& S, const Epi& E, const PG8_LAS int* gmap = nullptr) {
    typedef int i32x8_ __attribute__((ext_vector_type(8))); typedef int i32x4_ __attribute__((ext_vector_type(4)));
    const int tid = threadIdx.x, wid = __builtin_amdgcn_readfirstlane(tid >> 6), lane = tid & 63, wr = wid >> 2, wc = wid & 3, fr = lane & 15, fq = lane >> 4;
    const int K = g.K, nt = K / BK;
    unsigned voffA[2], voffB[2];
    int gR[2]; unsigned gCb[2]; unsigned gC0[2], gC1[2], gN0[2], gN1[2];
#pragma unroll
    for (int i = 0; i < 2; ++i) { int R, C; stage_rc(tid * 16 + i * 8192, R, C); const int Rb = Epi::PERM ? ((R & ~31) + perm32(R & 31)) : R;
        voffA[i] = (unsigned)(R * K + C) * 2u; voffB[i] = (unsigned)(Rb * K + C) * 2u; gR[i] = R; gCb[i] = (unsigned)C * 2u; }
#define PG8_GOFF(D0, D1, ui_) do { _Pragma("unroll") for (int i_ = 0; i_ < 2; ++i_) { D0[i_] = (unsigned)gmap[(ui_) * 256 + gR[i_]] * (unsigned)(K * 2) + gCb[i_]; D1[i_] = (unsigned)gmap[(ui_) * 256 + 128 + gR[i_]] * (unsigned)(K * 2) + gCb[i_]; } } while (0)
#define PG8_STAGE_A(bufoff, gbase, h_, nx_) do { if constexpr (GATHER) { if (nx_) PG8_STAGE(bufoff, gbase, ((h_) ? gN1 : gN0)); else PG8_STAGE(bufoff, gbase, ((h_) ? gC1 : gC0)); } \
        else PG8_STAGE(bufoff, (gbase) + ((h_) ? hstep : 0), voffA); } while (0)
    const size_t kstep = (size_t)(BK * 2);
    const size_t hstep = (size_t)HALF * K * 2;
    const size_t tstep = 2 * hstep;
    const unsigned ldsw = (unsigned)wid * 1024u;
    const int aoff = lds_byte(wr * 64 + fr, fq * 8), boff = lds_byte(wc * 32 + fr, fq * 8);
#define PG8_SA(b, h) (((b) * 2 + (h)) * HTB)
#define PG8_SB(b, h) ((4 + (b) * 2 + (h)) * HTB)
#define PG8_STAGE(bufoff, gbase, voff) do { _Pragma("unroll") for (int _i = 0; _i < 2; ++_i) \
        __builtin_amdgcn_global_load_lds((const unsigned*)((const char*)(gbase) + (voff)[_i]), (PG8_LAS unsigned*)(lds + (bufoff) + ldsw + _i * 8192), 16, 0, 0); } while (0)
#define PG8_LDA(dst, b, h) do { _Pragma("unroll") for (int m = 0; m < 4; ++m) _Pragma("unroll") for (int k = 0; k < 2; ++k) dst[m][k] = *(const PG8_LAS bf16x8*)(lds + PG8_SA(b, h) + aoff + m * 2048 + k * 1024); } while (0)
#define PG8_LDB(dst, b, h) do { _Pragma("unroll") for (int n = 0; n < 2; ++n) _Pragma("unroll") for (int k = 0; k < 2; ++k) dst[n][k] = *(const PG8_LAS bf16x8*)(lds + PG8_SB(b, h) + boff + n * 2048 + k * 1024); } while (0)
#define PG8_MMA16(ai, bj, At, Bt) do { __builtin_amdgcn_s_setprio(1); _Pragma("unroll") for (int m = 0; m < 4; ++m) _Pragma("unroll") for (int n = 0; n < 2; ++n) _Pragma("unroll") for (int k = 0; k < 2; ++k) \
        acc[ai][bj][m][n] = __builtin_amdgcn_mfma_f32_16x16x32_bf16(Bt[n][k], At[m][k], acc[ai][bj][m][n], 0, 0, 0); __builtin_amdgcn_s_setprio(0); } while (0)
#define PG8_LDA8(dst, b, h) do { _Pragma("unroll") for (int m = 0; m < 4; ++m) { const i32x4_ lo_ = *(const PG8_LAS i32x4_*)(lds + PG8_SA(b, h) + aoff + m * 2048), hi_ = *(const PG8_LAS i32x4_*)(lds + PG8_SA(b, h) + aoff + m * 2048 + 1024); \
        dst[m] = __builtin_shufflevector(lo_, hi_, 0, 1, 2, 3, 4, 5, 6, 7); } } while (0)
#define PG8_LDB8(dst, b, h) do { _Pragma("unroll") for (int n = 0; n < 2; ++n) { const i32x4_ lo_ = *(const PG8_LAS i32x4_*)(lds + PG8_SB(b, h) + boff + n * 2048), hi_ = *(const PG8_LAS i32x4_*)(lds + PG8_SB(b, h) + boff + n * 2048 + 1024); \
        dst[n] = __builtin_shufflevector(lo_, hi_, 0, 1, 2, 3, 4, 5, 6, 7); } } while (0)
#define PG8_MMA8(ai, bj, At, Bt) do { __builtin_amdgcn_s_setprio(1); _Pragma("unroll") for (int m = 0; m < 4; ++m) _Pragma("unroll") for (int n = 0; n < 2; ++n) \
        asm volatile("v_mfma_f32_16x16x128_f8f6f4 %0, %1, %2, %0" : "+v"(acc[ai][bj][m][n]) : "v"(Bt[n]), "v"(At[m])); \
        __builtin_amdgcn_s_setprio(0); } while (0)
#define PG8_LDAX(dst, b, h) do { if constexpr (FP8) PG8_LDA8(dst##8, b, h); else PG8_LDA(dst, b, h); } while (0)
#define PG8_LDBX(dst, b, h) do { if constexpr (FP8) PG8_LDB8(dst##8, b, h); else PG8_LDB(dst, b, h); } while (0)
#define PG8_MMA(ai, bj, At, Bt) do { if constexpr (FP8) PG8_MMA8(ai, bj, At##8, Bt##8); else PG8_MMA16(ai, bj, At, Bt); } while (0)
#define PG8_WAIT_V(n) asm volatile("s_waitcnt vmcnt(" #n ")" ::: "memory")
#define PG8_WAIT_L(n) asm volatile("s_waitcnt lgkmcnt(" #n ")" ::: "memory")
#define PG8_BAR __builtin_amdgcn_s_barrier()
#define PG8_SCHED __builtin_amdgcn_sched_barrier(0)
    Unit cur, nxt; int ui = 0;
    if (!S.next(0, cur)) return;
    f32x4 acc[2][2][4][2];
#pragma unroll
    for (int a = 0; a < 2; ++a)
#pragma unroll
        for (int b = 0; b < 2; ++b)
#pragma unroll
            for (int m = 0; m < 4; ++m)
#pragma unroll
                for (int n = 0; n < 2; ++n) acc[a][b][m][n] = (f32x4){0.f, 0.f, 0.f, 0.f};
    bf16x8 At[4][2], B0[2][2], B1[2][2];
    i32x8_ At8[4], B08[2], B18[2]; int scale1 = 0x7f7f7f7f; asm volatile("" : "+v"(scale1));
    const char* cA = (const char*)g.A + (GATHER ? (size_t)0 : (size_t)cur.pm * tstep); const char* cB = (const char*)g.Bt + (size_t)cur.pn * tstep;
    if constexpr (GATHER) { PG8_GOFF(gC0, gC1, 0); }
    S.a_ready(cur);
    E.pre(cur, wid, lane, 0);
    if constexpr (SP2) {
        PG8_STAGE(PG8_SB(0, 0), cB, voffB); PG8_STAGE(PG8_SB(0, 1), cB + hstep, voffB); PG8_STAGE_A(PG8_SA(0, 0), cA, 0, false); PG8_STAGE_A(PG8_SA(0, 1), cA, 1, false);
        if (wr == 1) PG8_BAR;
        PG8_WAIT_V(2); PG8_BAR;
        PG8_STAGE(PG8_SB(1, 0), cB + kstep, voffB); PG8_STAGE_A(PG8_SA(1, 0), cA + kstep, 0, false); PG8_STAGE(PG8_SB(1, 1), cB + hstep + kstep, voffB);
        PG8_WAIT_V(6); PG8_BAR;
    } else {
        PG8_STAGE(PG8_SB(0, 0), cB, voffB); PG8_STAGE(PG8_SA(0, 0), cA, voffA); PG8_STAGE(PG8_SB(0, 1), cB + hstep, voffB); PG8_STAGE(PG8_SA(0, 1), cA + hstep, voffA);
        if (wr == 1) PG8_BAR;
        PG8_WAIT_V(4); PG8_BAR;
        PG8_STAGE(PG8_SB(1, 0), cB + kstep, voffB); PG8_STAGE(PG8_SA(1, 0), cA + kstep, voffA); PG8_STAGE(PG8_SB(1, 1), cB + hstep + kstep, voffB);
        PG8_WAIT_V(6); PG8_BAR;
    }
    for (;;) {
        const bool has_next = S.next(ui + 1, nxt);
        const char* nA = (has_next && !GATHER) ? (const char*)g.A + (size_t)nxt.pm * tstep : cA; const char* nB = has_next ? (const char*)g.Bt + (size_t)nxt.pn * tstep : cB;
        if constexpr (GATHER) { if (has_next) { PG8_GOFF(gN0, gN1, ui + 1); } else { _Pragma("unroll") for (int i_ = 0; i_ < 2; ++i_) { gN0[i_] = gC0[i_]; gN1[i_] = gC1[i_]; } } }
#pragma clang loop unroll(disable)
        for (int t = 0; t < nt; t += 2) {
            const bool last = (t == nt - 2);
            const char* a1 = cA + (size_t)(t + 1) * kstep;
            const char* a2 = last ? nA : cA + (size_t)(t + 2) * kstep; const char* b2 = last ? nB : cB + (size_t)(t + 2) * kstep;
            const char* a3 = a2 + kstep; const char* b3 = b2 + kstep;
            if (last && has_next) S.a_ready(nxt);
            if constexpr (SP2) {
            PG8_LDBX(B0, 0, 0); PG8_LDBX(B1, 0, 1); PG8_SCHED; PG8_LDAX(At, 0, 0); PG8_STAGE_A(PG8_SA(1, 1), a1, 1, false);
            PG8_WAIT_V(8); PG8_WAIT_L(0); PG8_BAR; PG8_MMA(0, 0, At, B0); PG8_MMA(0, 1, At, B1); PG8_BAR; PG8_SCHED;
            PG8_LDAX(At, 0, 1); PG8_STAGE(PG8_SB(0, 0), b2, voffB); PG8_STAGE(PG8_SB(0, 1), b2 + hstep, voffB); PG8_STAGE_A(PG8_SA(0, 0), a2, 0, last);
            PG8_WAIT_V(8); PG8_WAIT_L(0); PG8_BAR; PG8_MMA(1, 0, At, B0); PG8_MMA(1, 1, At, B1); PG8_BAR; PG8_SCHED;
            PG8_LDBX(B0, 1, 0); PG8_LDBX(B1, 1, 1); PG8_SCHED; PG8_LDAX(At, 1, 0); PG8_STAGE_A(PG8_SA(0, 1), a2, 1, last);
            PG8_WAIT_V(8); PG8_WAIT_L(0); PG8_BAR; PG8_MMA(0, 0, At, B0); PG8_MMA(0, 1, At, B1); PG8_BAR; PG8_SCHED;
            PG8_LDAX(At, 1, 1); PG8_STAGE(PG8_SB(1, 0), b3, voffB); PG8_STAGE(PG8_SB(1, 1), b3 + hstep, voffB); PG8_STAGE_A(PG8_SA(1, 0), a3, 0, last);
            PG8_WAIT_V(8); PG8_WAIT_L(0); PG8_BAR; PG8_MMA(1, 0, At, B0); PG8_MMA(1, 1, At, B1); PG8_BAR; PG8_SCHED;
            } else {
            PG8_LDBX(B0, 0, 0); PG8_SCHED; PG8_LDAX(At, 0, 0); PG8_STAGE(PG8_SA(1, 1), a1 + hstep, voffA);
            PG8_WAIT_L(8); PG8_BAR; PG8_WAIT_L(0); PG8_MMA(0, 0, At, B0); PG8_BAR; PG8_SCHED;
            PG8_LDBX(B1, 0, 1); PG8_STAGE(PG8_SB(0, 0), b2, voffB);
            PG8_BAR; PG8_WAIT_L(0); PG8_MMA(0, 1, At, B1); PG8_BAR;
            PG8_LDAX(At, 0, 1); PG8_STAGE(PG8_SA(0, 0), a2, voffA);
            PG8_BAR; PG8_WAIT_L(0); PG8_MMA(1, 0, At, B0); PG8_BAR; PG8_SCHED;
            PG8_STAGE(PG8_SB(0, 1), b2 + hstep, voffB);
            PG8_WAIT_V(6); PG8_BAR; PG8_MMA(1, 1, At, B1); PG8_BAR;
            PG8_LDBX(B0, 1, 0); PG8_SCHED; PG8_LDAX(At, 1, 0); PG8_STAGE(PG8_SA(0, 1), a2 + hstep, voffA);
            PG8_WAIT_L(8); PG8_BAR; PG8_WAIT_L(0); PG8_MMA(0, 0, At, B0); PG8_BAR; PG8_SCHED;
            PG8_LDBX(B1, 1, 1); PG8_STAGE(PG8_SB(1, 0), b3, voffB);
            PG8_BAR; PG8_WAIT_L(0); PG8_MMA(0, 1, At, B1); PG8_BAR;
            PG8_LDAX(At, 1, 1); PG8_STAGE(PG8_SA(1, 0), a3, voffA);
            PG8_BAR; PG8_WAIT_L(0); PG8_MMA(1, 0, At, B0); PG8_BAR; PG8_SCHED;
            PG8_STAGE(PG8_SB(1, 1), b3 + hstep, voffB);
            PG8_WAIT_V(6); PG8_BAR; PG8_MMA(1, 1, At, B1); PG8_BAR;
            }
        }
        if constexpr (ALIGN_EPI) { if (wr == 0) PG8_BAR; }
        if constexpr (FP8) asm volatile("s_nop 15\n\ts_nop 15\n\ts_nop 15\n\ts_nop 15\n\ts_nop 15" ::: "memory");
        if constexpr (!Epi::AFTER_DRAIN) { Unit eu = cur; int fr_ = fr, fq_ = fq; asm volatile("" : "+v"(eu.pm), "+v"(eu.pn), "+v"(fr_), "+v"(fq_));
            E(acc, eu, wr, wc, fr_, fq_, ui & 1); S.done(cur); }
        if (!has_next) break;
#pragma unroll
        for (int a = 0; a < 2; ++a)
#pragma unroll
            for (int b = 0; b < 2; ++b)
#pragma unroll
                for (int m = 0; m < 4; ++m)
#pragma unroll
                    for (int n = 0; n < 2; ++n) acc[a][b][m][n] = (f32x4){0.f, 0.f, 0.f, 0.f};
        cur = nxt; cA = nA; cB = nB; ++ui;
        E.pre(cur, wid, lane, ui & 1);
        if constexpr (GATHER) { _Pragma("unroll") for (int i_ = 0; i_ < 2; ++i_) { gC0[i_] = gN0[i_]; gC1[i_] = gN1[i_]; } }
        if constexpr (ALIGN_EPI) { if (wr == 1) PG8_BAR; }
    }
    PG8_WAIT_V(0);
    if constexpr (!ALIGN_EPI) { if (wr == 0) PG8_BAR; }
    PG8_BAR;
    if constexpr (Epi::AFTER_DRAIN) { E.fused(acc, cur, wr, wc, fr, fq, lds, wid, lane); S.done(cur); }
#undef PG8_SA
#undef PG8_SB
#undef PG8_STAGE
#undef PG8_STAGE_A
#undef PG8_GOFF
#undef PG8_LDA
#undef PG8_LDB
#undef PG8_MMA
#undef PG8_MMA16
#undef PG8_MMA8
#undef PG8_LDA8
#undef PG8_LDB8
#undef PG8_LDAX
#undef PG8_LDBX
#undef PG8_WAIT_V
#undef PG8_WAIT_L
#undef PG8_BAR
#undef PG8_SCHED
}
}

#ifndef MK_PER_PHASE
#define MK_PER_PHASE 0
#endif
#ifndef PROBE_TWICE
#define PROBE_TWICE -1
#endif
#ifndef DBG_SEL
#define DBG_SEL 9
#endif
#ifndef DBG_MODE
#define DBG_MODE 0
#endif
#if 0
#endif

#define GAS __attribute__((address_space(1)))
#define LAS __attribute__((address_space(3)))
typedef unsigned short bf16;
typedef float f32x4 __attribute__((ext_vector_type(4)));
typedef short bf16x8 __attribute__((ext_vector_type(8)));
typedef unsigned u32x4 __attribute__((ext_vector_type(4)));
typedef unsigned u32x2 __attribute__((ext_vector_type(2)));

constexpr int NB = 2, SEQ = 16384, D = 1024, T = NB * SEQ, CTXL = 256, TC = NB * CTXL, TALL = T + TC;
constexpr int NPROJ = 3328, NPROJ_SRC = 3088;
constexpr int PC_Z = 1536, PC_U = 2048, PC_V = 2560, PC_BA = 3072;
constexpr int NH = 4, NE = 32, NCH = 260;
constexpr int MAXPAN = 544, MAXROWS = MAXPAN * 256;
constexpr float EPS = 1e-6f;
constexpr int NWAVES = 8, NTHR = 512;
constexpr int NPHASE = 12;
constexpr int CV_A0 = 0, CV_A1 = 5712, CV_B1 = CV_A1 + 5376, CV_C1 = CV_B1 + 2304, CV_D0 = NE * 768 - 3072;

constexpr size_t MiB = 1ull << 20;
constexpr size_t WS_CTL = 0, CTL_BYTES = 1 * MiB;
constexpr size_t WS_MOD = 1 * MiB;
constexpr size_t WS_WRT = 1 * MiB + 128 * 1024;
constexpr size_t WS_BGUP = 1 * MiB + 256 * 1024;
constexpr size_t WS_TKE = 2 * MiB, WS_TKRANK = 2 * MiB + 512 * 1024, WS_TKGATE = 3 * MiB, WS_TKROW = 3 * MiB + 512 * 1024;
constexpr size_t WS_ROWGATE = 4 * MiB;
constexpr size_t WS_WINT = 6 * MiB;
constexpr size_t WS_WOUTT = 13 * MiB;
constexpr size_t WS_WGUT = 16 * MiB;
constexpr size_t WS_WDT = 144 * MiB;
constexpr size_t WS_X1 = 208 * MiB;
constexpr size_t WS_MIX = WS_X1;
constexpr size_t WS_H2 = 336 * MiB;
constexpr size_t WS_R1 = 400 * MiB;
constexpr size_t WS_P = WS_R1, WS_ACT = WS_R1;
constexpr size_t WS_R2 = 672 * MiB;
constexpr size_t WS_HALL = WS_R2, WS_O = WS_R2;
constexpr size_t WS_PREP = WS_R2 + 65 * MiB;
constexpr size_t WS_R = WS_PREP;
constexpr size_t WS_VEC = WS_R2 + 261 * MiB;
constexpr size_t WS_ROWTOK = WS_R2;
constexpr size_t WS_XS = WS_R2, WS_Y = WS_R2;
constexpr size_t WS_END = 944 * MiB;
constexpr size_t PREP_UNIT = 98304;
constexpr int PO_KQ = 0, PO_KT = 32768, PO_V = 49152, PO_T = 65536, PO_A = 81920;
constexpr int CW_BAR = 4096, CW_GCNT = 8192;

constexpr int LDS_BYTES = 163840;
constexpr int LDS_TAB = 131072;
constexpr int LDS_GMAP = LDS_TAB + 4096;
constexpr int LDS_EPI = LDS_GMAP + 17 * 1024 + 1024;
constexpr int LDS_MISC = LDS_BYTES - 64;

#define LDS_WAIT() asm volatile("s_waitcnt lgkmcnt(0)" ::: "memory")
#define VM_WAIT() asm volatile("s_waitcnt vmcnt(0)" ::: "memory")

__device__ __forceinline__ float bf2f(unsigned b) { return __uint_as_float(b << 16); }
__device__ __forceinline__ float bflo(unsigned w) { return __uint_as_float(w << 16); }
__device__ __forceinline__ float bfhi(unsigned w) { return __uint_as_float(w & 0xffff0000u); }
typedef __bf16 bf16x2_t __attribute__((ext_vector_type(2)));
typedef float f32x2_t __attribute__((ext_vector_type(2)));
__device__ __forceinline__ unsigned pk2(float lo, float hi) { const f32x2_t f = {lo, hi}; const bf16x2_t v = __builtin_convertvector(f, bf16x2_t); return __builtin_bit_cast(unsigned, v); }
__device__ __forceinline__ float sat8(float x) { return __builtin_amdgcn_fmed3f(x, -448.f, 448.f); }
__device__ __forceinline__ unsigned pk_fp8x4(float a, float b, float c, float d) { a = sat8(a); b = sat8(b); c = sat8(c); d = sat8(d); int w = 0; w = __builtin_amdgcn_cvt_pk_fp8_f32(a, b, w, false); w = __builtin_amdgcn_cvt_pk_fp8_f32(c, d, w, true); return (unsigned)w; }
constexpr float W8_SCALE = 32.f, W8_INV = 1.f / 32.f;
__device__ __forceinline__ float frcp(float x) { return __builtin_amdgcn_rcpf(x); }
__device__ __forceinline__ float sigm(float x) { return frcp(1.f + __expf(-x)); }
__device__ __forceinline__ float silu_(float x) { return x * frcp(1.f + __expf(-x)); }
__device__ __forceinline__ float gelu_t(float x) { const float y = 0.7978845608028654f * (x + 0.044715f * x * x * x); const float t = 1.f - 2.f * frcp(__expf(2.f * y) + 1.f); return 0.5f * x * (1.f + t); }
#define DPP_MOV(v, ctrl) __builtin_bit_cast(float, __builtin_amdgcn_update_dpp(0, __builtin_bit_cast(int, (v)), (ctrl), 0xf, 0xf, true))
__device__ __forceinline__ float sum16(float v) { v += DPP_MOV(v, 0xB1); v += DPP_MOV(v, 0x4E); v += DPP_MOV(v, 0x124); v += DPP_MOV(v, 0x128); return v; }
__device__ __forceinline__ float wave_sum(float v) {
    v = sum16(v); const int iv = __builtin_bit_cast(int, v);
    return (__builtin_bit_cast(float, __builtin_amdgcn_readlane(iv, 0)) + __builtin_bit_cast(float, __builtin_amdgcn_readlane(iv, 16))) + (__builtin_bit_cast(float, __builtin_amdgcn_readlane(iv, 32)) + __builtin_bit_cast(float, __builtin_amdgcn_readlane(iv, 48)));
}
#define XB_TMO      128
#define XB_XCNT(j)  (256  + 64 * (j))
#define XB_XSUB(j)  (1280 + 64 * (j))
#define XB_XGEN(j)  (2304 + 64 * (j))
#define XB_TOP      3328
#define XB_TOPGEN   3392
#define XCD_BAR_WORDS 3456
#define XB_SPIN_CAP (1u << 18)
__device__ __forceinline__ unsigned xb_ld(unsigned* p)              { return __hip_atomic_load(p, __ATOMIC_RELAXED, __HIP_MEMORY_SCOPE_AGENT); }
__device__ __forceinline__ unsigned xb_add(unsigned* p, unsigned v) { return __hip_atomic_fetch_add(p, v, __ATOMIC_RELAXED, __HIP_MEMORY_SCOPE_AGENT); }
__device__ __forceinline__ unsigned xb_xcc_id() { return (unsigned)__builtin_amdgcn_s_getreg((3 << 11) | 20) & 0xFu; }
#define XB_SPIN(cond, bar) do { unsigned _sp = 0; while (cond) { __builtin_amdgcn_s_sleep(1); \
    if ((++_sp & 255u) == 0u) { if (xb_ld(&(bar)[XB_TMO])) break; if (_sp > XB_SPIN_CAP) { atomicAdd(&(bar)[XB_TMO], 1u); break; } } } } while (0)
struct XcdBarrier { unsigned* bar; unsigned x; volatile LAS unsigned* st; };
__device__ __forceinline__ XcdBarrier xcd_barrier_post(unsigned* bar, volatile LAS unsigned* st) {
    XcdBarrier b; b.bar = bar; b.x = xb_xcc_id(); b.st = st;
    if (threadIdx.x == 0) (void)xb_add(&bar[XB_XCNT(b.x)], 1u);
    return b;
}
__device__ __forceinline__ void xcd_barrier_complete(unsigned* bar, unsigned x, unsigned& nloc, unsigned& nx) {
    const unsigned G = gridDim.x * gridDim.y * gridDim.z;
    unsigned sum, cnt, mine, sp = 0u;
    for (;;) {
        sum = 0u; cnt = 0u; mine = 0u;
#pragma unroll
        for (unsigned j = 0; j < 16; ++j) { const unsigned c = xb_ld(&bar[XB_XCNT(j)]); sum += c; cnt += (c > 0u) ? 1u : 0u; mine = (j == x) ? c : mine; }
        if (sum == G) break;
        __builtin_amdgcn_s_sleep(1);
        if ((++sp & 255u) == 0u) { if (xb_ld(&bar[XB_TMO])) break; if (sp > XB_SPIN_CAP) { atomicAdd(&bar[XB_TMO], 1u); break; } }
    }
    nloc = mine > 0u ? mine : 1u; nx = cnt > 0u ? cnt : 1u;
}
__device__ __forceinline__ void xcd_barrier(const XcdBarrier& b) {
    asm volatile("s_waitcnt vmcnt(0)" ::: "memory");
    __syncthreads();
    if (threadIdx.x == 0) {
        unsigned* bar = b.bar;
        __builtin_amdgcn_s_waitcnt(0);
        unsigned nloc = b.st[0], nx = b.st[1];
        if (nloc == 0u) { xcd_barrier_complete(bar, b.x, nloc, nx); b.st[0] = nloc; b.st[1] = nx; }
        const unsigned old = xb_add(&bar[XB_XSUB(b.x)], 1u);
        const unsigned gen = old / nloc;
        if (old + 1u == (gen + 1u) * nloc) {
            __builtin_amdgcn_fence(__ATOMIC_RELEASE, "agent");
            asm volatile("s_waitcnt vmcnt(0)" ::: "memory");
            const unsigned og = xb_add(&bar[XB_TOP], 1u);
            const unsigned tg = og / nx;
            if (og + 1u == (tg + 1u) * nx) xb_add(&bar[XB_TOPGEN], 1u);
            else XB_SPIN(xb_ld(&bar[XB_TOPGEN]) == tg, bar);
            __builtin_amdgcn_fence(__ATOMIC_ACQUIRE, "agent");
            xb_add(&bar[XB_XGEN(b.x)], 1u);
            asm volatile("s_waitcnt vmcnt(0)" ::: "memory");
        } else {
            XB_SPIN(xb_ld(&bar[XB_XGEN(b.x)]) == gen, bar);
            __builtin_amdgcn_fence(__ATOMIC_ACQUIRE, "agent");
            asm volatile("s_waitcnt vmcnt(0)" ::: "memory");
        }
    }
    __syncthreads();
}

struct Fr {
    LAS unsigned char* lds; unsigned char* ws; const float* in[23]; float* out;
    int tid, lane, wave, wg, G;
};
#define WSP(T_, off) ((T_*)(F.ws + (off)))

struct MapId { __device__ __forceinline__ int operator()(int n) const { return n; } };
struct MapIn { __device__ __forceinline__ int operator()(int n) const { return n < 1536 ? n : (n < 1552 ? PC_BA + (n - 1536) : n - 16); } };
struct MapGu { __device__ __forceinline__ int operator()(int s) const { const int a = s >> 1; return 32 * (a >> 4) + 16 * (s & 1) + (a & 15); } };
template <class RM> __device__ __forceinline__ void tr_item(const float* W, int N, int k0, int n0, bf16* WT, RM rm, LAS float* scr, int lane) {
    const int cq = lane & 15, rq = lane >> 4;
#pragma unroll
    for (int i = 0; i < 16; ++i) { const int kk = 4 * i + rq, n = n0 + 4 * cq; f32x4 v = (f32x4){0.f, 0.f, 0.f, 0.f};
        if (n < N) v = *(const f32x4*)(W + (size_t)(k0 + kk) * N + n);
        *(LAS f32x4*)(scr + kk * 68 + 4 * cq) = v; }
    LDS_WAIT();
    const int c = lane & 7;
#pragma unroll
    for (int j = 0; j < 8; ++j) { const int n = 8 * j + (lane >> 3);
        if (n0 + n < N) { const LAS float* s = scr + (8 * c) * 68 + n;
            u32x4 o; o.x = pk2(s[0], s[68]); o.y = pk2(s[136], s[204]); o.z = pk2(s[272], s[340]); o.w = pk2(s[408], s[476]);
            *(u32x4*)(WT + (size_t)rm(n0 + n) * 1024 + k0 + 8 * c) = o; } }
    LDS_WAIT();
}
struct MapGu8 { __device__ __forceinline__ int operator()(int s) const { const int a = s >> 1, n = s & 1, pn = a >> 7, al = a & 127; return 256 * pn + 128 * ((al >> 2) & 1) + 32 * (al >> 5) + 16 * n + 4 * ((al >> 3) & 3) + (al & 3); } };
struct MapDn8 { __device__ __forceinline__ int operator()(int o) const { const int pn = o >> 8, ol = o & 255; return 256 * pn + 128 * ((ol >> 3) & 1) + 32 * (ol >> 6) + 8 * ((ol >> 4) & 3) + (ol & 7); } };
template <class RM> __device__ __forceinline__ void tr_item8(const float* W, int N, int k0, int n0, unsigned char* WT, RM rm, LAS float* scr, int lane) {
    const int cq = lane & 15, rq = lane >> 4;
#pragma unroll
    for (int i = 0; i < 16; ++i) { const int kk = 4 * i + rq, n = n0 + 4 * cq; *(LAS f32x4*)(scr + kk * 68 + 4 * cq) = *(const f32x4*)(W + (size_t)(k0 + kk) * N + n); }
    LDS_WAIT();
    const int c = lane & 7;
#pragma unroll
    for (int j = 0; j < 8; ++j) { const int n = 8 * j + (lane >> 3); const LAS float* sp = scr + (8 * c) * 68 + n;
        u32x2 o; o.x = pk_fp8x4(sp[0] * W8_SCALE, sp[68] * W8_SCALE, sp[136] * W8_SCALE, sp[204] * W8_SCALE); o.y = pk_fp8x4(sp[272] * W8_SCALE, sp[340] * W8_SCALE, sp[408] * W8_SCALE, sp[476] * W8_SCALE);
        *(u32x2*)(WT + (size_t)rm(n0 + n) * 1024 + k0 + 8 * c) = o; }
    LDS_WAIT();
}
__device__ __forceinline__ void p0_prologue(const Fr& F) {
    const float* c = F.in[1]; const float* cc = F.in[3]; const float* wada = F.in[4]; const float* bada = F.in[5];
    {
        LAS float* SIL = (LAS float*)F.lds; LAS float* RED = SIL + 3072; float* MOD = WSP(float, WS_MOD);
        for (int u = F.wg; u < 96; u += F.G) {
            for (int i = F.tid; i < 3072; i += NTHR) { const int r = i >> 10, k = i & 1023; const float x = r == 0 ? c[k] : (r == 1 ? c[1024 + k] : cc[k]); SIL[i] = silu_(x); }
            __syncthreads();
            const int n0 = u * 64, kb = F.wave * 128; float a0 = 0.f, a1 = 0.f, a2 = 0.f;
#pragma unroll 8
            for (int k = 0; k < 128; ++k) { const float w = wada[(size_t)(kb + k) * 6144 + n0 + F.lane]; a0 += SIL[kb + k] * w; a1 += SIL[1024 + kb + k] * w; a2 += SIL[2048 + kb + k] * w; }
            RED[(F.wave * 3 + 0) * 64 + F.lane] = a0; RED[(F.wave * 3 + 1) * 64 + F.lane] = a1; RED[(F.wave * 3 + 2) * 64 + F.lane] = a2;
            __syncthreads();
            if (F.tid < 192) { const int r = F.tid >> 6, l = F.tid & 63; float s = bada[n0 + l];
#pragma unroll
                for (int w = 0; w < 8; ++w) s += RED[(w * 3 + r) * 64 + l];
                MOD[r * 6144 + n0 + l] = s; }
            __syncthreads();
        }
    }
    {
        LAS float* scr = (LAS float*)(F.lds + F.wave * 17408);
        const int gw = F.wg * NWAVES + F.wave, NGW = F.G * NWAVES;
        constexpr int I_IN = 16 * 49, I_OUT = 16 * 16;
        for (int it = gw; it < I_IN + I_OUT; it += NGW) {
            int r = it;
            if (r < I_IN) { tr_item(F.in[7], NPROJ_SRC, (r / 49) * 64, (r % 49) * 64, WSP(bf16, WS_WINT), MapIn{}, scr, F.lane); continue; } r -= I_IN;
            tr_item(F.in[16], 1024, (r / 16) * 64, (r % 16) * 64, WSP(bf16, WS_WOUTT), MapId{}, scr, F.lane);
        }
    }
    {
        const int gt = F.wg * NTHR + F.tid, NGT = F.G * NTHR;
        float* WRT = WSP(float, WS_WRT); const float* rw = F.in[17];
        for (int i = gt; i < NE * 1024; i += NGT) { const int e = i >> 10, k = i & 1023; WRT[i] = rw[k * NE + e]; }
        float* BG = WSP(float, WS_BGUP); const float* bgu = F.in[20]; MapGu8 mg;
        for (int i = gt; i < NE * 2048; i += NGT) { const int e = i >> 11, s = i & 2047; BG[e * 2048 + mg(s)] = bgu[i]; }
        u32x4* z = (u32x4*)(WSP(bf16, WS_WINT) + (size_t)NPROJ_SRC * 1024);
        for (int i = gt; i < (NPROJ - NPROJ_SRC) * 1024 / 8; i += NGT) z[i] = (u32x4){0u, 0u, 0u, 0u};
    }
}

__device__ __forceinline__ void p4_convert(const Fr& F, int worker, int nworkers, int it_lo, int it_hi) {
    LAS float* scr = (LAS float*)(F.lds + F.wave * 17408);
    const int gw = worker * NWAVES + F.wave, NGW = nworkers * NWAVES;
    constexpr int I_GU = NE * 16 * 32, I_DN = NE * 16 * 16;
    for (int it = it_lo + gw; it < it_hi; it += NGW) {
        int r = it;
        if (r < I_GU) { const int e = r / 512, rr = r % 512; tr_item8(F.in[19] + (size_t)e * 1024 * 2048, 2048, (rr / 32) * 64, (rr % 32) * 64, WSP(unsigned char, WS_WGUT) + (size_t)e * 2048 * 1024, MapGu8{}, scr, F.lane); continue; } r -= I_GU;
        { const int e = r / 256, rr = r % 256; tr_item8(F.in[21] + (size_t)e * 1024 * 1024, 1024, (rr / 16) * 64, (rr % 16) * 64, WSP(unsigned char, WS_WDT) + (size_t)e * 1024 * 1024, MapDn8{}, scr, F.lane); }
    }
}
__device__ __forceinline__ void p1_norm(const Fr& F) {
    const float* x = F.in[0]; const float* ctx = F.in[2]; const float* ng = F.in[6]; const float* MOD = WSP(float, WS_MOD); bf16* H = WSP(bf16, WS_HALL);
    const int gw = F.wg * NWAVES + F.wave, NGW = F.G * NWAVES, lane = F.lane;
    for (int blk = gw; blk < TALL / 4; blk += NGW) {
        const int r0 = blk * 4; const float* xb = r0 < T ? x + (size_t)r0 * D : ctx + (size_t)(r0 - T) * D; const int mi = r0 < T ? (r0 >> 14) : 2;
        const float* m0 = MOD + mi * 6144; const float* m1 = m0 + 1024;
        f32x4 sc[4], sh[4];
#pragma unroll
        for (int j = 0; j < 4; ++j) { const int k = 256 * j + 4 * lane; sc[j] = *(const f32x4*)(ng + k) * (*(const f32x4*)(m1 + k) + 1.f); sh[j] = *(const f32x4*)(m0 + k); }
        f32x4 cur[4], nxt[4];
#pragma unroll
        for (int j = 0; j < 4; ++j) cur[j] = *(const f32x4*)(xb + 256 * j + 4 * lane);
#pragma clang loop unroll(disable)
        for (int i = 0; i < 4; ++i) {
            const int in = i + 1 < 4 ? i + 1 : i;
#pragma unroll
            for (int j = 0; j < 4; ++j) nxt[j] = *(const f32x4*)(xb + (size_t)in * D + 256 * j + 4 * lane);
            float ss = 0.f;
#pragma unroll
            for (int j = 0; j < 4; ++j) ss += (cur[j].x * cur[j].x + cur[j].y * cur[j].y) + (cur[j].z * cur[j].z + cur[j].w * cur[j].w);
            const float rstd = rsqrtf(wave_sum(ss) * (1.f / D) + EPS);
#pragma unroll
            for (int j = 0; j < 4; ++j) { const f32x4 h = cur[j] * rstd * sc[j] + sh[j];
                u32x2 o; o.x = pk2(h.x, h.y); o.y = pk2(h.z, h.w); *(u32x2*)(H + (size_t)(r0 + i) * D + 256 * j + 4 * lane) = o; cur[j] = nxt[j]; }
        }
    }
}

__device__ __forceinline__ void p3_prep(const Fr& F) {
    const bf16* P = WSP(bf16, WS_P); const float* convw = F.in[8]; const float* alog = F.in[9]; const float* dtb = F.in[10];
    LAS bf16* QL = (LAS bf16*)F.lds; LAS bf16* KL = QL + 64 * 136; LAS bf16* VL = KL + 64 * 136;
    LAS float* AM = (LAS float*)(F.lds + 52224); LAS float* XM = AM + 2 * 64 * 65; LAS bf16* AT = (LAS bf16*)(F.lds + 118784);
    LAS float* TMPW = (LAS float*)(F.lds + 137216); LAS float* GV = (LAS float*)(F.lds + 139392);
    for (int u = F.wg; u < NB * NCH * NH; u += F.G) {
        int tid = F.tid; asm volatile("" : "+v"(tid));
        const int lane = tid & 63, wave = __builtin_amdgcn_readfirstlane(tid >> 6), l16 = lane & 15, q4 = lane >> 4;
        const int b = u / (NCH * NH), rem = u % (NCH * NH), cn = rem >> 2, h = rem & 3;
        int rowbase, lo, hi;
        if (cn < 4) { lo = T + b * CTXL; hi = lo + CTXL; rowbase = lo + cn * 64; } else { rowbase = b * SEQ + (cn - 4) * 64; lo = rowbase; hi = rowbase + 64; }
        unsigned char* pu = F.ws + WS_PREP + (size_t)u * PREP_UNIT; float* vec = WSP(float, WS_VEC) + (size_t)u * 512;
        u32x4 xc[6], xn[6]; f32x4 cwc[6], cwn[6];
#define P3_LOAD(XD, WD, part_) do { const int cg_ = tid & 15, col_ = (part_) * 512 + h * 128 + cg_ * 8; \
            _Pragma("unroll") for (int sub_ = 0; sub_ < 2; ++sub_) { const int row_ = rowbase + (sub_ << 5) + (tid >> 4); const u32x4 zero_ = (u32x4){0u, 0u, 0u, 0u}; \
                XD[sub_ * 3 + 1] = *(const u32x4*)(P + (size_t)row_ * NPROJ + col_); XD[sub_ * 3 + 0] = zero_; XD[sub_ * 3 + 2] = zero_; \
                if (row_ - 1 >= lo) XD[sub_ * 3 + 0] = *(const u32x4*)(P + (size_t)(row_ - 1) * NPROJ + col_); \
                if (row_ + 1 < hi) XD[sub_ * 3 + 2] = *(const u32x4*)(P + (size_t)(row_ + 1) * NPROJ + col_); } \
            _Pragma("unroll") for (int hh_ = 0; hh_ < 2; ++hh_) { WD[hh_ * 3 + 0] = *(const f32x4*)(convw + col_ + 4 * hh_); WD[hh_ * 3 + 1] = *(const f32x4*)(convw + 1536 + col_ + 4 * hh_); WD[hh_ * 3 + 2] = *(const f32x4*)(convw + 3072 + col_ + 4 * hh_); } } while (0)
        P3_LOAD(xc, cwc, 0);
#pragma unroll
        for (int part = 0; part < 3; ++part) {
            const int cg = tid & 15;
            if (part < 2) P3_LOAD(xn, cwn, part + 1);
#pragma unroll
            for (int sub = 0; sub < 2; ++sub) {
                const int i = (sub << 5) + (tid >> 4);
                const u32x4 xm = xc[sub * 3 + 0], x0 = xc[sub * 3 + 1], xp = xc[sub * 3 + 2];
                float val[8];
#pragma unroll
                for (int hh = 0; hh < 2; ++hh) {
                    const f32x4 w0 = cwc[hh * 3 + 0], w1 = cwc[hh * 3 + 1], w2 = cwc[hh * 3 + 2];
                    const unsigned m0 = hh ? xm.z : xm.x, m1 = hh ? xm.w : xm.y, c0 = hh ? x0.z : x0.x, c1 = hh ? x0.w : x0.y, p0 = hh ? xp.z : xp.x, p1 = hh ? xp.w : xp.y;
                    val[4 * hh + 0] = w0.x * bflo(m0) + w1.x * bflo(c0) + w2.x * bflo(p0);
                    val[4 * hh + 1] = w0.y * bfhi(m0) + w1.y * bfhi(c0) + w2.y * bfhi(p0);
                    val[4 * hh + 2] = w0.z * bflo(m1) + w1.z * bflo(c1) + w2.z * bflo(p1);
                    val[4 * hh + 3] = w0.w * bfhi(m1) + w1.w * bfhi(c1) + w2.w * bfhi(p1);
                }
                float ss = 0.f;
#pragma unroll
                for (int e = 0; e < 8; ++e) { val[e] = silu_(val[e]); ss += val[e] * val[e]; }
                if (part < 2) { ss = sum16(ss); const float sc = rsqrtf(ss + EPS) * (part == 0 ? 0.08838834764831845f : 1.f);
#pragma unroll
                    for (int e = 0; e < 8; ++e) val[e] *= sc; }
                u32x4 w; w.x = pk2(val[0], val[1]); w.y = pk2(val[2], val[3]); w.z = pk2(val[4], val[5]); w.w = pk2(val[6], val[7]);
                LAS bf16* dst = part == 0 ? QL : (part == 1 ? KL : VL);
                *(LAS u32x4*)(dst + i * 136 + cg * 8) = w;
                if (part < 2) { const int rb = (part == 0 ? 4 : 0) + (i >> 4), ks = cg >> 2, ln = (i & 15) + 16 * (cg & 3);
                    *(u32x4*)(pu + PO_KQ + ((rb * 4 + ks) * 64 + ln) * 16) = w; }
            }
#pragma unroll
            for (int e = 0; e < 6; ++e) { cwc[e] = cwn[e]; xc[e] = xn[e]; }
        }
#undef P3_LOAD
        if (wave < 2) {
            const int d = wave, row = rowbase + lane;
            const float bb = bf2f(P[(size_t)row * NPROJ + PC_BA + d * 4 + h]), aa = bf2f(P[(size_t)row * NPROJ + PC_BA + 8 + d * 4 + h]);
            const float beta = sigm(bb), xx = aa + dtb[d * 4 + h];
            const float sp = xx > 20.f ? xx : log1pf(expf(xx));
            float Gc = -expf(alog[d * 4 + h]) * sp;
#pragma unroll
            for (int o = 1; o < 64; o <<= 1) { const float up = __shfl_up(Gc, o), dn = __shfl_down(Gc, o);
                if (d == 0) { if (lane >= o) Gc += up; } else { if (lane + o < 64) Gc += dn; } }
            const float glast = __shfl(Gc, d == 0 ? 63 : 0);
            GV[d * 64 + lane] = Gc; GV[128 + d * 64 + lane] = beta;
            float* vd = vec + d * 256;
            vd[lane] = expf(Gc); vd[64 + lane] = beta; vd[128 + lane] = expf(glast - Gc); vd[192 + lane] = expf(glast);
        }
        __syncthreads();
#pragma unroll
        for (int jj = 0; jj < 4; ++jj) {
            const int job = wave * 4 + jj, mat = job >> 4, ti = (job >> 2) & 3, tj = job & 3;
            const LAS bf16* Ap = (mat == 0 ? KL : QL) + (ti * 16 + l16) * 136 + q4 * 8;
            const LAS bf16* Bp = KL + (tj * 16 + l16) * 136 + q4 * 8;
            f32x4 acc = (f32x4){0.f, 0.f, 0.f, 0.f};
#pragma unroll
            for (int ks = 0; ks < 4; ++ks) acc = __builtin_amdgcn_mfma_f32_16x16x32_bf16(*(const LAS bf16x8*)(Ap + ks * 32), *(const LAS bf16x8*)(Bp + ks * 32), acc, 0, 0, 0);
            const int j = tj * 16 + l16;
#pragma unroll
            for (int d = 0; d < 2; ++d) {
                const float Gj = GV[d * 64 + j];
#pragma unroll
                for (int r = 0; r < 4; ++r) { const int i = ti * 16 + 4 * q4 + r; const float Gi = GV[d * 64 + i];
                    const float dec = __expf(fminf(Gi - Gj, 0.f));
                    if (mat == 0) { const bool ok = d == 0 ? (j < i) : (j > i); const float v = ok ? GV[128 + d * 64 + i] * acc[r] * dec : 0.f;
                        const int ii = d == 0 ? i : 63 - i, jx = d == 0 ? j : 63 - j; AM[d * 4160 + ii * 65 + jx] = v; }
                    else { const bool ok = d == 0 ? (j <= i) : (j >= i); const float v = ok ? acc[r] * dec : 0.f; AT[d * 4608 + i * 72 + j] = (bf16)(pk2(v, 0.f) & 0xffffu); }
                }
            }
        }
        __syncthreads();
        if (wave < 2) {
            const int d = wave; LAS float* A = AM + d * 4160; LAS float* X = XM + d * 4160; LAS float* TW = TMPW + d * 272;
            for (int r = 0; r < 64; ++r) X[r * 65 + lane] = 0.f;
            LDS_WAIT();
            { const int blk = q4, c = l16; const LAS float* Ab = A + (blk * 16) * 65 + blk * 16; float xv[16];
#pragma unroll
                for (int r = 0; r < 16; ++r) { float s = (r == c) ? 1.f : 0.f;
#pragma unroll
                    for (int m = 0; m < r; ++m) s -= Ab[r * 65 + m] * xv[m];
                    xv[r] = s; }
#pragma unroll
                for (int r = 0; r < 16; ++r) X[(blk * 16 + r) * 65 + blk * 16 + c] = xv[r];
            }
            LDS_WAIT();
#pragma unroll
            for (int dd = 1; dd <= 3; ++dd)
#pragma unroll
                for (int a = dd; a <= 3; ++a) { const int bq = a - dd;
                    f32x4 acc = (f32x4){0.f, 0.f, 0.f, 0.f};
#pragma unroll
                    for (int cc2 = bq; cc2 < a; ++cc2)
#pragma unroll
                        for (int kk = 0; kk < 4; ++kk) { const float av = A[(a * 16 + l16) * 65 + cc2 * 16 + 4 * kk + q4], bv = X[(cc2 * 16 + 4 * kk + q4) * 65 + bq * 16 + l16];
                            acc = __builtin_amdgcn_mfma_f32_16x16x4f32(av, bv, acc, 0, 0, 0); }
#pragma unroll
                    for (int r = 0; r < 4; ++r) TW[(4 * q4 + r) * 17 + l16] = acc[r];
                    LDS_WAIT();
                    f32x4 acc2 = (f32x4){0.f, 0.f, 0.f, 0.f};
#pragma unroll
                    for (int kk = 0; kk < 4; ++kk) { const float av = X[(a * 16 + l16) * 65 + a * 16 + 4 * kk + q4], bv = TW[(4 * kk + q4) * 17 + l16];
                        acc2 = __builtin_amdgcn_mfma_f32_16x16x4f32(av, bv, acc2, 0, 0, 0); }
#pragma unroll
                    for (int r = 0; r < 4; ++r) X[(a * 16 + 4 * q4 + r) * 65 + bq * 16 + l16] = -acc2[r];
                    LDS_WAIT();
                }
        } else {
            const int t6 = tid - 128;
            for (int idx = t6; idx < 1024; idx += 384) { const int d = idx >> 9, e = idx & 511, rb = e >> 7, ks = (e >> 6) & 1, ln = e & 63, i = rb * 16 + (ln & 15), j0 = ks * 32 + (ln >> 4) * 8;
                *(u32x4*)(pu + PO_A + d * 8192 + e * 16) = *(const LAS u32x4*)(AT + d * 4608 + i * 72 + j0); }
            for (int e = t6; e < 1024; e += 384) { const int mb = e >> 7, ks = (e >> 6) & 1, ln = e & 63, m = mb * 16 + (ln & 15), kk0 = ks * 32 + (ln >> 4) * 8;
                unsigned short kv[8];
#pragma unroll
                for (int jj = 0; jj < 8; ++jj) kv[jj] = KL[(kk0 + jj) * 136 + m];
                u32x4 w; w.x = kv[0] | ((unsigned)kv[1] << 16); w.y = kv[2] | ((unsigned)kv[3] << 16); w.z = kv[4] | ((unsigned)kv[5] << 16); w.w = kv[6] | ((unsigned)kv[7] << 16);
                *(u32x4*)(pu + PO_KT + e * 16) = w; }
            for (int e = t6; e < 2048; e += 384) { const int nt = e >> 8, rb = (e >> 6) & 3, ln = e & 63, col = nt * 16 + (ln & 15), row0 = rb * 16 + 4 * (ln >> 4);
                const unsigned v0 = VL[(row0 + 0) * 136 + col], v1 = VL[(row0 + 1) * 136 + col], v2 = VL[(row0 + 2) * 136 + col], v3 = VL[(row0 + 3) * 136 + col];
                u32x2 w; w.x = v0 | (v1 << 16); w.y = v2 | (v3 << 16);
                *(u32x2*)(pu + PO_V + e * 8) = w; }
        }
        __syncthreads();
#pragma unroll
        for (int rep = 0; rep < 2; ++rep) { const int idx = rep * NTHR + tid, d = idx >> 9, e = idx & 511, rb = e >> 7, ks = (e >> 6) & 1, ln = e & 63, i = rb * 16 + (ln & 15), j0 = ks * 32 + (ln >> 4) * 8;
            float tv[8];
#pragma unroll
            for (int jj = 0; jj < 8; ++jj) tv[jj] = d == 0 ? XM[i * 65 + j0 + jj] : XM[4160 + (63 - i) * 65 + (63 - (j0 + jj))];
            u32x4 w; w.x = pk2(tv[0], tv[1]); w.y = pk2(tv[2], tv[3]); w.z = pk2(tv[4], tv[5]); w.w = pk2(tv[6], tv[7]);
            *(u32x4*)(pu + PO_T + d * 8192 + e * 16) = w;
        }
        __syncthreads();
    }
}

constexpr int SNT = 8;
constexpr size_t WS_SLOC = WS_R1 + 212 * MiB, WS_PMAT = WS_SLOC + 16 * MiB, WS_SST = WS_PMAT + 16 * MiB;
__device__ __forceinline__ int sb_lo(int j) { return j < 4 ? 17 * j : 68 + 16 * (j - 4); }
struct ScanRegs { bf16x8 kqA[4], kqB[4]; bf16x8 kt[2], ta[2]; f32x4 eg; float gl; u32x2 vv[SNT]; f32x4 be, kd; };
struct ScanAddr { const unsigned char* pu; const float* vd; };
__device__ __forceinline__ ScanAddr scan_addr(const unsigned char* ws, int d, int b, int h, int s) {
    const int cn = d == 0 ? s : (s < 4 ? 3 - s : 263 - s);
    const int u = (b * NCH + cn) * NH + h;
    ScanAddr a; a.pu = ws + WS_PREP + (size_t)u * PREP_UNIT; a.vd = (const float*)(ws + WS_VEC) + (size_t)u * 512 + d * 256; return a;
}
template <bool OUT> __device__ __forceinline__ void ld_kq(bf16x8 (&kq)[4], const ScanAddr& a, int w, int lane) {
    const int rb = OUT ? w : (w & 3);
#pragma unroll
    for (int ks = 0; ks < 4; ++ks) kq[ks] = *(const bf16x8*)(a.pu + PO_KQ + ((rb * 4 + ks) * 64 + lane) * 16);
}
template <bool HASV, bool OUT> __device__ __forceinline__ void ld_p1(ScanRegs& R, const ScanAddr& a, int w, int lane) {
    const int r0 = 16 * (w & 3) + 4 * (lane >> 4);
    R.eg = *(const f32x4*)(a.vd + r0); R.be = *(const f32x4*)(a.vd + 64 + r0);
    if (HASV) { const int nt0 = OUT ? 0 : 4 * (w >> 2);
#pragma unroll
        for (int i = 0; i < (OUT ? SNT : SNT / 2); ++i) R.vv[i] = *(const u32x2*)(a.pu + PO_V + (((nt0 + i) * 4 + (w & 3)) * 64 + lane) * 8); }
}
template <bool OUT> __device__ __forceinline__ void ld_ta(ScanRegs& R, const ScanAddr& a, int d, int w, int lane) {
    const int tao = ((OUT && w >= 4) ? PO_A : PO_T) + d * 8192;
#pragma unroll
    for (int ks = 0; ks < 2; ++ks) R.ta[ks] = *(const bf16x8*)(a.pu + tao + (((w & 3) * 2 + ks) * 64 + lane) * 16);
}
__device__ __forceinline__ void ld_p3(ScanRegs& R, const ScanAddr& a, int w, int lane) {
#pragma unroll
    for (int ks = 0; ks < 2; ++ks) R.kt[ks] = *(const bf16x8*)(a.pu + PO_KT + ((w * 2 + ks) * 64 + lane) * 16);
    R.gl = a.vd[192];
}
template <bool HASV, bool OUT, int PAR>
__device__ __forceinline__ void scan_step(ScanRegs& R, f32x4 (&S)[SNT], LAS bf16* ST, LAS bf16* TT, LAS bf16* VN, LAS bf16* VS, bf16* Od, int col0,
                                          const unsigned char* ws, int d, int b, int h, int s, int s1, int w, int lane) {
    constexpr int NTW = OUT ? SNT : SNT / 2;
    const int l16 = lane & 15, q4 = lane >> 4, rowo = 16 * (w & 3) + 4 * q4, nt0 = OUT ? 0 : 4 * (w >> 2);
    const bool kwave = !OUT || w < 4;
    const int sn1 = s + 1 < s1 ? s + 1 : s1 - 1, sn2 = s + 2 < s1 ? s + 2 : s1 - 1;
    const ScanAddr a1 = scan_addr(ws, d, b, h, sn1);
    bf16x8 (&kq)[4] = PAR ? R.kqB : R.kqA;
    bf16x8 fb[2][8];
    f32x4 a1v[NTW];
    {
#define RD1(c_) do { _Pragma("unroll") for (int i_ = 0; i_ < 8; ++i_) fb[(c_) & 1][i_] = *(const LAS bf16x8*)(ST + ((nt0 + 2 * (c_) + (i_ >> 2)) * 16 + l16) * 136 + (i_ & 3) * 32 + q4 * 8); } while (0)
        RD1(0);
#pragma unroll
        for (int c = 0; c < NTW / 2; ++c) {
            if (c + 1 < NTW / 2) RD1(c + 1);
            __builtin_amdgcn_sched_barrier(0);
#pragma unroll
            for (int j = 0; j < 2; ++j) { f32x4 acc = (f32x4){0.f, 0.f, 0.f, 0.f};
#pragma unroll
                for (int ks = 0; ks < 4; ++ks) acc = __builtin_amdgcn_mfma_f32_16x16x32_bf16(kq[ks], fb[c & 1][j * 4 + ks], acc, 0, 0, 0);
                a1v[2 * c + j] = acc; }
            __builtin_amdgcn_sched_barrier(0);
        }
#undef RD1
    }
    if (kwave) {
#pragma unroll
        for (int i = 0; i < NTW; ++i) { f32x4 t;
            if (HASV) { const f32x4 v = (f32x4){bflo(R.vv[i].x), bfhi(R.vv[i].x), bflo(R.vv[i].y), bfhi(R.vv[i].y)}; t = R.be * (v - R.eg * a1v[i]); }
            else t = R.be * (R.eg * a1v[i]) * -1.f;
            u32x2 pw; pw.x = pk2(t.x, t.y); pw.y = pk2(t.z, t.w); *(LAS u32x2*)(TT + ((nt0 + i) * 16 + l16) * 72 + rowo) = pw; }
    } else {
#pragma unroll
        for (int i = 0; i < NTW; ++i) a1v[i] = R.eg * a1v[i];
    }
    { const ScanAddr a2 = scan_addr(ws, d, b, h, sn2); ld_kq<OUT>(kq, a2, w, lane); ld_p1<HASV, OUT>(R, a1, w, lane); }
    __syncthreads();
#define RD2(BUF, t0_, c_) do { _Pragma("unroll") for (int i_ = 0; i_ < 8; ++i_) fb[(c_) & 1][i_] = *(const LAS bf16x8*)(BUF + (((t0_) + 4 * (c_) + (i_ >> 1)) * 16 + l16) * 72 + (i_ & 1) * 32 + q4 * 8); } while (0)
    if (kwave) {
        RD2(TT, nt0, 0);
#pragma unroll
        for (int c = 0; c < NTW / 4; ++c) {
            if (c + 1 < NTW / 4) RD2(TT, nt0, c + 1);
            __builtin_amdgcn_sched_barrier(0);
#pragma unroll
            for (int j = 0; j < 4; ++j) { const int nt = nt0 + 4 * c + j; f32x4 vn = (f32x4){0.f, 0.f, 0.f, 0.f};
#pragma unroll
                for (int ks = 0; ks < 2; ++ks) vn = __builtin_amdgcn_mfma_f32_16x16x32_bf16(R.ta[ks], fb[c & 1][j * 2 + ks], vn, 0, 0, 0);
                const f32x4 vs = R.kd * vn;
                u32x2 pw; pw.x = pk2(vn.x, vn.y); pw.y = pk2(vn.z, vn.w); *(LAS u32x2*)(VN + (nt * 16 + l16) * 72 + rowo) = pw;
                u32x2 ps; ps.x = pk2(vs.x, vs.y); ps.y = pk2(vs.z, vs.w); *(LAS u32x2*)(VS + (nt * 16 + l16) * 72 + rowo) = ps; }
            __builtin_amdgcn_sched_barrier(0);
        }
        ld_ta<OUT>(R, a1, d, w, lane); R.kd = *(const f32x4*)(a1.vd + 128 + rowo);
    }
    __syncthreads();
    if (!kwave) {
        RD2(VN, 0, 0);
#pragma unroll
        for (int c = 0; c < 2; ++c) {
            if (c + 1 < 2) RD2(VN, 0, c + 1);
            __builtin_amdgcn_sched_barrier(0);
#pragma unroll
            for (int j = 0; j < 4; ++j) { const int nt = 4 * c + j;
#pragma unroll
                for (int ks = 0; ks < 2; ++ks) a1v[nt < NTW ? nt : 0] = __builtin_amdgcn_mfma_f32_16x16x32_bf16(R.ta[ks], fb[c & 1][j * 2 + ks], a1v[nt < NTW ? nt : 0], 0, 0, 0); }
            __builtin_amdgcn_sched_barrier(0);
        }
        ld_ta<OUT>(R, a1, d, w, lane);
    }
    RD2(VS, 0, 0);
#pragma unroll
    for (int c = 0; c < 2; ++c) {
        if (c + 1 < 2) RD2(VS, 0, c + 1);
        __builtin_amdgcn_sched_barrier(0);
#pragma unroll
        for (int j = 0; j < 4; ++j) { const int nt = 4 * c + j; f32x4 sv = S[nt] * R.gl;
#pragma unroll
            for (int ks = 0; ks < 2; ++ks) sv = __builtin_amdgcn_mfma_f32_16x16x32_bf16(R.kt[ks], fb[c & 1][j * 2 + ks], sv, 0, 0, 0);
            S[nt] = sv;
            u32x2 pw; pw.x = pk2(sv.x, sv.y); pw.y = pk2(sv.z, sv.w); *(LAS u32x2*)(ST + (nt * 16 + l16) * 136 + 16 * w + 4 * q4) = pw; }
        __builtin_amdgcn_sched_barrier(0);
    }
#undef RD2
    ld_p3(R, a1, w, lane);
    if (OUT && w >= 4 && s >= 4) {
        const int n = d == 0 ? s - 4 : 259 - s, trow0 = b * SEQ + n * 64;
#pragma unroll
        for (int nt = 0; nt < NTW; ++nt)
#pragma unroll
            for (int r = 0; r < 4; ++r) Od[(size_t)(trow0 + rowo + r) * 512 + col0 + nt * 16 + l16] = (bf16)(pk2(a1v[nt][r], 0.f) & 0xffffu); }
    __syncthreads();
}
template <int KIND>
__device__ __forceinline__ void scan_run(const Fr& F, int chain, int j) {
    int tid_ = F.tid; asm volatile("" : "+v"(tid_));
    const int d = chain >> 3, b = (chain >> 2) & 1, h = chain & 3, w = __builtin_amdgcn_readfirstlane(tid_ >> 6), lane = tid_ & 63, l16 = lane & 15, q4 = lane >> 4;
    LAS bf16* ST = (LAS bf16*)F.lds; LAS bf16* TT = ST + SNT * 16 * 136; LAS bf16* VN = TT + SNT * 16 * 72; LAS bf16* VS = VN + SNT * 16 * 72;
    f32x4 S[SNT];
    const size_t sidx = ((size_t)chain * 16 + j) * 16384;
#pragma unroll
    for (int nt = 0; nt < SNT; ++nt) {
        if (KIND == 0) S[nt] = (f32x4){0.f, 0.f, 0.f, 0.f};
        else if (KIND == 1) { const int col = nt * 16 + l16;
#pragma unroll
            for (int r = 0; r < 4; ++r) S[nt][r] = (16 * w + 4 * q4 + r == col) ? 1.f : 0.f; }
        else S[nt] = j == 0 ? (f32x4){0.f, 0.f, 0.f, 0.f} : *(const f32x4*)(WSP(float, WS_SST) + sidx + ((nt * 8 + w) * 64 + lane) * 4);
        u32x2 pw; pw.x = pk2(S[nt].x, S[nt].y); pw.y = pk2(S[nt].z, S[nt].w); *(LAS u32x2*)(ST + (nt * 16 + l16) * 136 + 16 * w + 4 * q4) = pw; }
    __syncthreads();
    bf16* Od = WSP(bf16, WS_O) + (size_t)d * T * 512; const int col0 = h * 128;
    const int s0 = sb_lo(j), s1 = sb_lo(j + 1);
    ScanRegs R;
    { const ScanAddr a0 = scan_addr(F.ws, d, b, h, s0), a1 = scan_addr(F.ws, d, b, h, s0 + 1 < s1 ? s0 + 1 : s1 - 1);
        ld_kq<KIND == 2>(R.kqA, a0, w, lane); ld_p1<KIND != 1, KIND == 2>(R, a0, w, lane); ld_ta<KIND == 2>(R, a0, d, w, lane); R.kd = *(const f32x4*)(a0.vd + 128 + 16 * (w & 3) + 4 * q4); ld_p3(R, a0, w, lane);
        ld_kq<KIND == 2>(R.kqB, a1, w, lane); }
    for (int s = s0; s < s1; s += 2) {
        scan_step<KIND != 1, KIND == 2, 0>(R, S, ST, TT, VN, VS, Od, col0, F.ws, d, b, h, s, s1, w, lane);
        if (s + 1 < s1) scan_step<KIND != 1, KIND == 2, 1>(R, S, ST, TT, VN, VS, Od, col0, F.ws, d, b, h, s + 1, s1, w, lane);
    }
    if (KIND == 0) {
#pragma unroll
        for (int nt = 0; nt < SNT; ++nt) *(f32x4*)(WSP(float, WS_SLOC) + sidx + ((nt * 8 + w) * 64 + lane) * 4) = S[nt];
    } else if (KIND == 1) { bf16* Pm = WSP(bf16, WS_PMAT) + sidx;
#pragma unroll
        for (int nt = 0; nt < SNT; ++nt)
#pragma unroll
            for (int r = 0; r < 4; ++r) Pm[(16 * w + 4 * q4 + r) * 128 + nt * 16 + l16] = (bf16)(pk2(S[nt][r], 0.f) & 0xffffu);
    }
    __syncthreads();
}
__device__ __forceinline__ void scan_combine(const Fr& F, int cu) {
    const int chain = cu >> 3, nt = cu & 7, w = F.wave, lane = F.lane, l16 = lane & 15, q4 = lane >> 4;
    LAS bf16* ST = (LAS bf16*)F.lds;
    f32x4 S = (f32x4){0.f, 0.f, 0.f, 0.f};
    { u32x2 z; z.x = 0u; z.y = 0u; *(LAS u32x2*)(ST + l16 * 136 + 16 * w + 4 * q4) = z; }
    __syncthreads();
    bf16x8 pa[4]; f32x4 sl;
#define SC2_LOAD(j_) do { const size_t si_ = ((size_t)chain * 16 + (j_)) * 16384; const bf16* Pm_ = WSP(bf16, WS_PMAT) + si_; \
        _Pragma("unroll") for (int ks = 0; ks < 4; ++ks) pa[ks] = *(const bf16x8*)(Pm_ + (16 * w + l16) * 128 + ks * 32 + q4 * 8); \
        sl = *(const f32x4*)(WSP(float, WS_SLOC) + si_ + ((nt * 8 + w) * 64 + lane) * 4); } while (0)
    SC2_LOAD(0);
    for (int j = 0; j < 15; ++j) {
        f32x4 acc = sl;
#pragma unroll
        for (int ks = 0; ks < 4; ++ks) acc = __builtin_amdgcn_mfma_f32_16x16x32_bf16(pa[ks], *(const LAS bf16x8*)(ST + l16 * 136 + ks * 32 + q4 * 8), acc, 0, 0, 0);
        S = acc;
        if (j + 1 < 15) SC2_LOAD(j + 1);
        *(f32x4*)(WSP(float, WS_SST) + ((size_t)chain * 16 + j + 1) * 16384 + ((nt * 8 + w) * 64 + lane) * 4) = S;
        __syncthreads();
        { u32x2 pw; pw.x = pk2(S.x, S.y); pw.y = pk2(S.z, S.w); *(LAS u32x2*)(ST + l16 * 136 + 16 * w + 4 * q4) = pw; }
        __syncthreads();
    }
#undef SC2_LOAD
}
__device__ __forceinline__ void p4_sgu(const Fr& F, int worker, int nworkers, int u_lo, int u_hi) {
    const bf16* P = WSP(bf16, WS_P); bf16* MIX = WSP(bf16, WS_MIX);
    const float* lng = F.in[12]; const float* lnb = F.in[13]; const float* sw = F.in[14]; const float* sb = F.in[15];
    LAS bf16* VT = (LAS bf16*)F.lds;
    for (int u = u_lo + worker; u < u_hi; u += nworkers) {
        int tid = F.tid; asm volatile("" : "+v"(tid));
        const int lane = tid & 63, wave = __builtin_amdgcn_readfirstlane(tid >> 6), l16 = lane & 15, q4 = lane >> 4;
        const int g = u & 3, ch = u >> 2, row00 = ch * 128;
#pragma unroll
        for (int it = 0; it < 4; ++it) { const int item = it * NTHR + tid, cg = item & 15, row = item >> 4;
            const u32x4 xv = *(const u32x4*)(P + (size_t)(row00 + row) * NPROJ + PC_V + g * 128 + cg * 8);
            float v[8]; v[0] = bflo(xv.x); v[1] = bfhi(xv.x); v[2] = bflo(xv.y); v[3] = bfhi(xv.y); v[4] = bflo(xv.z); v[5] = bfhi(xv.z); v[6] = bflo(xv.w); v[7] = bfhi(xv.w);
            float s = 0.f;
#pragma unroll
            for (int e = 0; e < 8; ++e) { v[e] = gelu_t(v[e]); s += v[e]; }
            const float mean = sum16(s) * (1.f / 128.f); float q = 0.f;
#pragma unroll
            for (int e = 0; e < 8; ++e) { v[e] -= mean; q += v[e] * v[e]; }
            const float rstd = rsqrtf(sum16(q) * (1.f / 128.f) + EPS);
#pragma unroll
            for (int e = 0; e < 8; ++e) { const int c = cg * 8 + e; const float y = v[e] * rstd * lng[g * 128 + c] + lnb[g * 128 + c]; VT[c * 136 + ((((row >> 3) ^ cg) << 3) | (row & 7))] = (bf16)(pk2(y, 0.f) & 0xffffu); }
        }
        __syncthreads();
        bf16x8 wf[4];
#pragma unroll
        for (int ks = 0; ks < 4; ++ks) { const float* wp = sw + (size_t)g * 16384 + (wave * 16 + l16) * 128 + ks * 32 + q4 * 8; const f32x4 a = *(const f32x4*)wp, bq = *(const f32x4*)(wp + 4);
            u32x4 t; t.x = pk2(a.x, a.y); t.y = pk2(a.z, a.w); t.z = pk2(bq.x, bq.y); t.w = pk2(bq.z, bq.w); wf[ks] = __builtin_bit_cast(bf16x8, t); }
        const int prow = wave * 16 + l16; const float bs = sb[g * 128 + prow];
        u32x2 uq[8];
#pragma unroll
        for (int ct = 0; ct < 8; ++ct) uq[ct] = *(const u32x2*)(P + (size_t)(row00 + prow) * NPROJ + PC_U + g * 128 + ct * 16 + 4 * q4);
#pragma unroll
        for (int ct = 0; ct < 8; ++ct) { f32x4 acc = (f32x4){0.f, 0.f, 0.f, 0.f};
#pragma unroll
            for (int ks = 0; ks < 4; ++ks) acc = __builtin_amdgcn_mfma_f32_16x16x32_bf16(*(const LAS bf16x8*)(VT + (ct * 16 + l16) * 136 + (((ks * 4 + q4) ^ (ct * 2 + (l16 >> 3))) << 3)), wf[ks], acc, 0, 0, 0);
            const int c0 = ct * 16 + 4 * q4;
            const u32x2 uv = uq[ct];
            const float o0 = gelu_t(bflo(uv.x)) * (acc[0] + bs), o1 = gelu_t(bfhi(uv.x)) * (acc[1] + bs), o2 = gelu_t(bflo(uv.y)) * (acc[2] + bs), o3 = gelu_t(bfhi(uv.y)) * (acc[3] + bs);
            u32x2 w; w.x = pk2(o0, o1); w.y = pk2(o2, o3); if (DBG_MODE == 3) w = (u32x2){0u, 0u}; *(u32x2*)(MIX + (size_t)(row00 + prow) * D + 512 + g * 128 + c0) = w; }
        __syncthreads();
    }
}

__device__ __forceinline__ void p5_gdn_out(const Fr& F) {
    const bf16* P = WSP(bf16, WS_P); const bf16* O = WSP(bf16, WS_O); bf16* MIX = WSP(bf16, WS_MIX); const float* gng = F.in[11];
    const int gw = F.wg * NWAVES + F.wave, NGW = F.G * NWAVES, lane = F.lane;
    const f32x4 g0 = *(const f32x4*)(gng + (lane & 15) * 8), g1 = *(const f32x4*)(gng + (lane & 15) * 8 + 4);
    const float gg[8] = {g0.x, g0.y, g0.z, g0.w, g1.x, g1.y, g1.z, g1.w};
    for (int blk = gw; blk < T / 16; blk += NGW) {
        const int t0 = blk * 16;
        u32x4 a = *(const u32x4*)(O + (size_t)t0 * 512 + lane * 8), bq = *(const u32x4*)(O + (size_t)(T + t0) * 512 + lane * 8), z = *(const u32x4*)(P + (size_t)t0 * NPROJ + PC_Z + lane * 8);
#pragma clang loop unroll(disable)
        for (int i = 0; i < 16; ++i) {
            const int t = t0 + i, tn = t0 + (i + 1 < 16 ? i + 1 : i);
            const u32x4 an = *(const u32x4*)(O + (size_t)tn * 512 + lane * 8), bn = *(const u32x4*)(O + (size_t)(T + tn) * 512 + lane * 8), zn = *(const u32x4*)(P + (size_t)tn * NPROJ + PC_Z + lane * 8);
            float o[8]; o[0] = bflo(a.x) + bflo(bq.x); o[1] = bfhi(a.x) + bfhi(bq.x); o[2] = bflo(a.y) + bflo(bq.y); o[3] = bfhi(a.y) + bfhi(bq.y);
            o[4] = bflo(a.z) + bflo(bq.z); o[5] = bfhi(a.z) + bfhi(bq.z); o[6] = bflo(a.w) + bflo(bq.w); o[7] = bfhi(a.w) + bfhi(bq.w);
            float ss = 0.f;
#pragma unroll
            for (int e = 0; e < 8; ++e) ss += o[e] * o[e];
            const float rstd = rsqrtf(sum16(ss) * (1.f / 128.f) + EPS);
            const float zz[8] = {bflo(z.x), bfhi(z.x), bflo(z.y), bfhi(z.y), bflo(z.z), bfhi(z.z), bflo(z.w), bfhi(z.w)};
            float r[8];
#pragma unroll
            for (int e = 0; e < 8; ++e) r[e] = o[e] * rstd * gg[e] * silu_(zz[e]);
            u32x4 w; w.x = pk2(r[0], r[1]); w.y = pk2(r[2], r[3]); w.z = pk2(r[4], r[5]); w.w = pk2(r[6], r[7]);
            if (DBG_MODE == 2) w = (u32x4){0u, 0u, 0u, 0u};
            *(u32x4*)(MIX + (size_t)t * D + lane * 8) = w;
            a = an; bq = bn; z = zn;
        }
    }
}

__device__ __forceinline__ void p7_mid(const Fr& F) {
    const float* x = F.in[0]; const float* ng = F.in[6]; const float* MOD = WSP(float, WS_MOD); const bf16* R = WSP(bf16, WS_R); const float* rbias = F.in[18];
    bf16* X1 = WSP(bf16, WS_X1); unsigned char* H2 = WSP(unsigned char, WS_H2);
    LAS bf16* HI = (LAS bf16*)F.lds; LAS bf16* LO = HI + 16 * 1032; LAS float* PART = (LAS float*)(F.lds + 66048);
    LAS int* ENT_E = (LAS int*)(F.lds + 83968); LAS int* ENT_R = ENT_E + 1024; LAS int* CNT = ENT_R + 1024; LAS int* BASE = CNT + 32;
    const int tid = F.tid, lane = F.lane, wave = F.wave, l16 = lane & 15, q4 = lane >> 4;
    if (tid < 32) CNT[tid] = 0;
    { int* RT = WSP(int, WS_ROWTOK); const int per = (MAXROWS + F.G - 1) / F.G; for (int i = tid; i < per; i += NTHR) { const int r = F.wg * per + i; if (r < MAXROWS) RT[r] = 0; } }
    const int TPW = T / F.G, t0 = F.wg * TPW;
    LAS float* AV = (LAS float*)(F.lds + 92672); LAS float* BV = AV + 1024; LAS float* CV = BV + 1024;
    { const float* mb = MOD + (t0 >> 14) * 6144;
        for (int k = tid; k < 1024; k += NTHR) { AV[k] = mb[2048 + k] * ng[1024 + k]; BV[k] = ng[2048 + k] * (mb[4096 + k] + 1.f); CV[k] = mb[3072 + k]; } }
    const float my_rbias = rbias[tid & 31];
    bf16x8 wh[4][2], wl[4][2];
    { const float* WRT = WSP(float, WS_WRT);
#pragma unroll
        for (int ks = 0; ks < 4; ++ks)
#pragma unroll
            for (int nt = 0; nt < 2; ++nt) { const float* wp = WRT + (size_t)(nt * 16 + l16) * 1024 + wave * 128 + ks * 32 + q4 * 8; const f32x4 a = *(const f32x4*)wp, b = *(const f32x4*)(wp + 4);
                u32x4 h; h.x = pk2(a.x, a.y); h.y = pk2(a.z, a.w); h.z = pk2(b.x, b.y); h.w = pk2(b.z, b.w);
                u32x4 l; l.x = pk2(a.x - bflo(h.x), a.y - bfhi(h.x)); l.y = pk2(a.z - bflo(h.y), a.w - bfhi(h.y)); l.z = pk2(b.x - bflo(h.z), b.y - bfhi(h.z)); l.w = pk2(b.z - bflo(h.w), b.w - bfhi(h.w));
                wh[ks][nt] = __builtin_bit_cast(bf16x8, h); wl[ks][nt] = __builtin_bit_cast(bf16x8, l); } }
    __syncthreads();
    u32x2 rq[2][4]; f32x4 xq[2][4];
#define P7_LOAD(tile_) do { _Pragma("unroll") for (int sub_ = 0; sub_ < 2; ++sub_) { const int t_ = t0 + (tile_) * 16 + 2 * wave + sub_; \
        _Pragma("unroll") for (int j_ = 0; j_ < 4; ++j_) { rq[sub_][j_] = *(const u32x2*)(R + (size_t)t_ * D + 256 * j_ + 4 * lane); xq[sub_][j_] = *(const f32x4*)(x + (size_t)t_ * D + 256 * j_ + 4 * lane); } } } while (0)
    P7_LOAD(0);
    for (int tile = 0; tile < TPW / 16; ++tile) {
        f32x4 hq[2][4];
#pragma unroll
        for (int sub = 0; sub < 2; ++sub) {
            f32x4 rv[4]; float ss = 0.f;
#pragma unroll
            for (int j = 0; j < 4; ++j) { const u32x2 rw = rq[sub][j]; rv[j] = (f32x4){bflo(rw.x), bfhi(rw.x), bflo(rw.y), bfhi(rw.y)};
                ss += (rv[j].x * rv[j].x + rv[j].y * rv[j].y) + (rv[j].z * rv[j].z + rv[j].w * rv[j].w); }
            const float rstd1 = rsqrtf(wave_sum(ss) * (1.f / D) + EPS);
            f32x4 xv[4]; float s2 = 0.f;
#pragma unroll
            for (int j = 0; j < 4; ++j) { const int k = 256 * j + 4 * lane; const f32x4 av = *(const LAS f32x4*)(AV + k);
                xv[j] = xq[sub][j] + av * (rv[j] * rstd1);
                s2 += (xv[j].x * xv[j].x + xv[j].y * xv[j].y) + (xv[j].z * xv[j].z + xv[j].w * xv[j].w); }
            const float rstd2 = rsqrtf(wave_sum(s2) * (1.f / D) + EPS);
#pragma unroll
            for (int j = 0; j < 4; ++j) { const int k = 256 * j + 4 * lane; const f32x4 bv = *(const LAS f32x4*)(BV + k), cv = *(const LAS f32x4*)(CV + k);
                hq[sub][j] = xv[j] * rstd2 * bv + cv; xq[sub][j] = xv[j]; }
        }
#pragma unroll
        for (int sub = 0; sub < 2; ++sub) { const int tr = 2 * wave + sub, t = t0 + tile * 16 + tr;
#pragma unroll
            for (int j = 0; j < 4; ++j) { const int k = 256 * j + 4 * lane; const f32x4 hv = hq[sub][j];
                { u32x2 x1w; x1w.x = pk2(xq[sub][j].x, xq[sub][j].y); x1w.y = pk2(xq[sub][j].z, xq[sub][j].w); *(u32x2*)(X1 + (size_t)t * D + k) = x1w; }
                u32x2 o; o.x = pk2(hv.x, hv.y); o.y = pk2(hv.z, hv.w); *(unsigned*)(H2 + (size_t)t * D + k) = pk_fp8x4(hv.x, hv.y, hv.z, hv.w);
                u32x2 lo; lo.x = pk2(hv.x - bflo(o.x), hv.y - bfhi(o.x)); lo.y = pk2(hv.z - bflo(o.y), hv.w - bfhi(o.y));
                *(LAS u32x2*)(HI + tr * 1032 + k) = o; *(LAS u32x2*)(LO + tr * 1032 + k) = lo; } }
        if (tile + 1 < TPW / 16) P7_LOAD(tile + 1);
        __syncthreads();
        { f32x4 acc[2]; acc[0] = (f32x4){0.f, 0.f, 0.f, 0.f}; acc[1] = acc[0];
#pragma unroll
            for (int ks = 0; ks < 4; ++ks) { const int ko = l16 * 1032 + wave * 128 + ks * 32 + q4 * 8;
                const bf16x8 ah = *(const LAS bf16x8*)(HI + ko), al = *(const LAS bf16x8*)(LO + ko);
#pragma unroll
                for (int nt = 0; nt < 2; ++nt) { acc[nt] = __builtin_amdgcn_mfma_f32_16x16x32_bf16(ah, wh[ks][nt], acc[nt], 0, 0, 0);
                    acc[nt] = __builtin_amdgcn_mfma_f32_16x16x32_bf16(al, wh[ks][nt], acc[nt], 0, 0, 0);
                    acc[nt] = __builtin_amdgcn_mfma_f32_16x16x32_bf16(ah, wl[ks][nt], acc[nt], 0, 0, 0); } }
#pragma unroll
            for (int nt = 0; nt < 2; ++nt)
#pragma unroll
                for (int r = 0; r < 4; ++r) PART[(wave * 16 + 4 * q4 + r) * 33 + nt * 16 + l16] = acc[nt][r]; }
        __syncthreads();
        { const int tok = tid >> 5, me = tid & 31, t = t0 + tile * 16 + tok;
            float logit = my_rbias;
#pragma unroll
            for (int w = 0; w < 8; ++w) logit += PART[(w * 16 + tok) * 33 + me];
            float tv[4]; int ti[4];
#pragma unroll
            for (int k = 0; k < 4; ++k) { float bv = logit; int bi = me;
#define P7_AMAX(OV, OI) do { const float ov_ = (OV); const int oi_ = (OI); const bool tk_ = (ov_ > bv) | ((ov_ == bv) & (oi_ < bi)); bv = tk_ ? ov_ : bv; bi = tk_ ? oi_ : bi; } while (0)
                P7_AMAX(DPP_MOV(bv, 0xB1), __builtin_amdgcn_update_dpp(0, bi, 0xB1, 0xf, 0xf, true));
                P7_AMAX(DPP_MOV(bv, 0x4E), __builtin_amdgcn_update_dpp(0, bi, 0x4E, 0xf, 0xf, true));
                P7_AMAX(DPP_MOV(bv, 0x124), __builtin_amdgcn_update_dpp(0, bi, 0x124, 0xf, 0xf, true));
                P7_AMAX(DPP_MOV(bv, 0x128), __builtin_amdgcn_update_dpp(0, bi, 0x128, 0xf, 0xf, true));
                P7_AMAX(__shfl_xor(bv, 16), __shfl_xor(bi, 16));
#undef P7_AMAX
                tv[k] = bv; ti[k] = bi; if (me == bi) logit = -3.0e38f; }
            const float e1 = __expf(tv[1] - tv[0]), e2 = __expf(tv[2] - tv[0]), e3 = __expf(tv[3] - tv[0]), inv = 1.f / (1.f + e1 + e2 + e3);
            if (me == 0) { const float gt[4] = {inv, e1 * inv, e2 * inv, e3 * inv}; float* TG = WSP(float, WS_TKGATE); const int tl = tile * 16 + tok;
#pragma unroll
                for (int k = 0; k < 4; ++k) { const int rk = atomicAdd((int*)&CNT[ti[k]], 1); ENT_E[tl * 4 + k] = ti[k]; ENT_R[tl * 4 + k] = rk; TG[(size_t)t * 4 + k] = gt[k]; } }
        }
    }
#undef P7_LOAD
    __syncthreads();
    if (tid < 32) BASE[tid] = (int)__hip_atomic_fetch_add(WSP(unsigned, WS_CTL) + CW_GCNT + 64 * tid, (unsigned)CNT[tid], __ATOMIC_RELAXED, __HIP_MEMORY_SCOPE_AGENT);
    __syncthreads();
    int* TE = WSP(int, WS_TKE); int* TR = WSP(int, WS_TKRANK);
    for (int i = tid; i < TPW * 4; i += NTHR) { const int e = ENT_E[i]; TE[(size_t)t0 * 4 + i] = e; TR[(size_t)t0 * 4 + i] = BASE[e] + ENT_R[i]; }
}

__device__ __forceinline__ void moe_tables(const Fr& F) {
    LAS int* NPL = (LAS int*)(F.lds + LDS_TAB); LAS int* RB = NPL + 32; LAS int* NPAN = NPL + 64; LAS int* PEXP = NPL + 128;
    if (F.tid < 32) NPL[F.tid] = ((int)__hip_atomic_load(WSP(unsigned, WS_CTL) + CW_GCNT + 64 * F.tid, __ATOMIC_RELAXED, __HIP_MEMORY_SCOPE_AGENT) + 255) >> 8;
    __syncthreads();
    if (F.tid < 32) { int s = 0; for (int e = 0; e < F.tid; ++e) s += NPL[e]; RB[F.tid] = s * 256; if (F.tid == 31) NPAN[0] = s + NPL[31];
        const int np = NPL[F.tid]; for (int p = 0; p < np; ++p) if (s + p < MAXPAN) PEXP[s + p] = F.tid; }
    __syncthreads();
}
__device__ __forceinline__ void p8_permute(const Fr& F) {
    moe_tables(F);
    const LAS int* RB = (const LAS int*)(F.lds + LDS_TAB) + 32;
    const int* TE = WSP(int, WS_TKE); const int* TR = WSP(int, WS_TKRANK); const float* TG = WSP(float, WS_TKGATE); int* TROW = WSP(int, WS_TKROW); float* RG = WSP(float, WS_ROWGATE);
    int* RT = WSP(int, WS_ROWTOK);
    const int gw = F.wg * NWAVES + F.wave, NGW = F.G * NWAVES, lane = F.lane;
    for (int blk = gw; blk < T / 16; blk += NGW) {
        const size_t a0 = (size_t)blk * 64;
        const int e = TE[a0 + lane]; int row = RB[e] + TR[a0 + lane]; row = row < MAXROWS ? row : MAXROWS - 1;
        TROW[a0 + lane] = row; RG[row] = TG[a0 + lane]; RT[row] = blk * 16 + (lane >> 2);
    }
}
struct MoeOrder {
    int nM, nN, nwg, G, c; const LAS int* pexp;
    __device__ __forceinline__ void init(int nM_, int nN_, int G_, int c_, const LAS int* pexp_) { nM = nM_; nN = nN_; nwg = nM * nN; G = G_; c = c_; pexp = pexp_; }
    __device__ __forceinline__ bool next(int i, pg8::Unit& u) const {
        const long L = (long)i * G + c; if (L >= nwg) return false;
        int wgid = (int)L; { const int q = nwg / pg8::NXCD, r = nwg % pg8::NXCD, xcd = wgid % pg8::NXCD, off = wgid / pg8::NXCD; wgid = (xcd < r ? xcd * (q + 1) : r * (q + 1) + (xcd - r) * q) + off; }
        const int nig = pg8::WGM * nN, gid = wgid / nig, fm = gid * pg8::WGM, gsz = (nM - fm) < pg8::WGM ? (nM - fm) : pg8::WGM;
        u.pm = fm + ((wgid % nig) % gsz); u.pn = pexp[u.pm] * nN + (wgid % nig) / gsz; return true;
    }
    __device__ __forceinline__ void a_ready(const pg8::Unit&) const {}
    __device__ __forceinline__ void done(const pg8::Unit&) const {}
};
struct EpiStore {
    static constexpr bool PERM = true, AFTER_DRAIN = false;
    bf16* O; int ldc;
    __device__ __forceinline__ void pre(const pg8::Unit&, int, int, int) const {}
    __device__ __forceinline__ void operator()(const pg8::f32x4 (&acc)[2][2][4][2], const pg8::Unit& u, int wr, int wc, int fr, int fq, int par) const {
        const int row0 = u.pm * 256 + wr * 64 + fr, col0 = u.pn * 256 + wc * 32 + 8 * fq;
#pragma unroll
        for (int ai = 0; ai < 2; ++ai)
#pragma unroll
            for (int m = 0; m < 4; ++m) { bf16* rowp = O + (size_t)(row0 + ai * 128 + m * 16) * ldc + col0;
#pragma unroll
                for (int bj = 0; bj < 2; ++bj) { const pg8::f32x4 v0 = acc[ai][bj][m][0], v1 = acc[ai][bj][m][1];
                    u32x4 w; w.x = pk2(v0[0], v0[1]); w.y = pk2(v0[2], v0[3]); w.z = pk2(v1[0], v1[1]); w.w = pk2(v1[2], v1[3]);
                    *(u32x4*)(rowp + bj * 128) = w; } }
    }
};
template <int EMODE = 0>
struct EpiSwiGLUT {
    static constexpr bool PERM = false, AFTER_DRAIN = false;
    unsigned char* ACT; const float* bias; LAS float* le;
    __device__ __forceinline__ void pre(const pg8::Unit& u, int wid, int lane, int par) const { if (EMODE == 3) return;
        if (wid < 4) __builtin_amdgcn_global_load_lds((const unsigned*)(bias + (u.pn >> 3) * 2048 + (u.pn & 7) * 256 + wid * 64 + lane), (LAS unsigned*)(le + par * 512 + wid * 64), 4, 0, 0); }
    __device__ __forceinline__ void operator()(const pg8::f32x4 (&acc)[2][2][4][2], const pg8::Unit& u, int wr, int wc, int fr, int fq, int par) const {
        if (EMODE == 3) return;
        const int e = u.pn >> 3, pnl = u.pn & 7, row0 = u.pm * 256 + wr * 64 + fr;
        const LAS float* bb = le + par * 512 + wc * 32 + 4 * fq; (void)e;
        pg8::f32x4 bg[2], bu[2];
#pragma unroll
        for (int bj = 0; bj < 2; ++bj) { bg[bj] = *(const LAS pg8::f32x4*)(bb + bj * 128); bu[bj] = *(const LAS pg8::f32x4*)(bb + bj * 128 + 16); }
#pragma unroll
        for (int ai = 0; ai < 2; ++ai)
#pragma unroll
            for (int m = 0; m < 4; ++m) { float a[8];
#pragma unroll
                for (int bj = 0; bj < 2; ++bj) { const pg8::f32x4 gv = acc[ai][bj][m][0] * W8_INV + bg[bj], uv = acc[ai][bj][m][1] * W8_INV + bu[bj];
#pragma unroll
                    for (int j = 0; j < 4; ++j) { const float gt = fminf(gv[j], 7.f), up = fminf(fmaxf(uv[j], -7.f), 7.f); a[4 * bj + j] = (up + 1.f) * gt * frcp(1.f + __expf(-1.702f * gt)); } }
                u32x2 w; w.x = pk_fp8x4(a[0], a[1], a[2], a[3]); w.y = pk_fp8x4(a[4], a[5], a[6], a[7]);
                *(u32x2*)(ACT + (size_t)(row0 + ai * 128 + m * 16) * D + pnl * 128 + wc * 32 + 8 * fq) = w; }
    }
};
typedef EpiSwiGLUT<0> EpiSwiGLU;
constexpr float Y8_SCALE = 16.f, Y8_INV = 1.f / 16.f;
template <int EMODE = 0>
struct EpiDownT {
    static constexpr bool PERM = true, AFTER_DRAIN = false;
    unsigned char* Y; const float* bias; const float* rowgate; LAS float* le;
    __device__ __forceinline__ void pre(const pg8::Unit& u, int wid, int lane, int par) const { if (EMODE == 3) return;
        const float* src = wid < 4 ? rowgate + u.pm * 256 + wid * 64 + lane : bias + (u.pn >> 2) * 1024 + (u.pn & 3) * 256 + (wid - 4) * 64 + lane;
        __builtin_amdgcn_global_load_lds((const unsigned*)src, (LAS unsigned*)(le + par * 512 + wid * 64), 4, 0, 0); }
    __device__ __forceinline__ void operator()(const pg8::f32x4 (&acc)[2][2][4][2], const pg8::Unit& u, int wr, int wc, int fr, int fq, int par) const {
        if (EMODE == 3) return;
        const int e = u.pn >> 2, pnl = u.pn & 3, row0 = u.pm * 256 + wr * 64 + fr, col0 = pnl * 256 + wc * 64 + 16 * fq;
        pg8::f32x4 bv[2][2];
#pragma unroll
        for (int bj = 0; bj < 2; ++bj)
#pragma unroll
            for (int n = 0; n < 2; ++n) bv[bj][n] = *(const LAS pg8::f32x4*)(le + par * 512 + 256 + wc * 64 + 16 * fq + 8 * bj + 4 * n);
        (void)e;
        float gt[2][4];
#pragma unroll
        for (int ai = 0; ai < 2; ++ai)
#pragma unroll
            for (int m = 0; m < 4; ++m) gt[ai][m] = (EMODE == 1 ? 0.37f : le[par * 512 + ai * 128 + wr * 64 + m * 16 + fr]);
#pragma unroll
        for (int ai = 0; ai < 2; ++ai)
#pragma unroll
            for (int m = 0; m < 4; ++m) { const int row = row0 + ai * 128 + m * 16; const float g = gt[ai][m] * Y8_SCALE; unsigned char* rowp = Y + (size_t)row * D + col0;
                u32x4 w;
                { const pg8::f32x4 v0 = (acc[ai][0][m][0] * W8_INV + bv[0][0]) * g, v1 = (acc[ai][0][m][1] * W8_INV + bv[0][1]) * g; w.x = pk_fp8x4(v0[0], v0[1], v0[2], v0[3]); w.y = pk_fp8x4(v1[0], v1[1], v1[2], v1[3]); }
                { const pg8::f32x4 v0 = (acc[ai][1][m][0] * W8_INV + bv[1][0]) * g, v1 = (acc[ai][1][m][1] * W8_INV + bv[1][1]) * g; w.z = pk_fp8x4(v0[0], v0[1], v0[2], v0[3]); w.w = pk_fp8x4(v1[0], v1[1], v1[2], v1[3]); }
                *(u32x4*)rowp = w; }
    }
};
typedef EpiDownT<0> EpiDown;
__device__ __forceinline__ void p11_final(const Fr& F) {
    const float* ng = F.in[6]; const float* MOD = WSP(float, WS_MOD); const bf16* X1 = WSP(bf16, WS_X1); const unsigned char* Y = WSP(unsigned char, WS_Y); const int* TROW = WSP(int, WS_TKROW);
    const int gw = F.wg * NWAVES + F.wave, NGW = F.G * NWAVES, lane = F.lane;
    typedef float f32x2_ __attribute__((ext_vector_type(2)));
    for (int blk = gw; blk < T / 16; blk += NGW) {
        const int t0 = blk * 16, b = t0 >> 14; const float* mb = MOD + b * 6144 + 5120;
        const int myrow = TROW[(size_t)t0 * 4 + lane];
        f32x4 gm[4];
#pragma unroll
        for (int j = 0; j < 4; ++j) { const int k = 256 * j + 4 * lane; gm[j] = *(const f32x4*)(ng + 3072 + k) * *(const f32x4*)(mb + k); }
        int yq0[4][4], yq1[4][4]; u32x2 xq0[4], xq1[4];
#define P11_LOAD(YQ, XQ, tk_) do { _Pragma("unroll") for (int k_ = 0; k_ < 4; ++k_) { const int row_ = __builtin_amdgcn_readlane(myrow, 4 * (tk_) + k_); \
            _Pragma("unroll") for (int j_ = 0; j_ < 4; ++j_) YQ[k_][j_] = *(const int*)(Y + (size_t)row_ * D + 256 * j_ + 4 * lane); } \
            _Pragma("unroll") for (int j_ = 0; j_ < 4; ++j_) XQ[j_] = *(const u32x2*)(X1 + (size_t)(t0 + (tk_)) * D + 256 * j_ + 4 * lane); } while (0)
#define P11_DO(YQ, XQ, tk_) do { f32x4 y[4]; \
            _Pragma("unroll") for (int j = 0; j < 4; ++j) y[j] = (f32x4){0.f, 0.f, 0.f, 0.f}; \
            _Pragma("unroll") for (int k = 0; k < 4; ++k) _Pragma("unroll") for (int j = 0; j < 4; ++j) { const int w = YQ[k][j]; const f32x2_ lo = __builtin_amdgcn_cvt_pk_f32_fp8(w, false), hi = __builtin_amdgcn_cvt_pk_f32_fp8(w, true); y[j] += (f32x4){lo.x, lo.y, hi.x, hi.y}; } \
            float ss = 0.f; \
            _Pragma("unroll") for (int j = 0; j < 4; ++j) { y[j] = y[j] * Y8_INV; ss += (y[j].x * y[j].x + y[j].y * y[j].y) + (y[j].z * y[j].z + y[j].w * y[j].w); } \
            const float rstd = rsqrtf(wave_sum(ss) * (1.f / D) + EPS); \
            _Pragma("unroll") for (int j = 0; j < 4; ++j) { const int k = 256 * j + 4 * lane; const u32x2 xw = XQ[j]; const f32x4 x1 = (f32x4){bflo(xw.x), bfhi(xw.x), bflo(xw.y), bfhi(xw.y)}; \
                *(f32x4*)(F.out + (size_t)(t0 + (tk_)) * D + k) = (DBG_MODE >= 1) ? x1 : x1 + gm[j] * (y[j] * rstd); } } while (0)
        P11_LOAD(yq0, xq0, 0);
#pragma clang loop unroll(disable)
        for (int tk = 0; tk < 16; tk += 2) {
            P11_LOAD(yq1, xq1, tk + 1);
            P11_DO(yq0, xq0, tk);
            if (tk + 2 < 16) P11_LOAD(yq0, xq0, tk + 2);
            P11_DO(yq1, xq1, tk + 1);
        }
#undef P11_DO
#undef P11_LOAD
    }
}

struct Args { const float* in[23]; float* out; unsigned char* ws; int ph_lo, ph_hi; };
__global__ void __launch_bounds__(NTHR, 2) mk_fwd(Args args) {
    extern __shared__ __attribute__((aligned(16))) unsigned char lds_raw[];
    Fr F; F.lds = (LAS unsigned char*)lds_raw; F.ws = args.ws; F.out = args.out;
#pragma unroll
    for (int i = 0; i < 23; ++i) F.in[i] = args.in[i];
    F.tid = threadIdx.x; F.lane = F.tid & 63; F.wave = __builtin_amdgcn_readfirstlane(F.tid >> 6); F.wg = blockIdx.x; F.G = gridDim.x;
    volatile LAS unsigned* MISC = (volatile LAS unsigned*)(F.lds + LDS_MISC);
    if (F.tid < 16) MISC[F.tid] = 0u;
    __syncthreads();
    const int lo = args.ph_lo, hi = args.ph_hi;
    XcdBarrier bar; bar.bar = WSP(unsigned, WS_CTL) + CW_BAR; bar.x = 0; bar.st = nullptr;
    if (hi - lo > 1) bar = xcd_barrier_post(WSP(unsigned, WS_CTL) + CW_BAR, MISC + 8);
#define IN(k) (lo <= (k) && (k) < hi)
#define SEAM(k) do { if (IN(k) && IN((k) + 1)) xcd_barrier(bar); } while (0)
#define PH0 { p0_prologue(F); }
#define PH1 { p1_norm(F); }
#define PH2 { pg8::Gemm g{WSP(bf16, WS_HALL), WSP(bf16, WS_WINT), TALL, NPROJ, D}; pg8::StaticOrder S; S.init(TALL, NPROJ, F.G, F.wg); \
        EpiStore E{WSP(bf16, WS_P), NPROJ}; pg8::gemm_phase<EpiStore, pg8::StaticOrder, true, true>(F.lds, g, S, E); \
        if (F.wg >= 154 && F.G == 256) p4_convert(F, F.wg - 154, 102, CV_A0, CV_A1); }
#define PH3 { p3_prep(F); if (F.wg >= 32 && F.G == 256) p4_convert(F, F.wg - 32, 224, CV_A1, CV_B1); }
#define PH4 {   \
        if (F.wg < 240) { scan_run<0>(F, F.wg / 15, F.wg % 15); scan_run<1>(F, F.wg / 15, F.wg % 15); } else if (F.G == 256) p4_convert(F, F.wg - 240, 16, CV_B1, CV_C1);        \
        xcd_barrier(bar); \
        if (F.wg < 128) scan_combine(F, F.wg); else { p4_sgu(F, F.wg - 128, F.G - 128, 0, 256); }        \
        xcd_barrier(bar); \
        if (F.wg < 256) scan_run<2>(F, F.wg >> 4, F.wg & 15); \
        p4_sgu(F, F.wg, F.G, 256, NB * 128 * 4); p4_convert(F, F.wg, F.G, F.G == 256 ? CV_C1 : 0, CV_D0); }
#define PH5 { p5_gdn_out(F); }
#define PH6 { pg8::Gemm g{WSP(bf16, WS_MIX), WSP(bf16, WS_WOUTT), T, D, D}; pg8::StaticOrder S; S.init(T, D, F.G, F.wg); \
        EpiStore E{WSP(bf16, WS_R), D}; pg8::gemm_phase<EpiStore, pg8::StaticOrder, true, true>(F.lds, g, S, E); }
#define PH7 { p7_mid(F); }
#define PH8 { p8_permute(F); }
#define PH9 { moe_tables(F); const LAS int* tab = (const LAS int*)(F.lds + LDS_TAB); const int npan = tab[64] < MAXPAN ? tab[64] : MAXPAN; \
        pg8::Gemm g{WSP(bf16, WS_H2), WSP(bf16, WS_WGUT), npan * 256, 2048, D / 2}; MoeOrder S; S.init(npan, 8, F.G, F.wg, tab + 128); \
        { LAS int* gm = (LAS int*)(F.lds + LDS_GMAP); const int* RT = WSP(int, WS_ROWTOK); pg8::Unit uu; \
            for (int i = 0; i < 17 && S.next(i, uu); ++i) if (F.tid < 256) gm[i * 256 + F.tid] = RT[uu.pm * 256 + F.tid]; \
            __syncthreads(); } \
        EpiSwiGLU E{WSP(unsigned char, WS_ACT), WSP(float, WS_BGUP), (LAS float*)(F.lds + LDS_EPI)}; pg8::gemm_phase<EpiSwiGLU, MoeOrder, true, true, true, true>(F.lds, g, S, E, (const LAS int*)(F.lds + LDS_GMAP)); \
        { const int rem = (npan * 8) % F.G; if (rem == 0) p4_convert(F, F.wg, F.G, CV_D0, NE * 768); else if (F.wg >= rem) p4_convert(F, F.wg - rem, F.G - rem, CV_D0, NE * 768); } }
#define PH10 { moe_tables(F); const LAS int* tab = (const LAS int*)(F.lds + LDS_TAB); const int npan = tab[64] < MAXPAN ? tab[64] : MAXPAN; \
        pg8::Gemm g{WSP(bf16, WS_ACT), WSP(bf16, WS_WDT), npan * 256, 1024, D / 2}; MoeOrder S; S.init(npan, 4, F.G, F.wg, tab + 128); \
        EpiDown E{WSP(unsigned char, WS_Y), F.in[22], WSP(float, WS_ROWGATE), (LAS float*)(F.lds + LDS_EPI)}; pg8::gemm_phase<EpiDown, MoeOrder, true, true, true>(F.lds, g, S, E); }
#define RUN(k, BODY) do { if (IN(k)) BODY if (PROBE_TWICE == (k) && IN(k)) { xcd_barrier(bar); BODY } } while (0)
    RUN(0, PH0); SEAM(0);
    RUN(1, PH1); SEAM(1);
    RUN(2, PH2); SEAM(2);
    RUN(3, PH3); SEAM(3);
    RUN(4, PH4);
    if (PROBE_TWICE == 46 && IN(4)) { xcd_barrier(bar); if (F.wg < 240) scan_run<0>(F, F.wg / 15, F.wg % 15); else if (F.wg < 256) scan_run<1>(F, (F.wg - 240) / 15, (F.wg - 240) % 15); if (F.wg < 224) scan_run<1>(F, (F.wg + 16) / 15, (F.wg + 16) % 15); }
    if (PROBE_TWICE == 47 && IN(4)) { xcd_barrier(bar); if (F.wg < 256) scan_run<2>(F, F.wg >> 4, F.wg & 15); }
    if (PROBE_TWICE == 48 && IN(4)) { xcd_barrier(bar); p4_convert(F, F.wg, F.G, CV_C1, CV_D0); }
    if (PROBE_TWICE == 49 && IN(4)) { xcd_barrier(bar); if (F.wg < 128) scan_combine(F, F.wg); }
    SEAM(4);
    RUN(5, PH5); SEAM(5);
    RUN(6, PH6); SEAM(6);
    RUN(7, PH7); SEAM(7);
    RUN(8, PH8); SEAM(8);
    RUN(9, PH9);
#define PH9X(EM) { moe_tables(F); const LAS int* tab = (const LAS int*)(F.lds + LDS_TAB); const int npan = tab[64] < MAXPAN ? tab[64] : MAXPAN; \
        pg8::Gemm g{WSP(bf16, WS_H2), WSP(bf16, WS_WGUT), npan * 256, 2048, D / 2}; MoeOrder S; S.init(npan, 8, F.G, F.wg, tab + 128); \
        { LAS int* gm = (LAS int*)(F.lds + LDS_GMAP); const int* RT = WSP(int, WS_ROWTOK); pg8::Unit uu; \
            for (int i = 0; i < 17 && S.next(i, uu); ++i) if (F.tid < 256) gm[i * 256 + F.tid] = RT[uu.pm * 256 + F.tid]; \
            __syncthreads(); } \
        EpiSwiGLUT<EM> E{WSP(unsigned char, WS_Y), WSP(float, WS_BGUP), (LAS float*)(F.lds + LDS_EPI)}; pg8::gemm_phase<EpiSwiGLUT<EM>, MoeOrder, true, true, true, true>(F.lds, g, S, E, (const LAS int*)(F.lds + LDS_GMAP)); }
    if (PROBE_TWICE == 90 && IN(9)) { xcd_barrier(bar); PH9X(0) }
    if (PROBE_TWICE == 93 && IN(9)) { xcd_barrier(bar); PH9X(3) }
    SEAM(9);
    RUN(10, PH10);
#define PH10X(EM) { moe_tables(F); const LAS int* tab = (const LAS int*)(F.lds + LDS_TAB); const int npan = tab[64] < MAXPAN ? tab[64] : MAXPAN; \
        pg8::Gemm g{WSP(bf16, WS_ACT), WSP(bf16, WS_WDT), npan * 256, 1024, D / 2}; MoeOrder S; S.init(npan, 4, F.G, F.wg, tab + 128); \
        EpiDownT<EM> E{WSP(unsigned char, WS_R1) + 136 * MiB, F.in[22], WSP(float, WS_ROWGATE), (LAS float*)(F.lds + LDS_EPI)}; pg8::gemm_phase<EpiDownT<EM>, MoeOrder, true, true, true>(F.lds, g, S, E); }
    if (PROBE_TWICE == 100 && IN(10)) { xcd_barrier(bar); PH10X(0) }
    if (PROBE_TWICE == 101 && IN(10)) { xcd_barrier(bar); PH10X(1) }
    if (PROBE_TWICE == 103 && IN(10)) { xcd_barrier(bar); PH10X(3) }
    if (PROBE_TWICE == 104 && IN(10)) { xcd_barrier(bar); moe_tables(F); const LAS int* tab = (const LAS int*)(F.lds + LDS_TAB); const int npan = tab[64] < MAXPAN ? tab[64] : MAXPAN;
        pg8::Gemm g{WSP(bf16, WS_ACT), WSP(bf16, WS_WDT), npan * 256, 1024, D}; MoeOrder S; S.init(npan / 2, 4, F.G, F.wg, tab + 128);
        EpiDownT<3> E{WSP(unsigned char, WS_R1) + 136 * MiB, F.in[22], WSP(float, WS_ROWGATE), (LAS float*)(F.lds + LDS_EPI)}; pg8::gemm_phase<EpiDownT<3>, MoeOrder, true, true, true>(F.lds, g, S, E); }
    SEAM(10);
    if (IN(11)) {
        if (DBG_MODE == 10) { const unsigned short* src = (const unsigned short*)(F.ws + WS_PREP);
            for (size_t i = (size_t)F.wg * NTHR + F.tid; i < (size_t)T * D; i += (size_t)F.G * NTHR) { float v = bf2f(src[i * 3]); F.out[i] = (v == v && fabsf(v) < 1e30f) ? v : 0.f; } }
        else if (DBG_MODE == 11) { const unsigned short* src = (const unsigned short*)(F.ws + WS_O);
            for (size_t i = (size_t)F.wg * NTHR + F.tid; i < (size_t)T * D; i += (size_t)F.G * NTHR) { float v = bf2f(src[i]); F.out[i] = (v == v && fabsf(v) < 1e30f) ? v : 0.f; } }
        else { p11_final(F); if (PROBE_TWICE == 11) { xcd_barrier(bar); p11_final(F); } } }
#undef IN
#undef SEAM
}

extern "C" void kernel_launch(void* const* d_in, const int* in_sizes, int n_in, void* d_out, int out_size, void* d_ws, size_t ws_size, hipStream_t stream) {
    static int grid = 0;
    if (grid == 0) {
        if (n_in != 23 || out_size != T * D || ws_size < WS_END) { fprintf(stderr, "kernel_launch: unexpected problem (n_in %d, out %d, ws %zu)\n", n_in, out_size, ws_size); grid = -1; return; }
        int dev = 0, cus = 0;
        if (hipGetDevice(&dev) != hipSuccess || hipDeviceGetAttribute(&cus, hipDeviceAttributeMultiprocessorCount, dev) != hipSuccess) { grid = -1; return; }
        if (hipFuncSetAttribute((const void*)mk_fwd, hipFuncAttributeMaxDynamicSharedMemorySize, LDS_BYTES) != hipSuccess) { fprintf(stderr, "kernel_launch: hipFuncSetAttribute failed\n"); grid = -1; return; }
        int per_cu = 0;
        if (hipOccupancyMaxActiveBlocksPerMultiprocessor(&per_cu, (const void*)mk_fwd, NTHR, LDS_BYTES) != hipSuccess || per_cu < 1) fprintf(stderr, "kernel_launch: occupancy query says %d\n", per_cu);
        (void)hipGetLastError();
        grid = cus;
        if (T % grid != 0 || T / grid > 256 || (T / grid) % 16 != 0 || SEQ % (T / grid) != 0) { fprintf(stderr, "kernel_launch: grid %d unsupported\n", grid); grid = -1; return; }
    }
    if (grid < 0) return;
    (void)hipMemsetAsync((char*)d_ws + WS_CTL, 0, CTL_BYTES, stream);
    Args a{};
    for (int i = 0; i < 23; ++i) a.in[i] = (const float*)d_in[i];
    a.out = (float*)d_out; a.ws = (unsigned char*)d_ws;
#if MK_PER_PHASE
    for (int p = 0; p < NPHASE; ++p) { if (DBG_MODE >= 10 && p >= 5 && p <= 10) continue; a.ph_lo = p; a.ph_hi = p + 1; hipLaunchKernelGGL(mk_fwd, dim3(grid), dim3(NTHR), LDS_BYTES, stream, a); }
#else
    a.ph_lo = 0; a.ph_hi = NPHASE; hipLaunchKernelGGL(mk_fwd, dim3(grid), dim3(NTHR), LDS_BYTES, stream, a);
#endif
}
```

```cpp
#include <hip/hip_runtime.h>
#include <cstdio>
#include <cstdint>
namespace pg8 {
#define PG8_LAS __attribute__((address_space(3)))
typedef unsigned short bf16_t;
typedef short bf16x8 __attribute__((ext_vector_type(8)));
typedef float f32x4 __attribute__((ext_vector_type(4)));
typedef unsigned u32x4 __attribute__((ext_vector_type(4)));
constexpr int BM = 256, BK = 64, HALF = 128, HTB = HALF * BK * 2  , STAGE_BYTES = 8 * HTB, NXCD = 8, WGM = 8;

__host__ __device__ __forceinline__ int lds_byte(int r, int c) { const int st = (r >> 4) * 2 + (c >> 5), rr = r & 15, cc = c & 31, ob = rr * 64 + cc * 2; return st * 1024 + (ob ^ (((ob >> 9) & 1) << 5)); }
__host__ __device__ __forceinline__ void stage_rc(int b, int& R, int& C) { const int st = b / 1024, sb = b % 1024, swz = sb ^ (((sb >> 9) & 1) << 5); R = (st >> 1) * 16 + swz / 64; C = (st & 1) * 32 + (swz % 64) / 2; }
__host__ __device__ __forceinline__ int perm32(int rho) { const int n = rho >> 4, i = rho & 15; return 8 * (i >> 2) + 4 * n + (i & 3); }

struct Unit { int pm, pn; };
struct Gemm { const bf16_t* A; const bf16_t* Bt; int M, N, K; };

struct StaticOrder {
    int nM, nN, nwg, G, c;
    __host__ __device__ void init(int M, int N, int G_, int c_) { nM = M / BM; nN = N / BM; nwg = nM * nN; G = G_; c = c_; }
    __host__ __device__ bool next(int i, Unit& u) const {
        const long L = (long)i * G + c; if (L >= nwg) return false;
        int wgid = (int)L; { const int q = nwg / NXCD, r = nwg % NXCD, xcd = wgid % NXCD, off = wgid / NXCD; wgid = (xcd < r ? xcd * (q + 1) : r * (q + 1) + (xcd - r) * q) + off; }
        const int nig = WGM * nN, gid = wgid / nig, fm = gid * WGM, gsz = (nM - fm) < WGM ? (nM - fm) : WGM;
        u.pm = fm + ((wgid % nig) % gsz); u.pn = (wgid % nig) / gsz; return true;
    }
    __device__ __forceinline__ void a_ready(const Unit&) const {}
    __device__ __forceinline__ void done(const Unit&) const {}
};
__device__ __forceinline__ unsigned cvt_pk_bf16(float lo, float hi) { unsigned r; asm volatile("v_cvt_pk_bf16_f32 %0, %1, %2" : "=v"(r) : "v"(lo), "v"(hi)); return r; }
template <class Epi, class Sched, bool ALIGN_EPI = false, bool SP2 = false, bool FP8 = false, bool GATHER = false>
__device__ __forceinline__ void gemm_phase(PG8_LAS unsigned char* lds, const Gemm g, const Sched& S, const Epi& E, const PG8_LAS int* gmap = nullptr) {
    typedef int i32x8_ __attribute__((ext_vector_type(8))); typedef int i32x4_ __attribute__((ext_vector_type(4)));
    const int tid = threadIdx.x, wid = __builtin_amdgcn_readfirstlane(tid >> 6), lane = tid & 63, wr = wid >> 2, wc = wid & 3, fr = lane & 15, fq = lane >> 4;
    const int K = g.K, nt = K / BK;
    unsigned voffA[2], voffB[2];
    int gR[2]; unsigned gCb[2]; unsigned gC0[2], gC1[2], gN0[2], gN1[2];
#pragma unroll
    for (int i = 0; i < 2; ++i) { int R, C; stage_rc(tid * 16 + i * 8192, R, C); const int Rb = Epi::PERM ? ((R & ~31) + perm32(R & 31)) : R;
        voffA[i] = (unsigned)(R * K + C) * 2u; voffB[i] = (unsigned)(Rb * K + C) * 2u; gR[i] = R; gCb[i] = (unsigned)C * 2u; }
#define PG8_GOFF(D0, D1, ui_) do { _Pragma("unroll") for (int i_ = 0; i_ < 2; ++i_) { D0[i_] = (unsigned)gmap[(ui_) * 256 + gR[i_]] * (unsigned)(K * 2) + gCb[i_]; D1[i_] = (unsigned)gmap[(ui_) * 256 + 128 + gR[i_]] * (unsigned)(K * 2) + gCb[i_]; } } while (0)
#define PG8_STAGE_A(bufoff, gbase, h_, nx_) do { if constexpr (GATHER) { if (nx_) PG8_STAGE(bufoff, gbase, ((h_) ? gN1 : gN0)); else PG8_STAGE(bufoff, gbase, ((h_) ? gC1 : gC0)); } \
        else PG8_STAGE(bufoff, (gbase) + ((h_) ? hstep : 0), voffA); } while (0)
    const size_t kstep = (size_t)(BK * 2);
    const size_t hstep = (size_t)HALF * K * 2;
    const size_t tstep = 2 * hstep;
    const unsigned ldsw = (unsigned)wid * 1024u;
    const int aoff = lds_byte(wr * 64 + fr, fq * 8), boff = lds_byte(wc * 32 + fr, fq * 8);
#define PG8_SA(b, h) (((b) * 2 + (h)) * HTB)
#define PG8_SB(b, h) ((4 + (b) * 2 + (h)) * HTB)
#define PG8_STAGE(bufoff, gbase, voff) do { _Pragma("unroll") for (int _i = 0; _i < 2; ++_i) \
        __builtin_amdgcn_global_load_lds((const unsigned*)((const char*)(gbase) + (voff)[_i]), (PG8_LAS unsigned*)(lds + (bufoff) + ldsw + _i * 8192), 16, 0, 0); } while (0)
#define PG8_LDA(dst, b, h) do { _Pragma("unroll") for (int m = 0; m < 4; ++m) _Pragma("unroll") for (int k = 0; k < 2; ++k) dst[m][k] = *(const PG8_LAS bf16x8*)(lds + PG8_SA(b, h) + aoff + m * 2048 + k * 1024); } while (0)
#define PG8_LDB(dst, b, h) do { _Pragma("unroll") for (int n = 0; n < 2; ++n) _Pragma("unroll") for (int k = 0; k < 2; ++k) dst[n][k] = *(const PG8_LAS bf16x8*)(lds + PG8_SB(b, h) + boff + n * 2048 + k * 1024); } while (0)
#define PG8_MMA16(ai, bj, At, Bt) do { __builtin_amdgcn_s_setprio(1); _Pragma("unroll") for (int m = 0; m < 4; ++m) _Pragma("unroll") for (int n = 0; n < 2; ++n) _Pragma("unroll") for (int k = 0; k < 2; ++k) \
        acc[ai][bj][m][n] = __builtin_amdgcn_mfma_f32_16x16x32_bf16(Bt[n][k], At[m][k], acc[ai][bj][m][n], 0, 0, 0); __builtin_amdgcn_s_setprio(0); } while (0)
#define PG8_LDA8(dst, b, h) do { _Pragma("unroll") for (int m = 0; m < 4; ++m) { const i32x4_ lo_ = *(const PG8_LAS i32x4_*)(lds + PG8_SA(b, h) + aoff + m * 2048), hi_ = *(const PG8_LAS i32x4_*)(lds + PG8_SA(b, h) + aoff + m * 2048 + 1024); \
        dst[m] = __builtin_shufflevector(lo_, hi_, 0, 1, 2, 3, 4, 5, 6, 7); } } while (0)
#define PG8_LDB8(dst, b, h) do { _Pragma("unroll") for (int n = 0; n < 2; ++n) { const i32x4_ lo_ = *(const PG8_LAS i32x4_*)(lds + PG8_SB(b, h) + boff + n * 2048), hi_ = *(const PG8_LAS i32x4_*)(lds + PG8_SB(b, h) + boff + n * 2048 + 1024); \
        dst[n] = __builtin_shufflevector(lo_, hi_, 0, 1, 2, 3, 4, 5, 6, 7); } } while (0)
#define PG8_MMA8(ai, bj, At, Bt) do { __builtin_amdgcn_s_setprio(1); _Pragma("unroll") for (int m = 0; m < 4; ++m) _Pragma("unroll") for (int n = 0; n < 2; ++n) \
        asm volatile("v_mfma_f32_16x16x128_f8f6f4 %0, %1, %2, %0" : "+v"(acc[ai][bj][m][n]) : "v"(Bt[n]), "v"(At[m])); \
        __builtin_amdgcn_s_setprio(0); } while (0)
#define PG8_LDAX(dst, b, h) do { if constexpr (FP8) PG8_LDA8(dst##8, b, h); else PG8_LDA(dst, b, h); } while (0)
#define PG8_LDBX(dst, b, h) do { if constexpr (FP8) PG8_LDB8(dst##8, b, h); else PG8_LDB(dst, b, h); } while (0)
#define PG8_MMA(ai, bj, At, Bt) do { if constexpr (FP8) PG8_MMA8(ai, bj, At##8, Bt##8); else PG8_MMA16(ai, bj, At, Bt); } while (0)
#define PG8_WAIT_V(n) asm volatile("s_waitcnt vmcnt(" #n ")" ::: "memory")
#define PG8_WAIT_L(n) asm volatile("s_waitcnt lgkmcnt(" #n ")" ::: "memory")
#define PG8_BAR __builtin_amdgcn_s_barrier()
#define PG8_SCHED __builtin_amdgcn_sched_barrier(0)
    Unit cur, nxt; int ui = 0;
    if (!S.next(0, cur)) return;
    f32x4 acc[2][2][4][2];
#pragma unroll
    for (int a = 0; a < 2; ++a)
#pragma unroll
        for (int b = 0; b < 2; ++b)
#pragma unroll
            for (int m = 0; m < 4; ++m)
#pragma unroll
                for (int n = 0; n < 2; ++n) acc[a][b][m][n] = (f32x4){0.f, 0.f, 0.f, 0.f};
    bf16x8 At[4][2], B0[2][2], B1[2][2];
    i32x8_ At8[4], B08[2], B18[2]; int scale1 = 0x7f7f7f7f; asm volatile("" : "+v"(scale1));
    const char* cA = (const char*)g.A + (GATHER ? (size_t)0 : (size_t)cur.pm * tstep); const char* cB = (const char*)g.Bt + (size_t)cur.pn * tstep;
    if constexpr (GATHER) { PG8_GOFF(gC0, gC1, 0); }
    S.a_ready(cur);
    E.pre(cur, wid, lane, 0);
    if constexpr (SP2) {
        PG8_STAGE(PG8_SB(0, 0), cB, voffB); PG8_STAGE(PG8_SB(0, 1), cB + hstep, voffB); PG8_STAGE_A(PG8_SA(0, 0), cA, 0, false); PG8_STAGE_A(PG8_SA(0, 1), cA, 1, false);
        if (wr == 1) PG8_BAR;
        PG8_WAIT_V(2); PG8_BAR;
        PG8_STAGE(PG8_SB(1, 0), cB + kstep, voffB); PG8_STAGE_A(PG8_SA(1, 0), cA + kstep, 0, false); PG8_STAGE(PG8_SB(1, 1), cB + hstep + kstep, voffB);
        PG8_WAIT_V(6); PG8_BAR;
    } else {
        PG8_STAGE(PG8_SB(0, 0), cB, voffB); PG8_STAGE(PG8_SA(0, 0), cA, voffA); PG8_STAGE(PG8_SB(0, 1), cB + hstep, voffB); PG8_STAGE(PG8_SA(0, 1), cA + hstep, voffA);
        if (wr == 1) PG8_BAR;
        PG8_WAIT_V(4); PG8_BAR;
        PG8_STAGE(PG8_SB(1, 0), cB + kstep, voffB); PG8_STAGE(PG8_SA(1, 0), cA + kstep, voffA); PG8_STAGE(PG8_SB(1, 1), cB + hstep + kstep, voffB);
        PG8_WAIT_V(6); PG8_BAR;
    }
    for (;;) {
        const bool has_next = S.next(ui + 1, nxt);
        const char* nA = (has_next && !GATHER) ? (const char*)g.A + (size_t)nxt.pm * tstep : cA; const char* nB = has_next ? (const char*)g.Bt + (size_t)nxt.pn * tstep : cB;
        if constexpr (GATHER) { if (has_next) { PG8_GOFF(gN0, gN1, ui + 1); } else { _Pragma("unroll") for (int i_ = 0; i_ < 2; ++i_) { gN0[i_] = gC0[i_]; gN1[i_] = gC1[i_]; } } }
#pragma clang loop unroll(disable)
        for (int t = 0; t < nt; t += 2) {
            const bool last = (t == nt - 2);
            const char* a1 = cA + (size_t)(t + 1) * kstep;
            const char* a2 = last ? nA : cA + (size_t)(t + 2) * kstep; const char* b2 = last ? nB : cB + (size_t)(t + 2) * kstep;
            const char* a3 = a2 + kstep; const char* b3 = b2 + kstep;
            if (last && has_next) S.a_ready(nxt);
            if constexpr (SP2) {
            PG8_LDBX(B0, 0, 0); PG8_LDBX(B1, 0, 1); PG8_SCHED; PG8_LDAX(At, 0, 0); PG8_STAGE_A(PG8_SA(1, 1), a1, 1, false);
            PG8_WAIT_V(8); PG8_WAIT_L(0); PG8_BAR; PG8_MMA(0, 0, At, B0); PG8_MMA(0, 1, At, B1); PG8_BAR; PG8_SCHED;
            PG8_LDAX(At, 0, 1); PG8_STAGE(PG8_SB(0, 0), b2, voffB); PG8_STAGE(PG8_SB(0, 1), b2 + hstep, voffB); PG8_STAGE_A(PG8_SA(0, 0), a2, 0, last);
            PG8_WAIT_V(8); PG8_WAIT_L(0); PG8_BAR; PG8_MMA(1, 0, At, B0); PG8_MMA(1, 1, At, B1); PG8_BAR; PG8_SCHED;
            PG8_LDBX(B0, 1, 0); PG8_LDBX(B1, 1, 1); PG8_SCHED; PG8_LDAX(At, 1, 0); PG8_STAGE_A(PG8_SA(0, 1), a2, 1, last);
            PG8_WAIT_V(8); PG8_WAIT_L(0); PG8_BAR; PG8_MMA(0, 0, At, B0); PG8_MMA(0, 1, At, B1); PG8_BAR; PG8_SCHED;
            PG8_LDAX(At, 1, 1); PG8_STAGE(PG8_SB(1, 0), b3, voffB); PG8_STAGE(PG8_SB(1, 1), b3 + hstep, voffB); PG8_STAGE_A(PG8_SA(1, 0), a3, 0, last);
            PG8_WAIT_V(8); PG8_WAIT_L(0); PG8_BAR; PG8_MMA(1, 0, At, B0); PG8_MMA(1, 1, At, B1); PG8_BAR; PG8_SCHED;
            } else {
            PG8_LDBX(B0, 0, 0); PG8_SCHED; PG8_LDAX(At, 0, 0); PG8_STAGE(PG8_SA(1, 1), a1 + hstep, voffA);
            PG8_WAIT_L(8); PG8_BAR; PG8_WAIT_L(0); PG8_MMA(0, 0, At, B0); PG8_BAR; PG8_SCHED;
            PG8_LDBX(B1, 0, 1); PG8_STAGE(PG8_SB(0, 0), b2, voffB);
            PG8_BAR; PG8_WAIT_L(0); PG8_MMA(0, 1, At, B1); PG8_BAR;
            PG8_LDAX(At, 0, 1); PG8_STAGE(PG8_SA(0, 0), a2, voffA);
            PG8_BAR; PG8_WAIT_L(0); PG8_MMA(1, 0, At, B0); PG8_BAR; PG8_SCHED;
            PG8_STAGE(PG8_SB(0, 1), b2 + hstep, voffB);
            PG8_WAIT_V(6); PG8_BAR; PG8_MMA(1, 1, At, B1); PG8_BAR;
            PG8_LDBX(B0, 1, 0); PG8_SCHED; PG8_LDAX(At, 1, 0); PG8_STAGE(PG8_SA(0, 1), a2 + hstep, voffA);
            PG8_WAIT_L(8); PG8_BAR; PG8_WAIT_L(0); PG8_MMA(0, 0, At, B0); PG8_BAR; PG8_SCHED;
            PG8_LDBX(B1, 1, 1); PG8_STAGE(PG8_SB(1, 0), b3, voffB);
            PG8_BAR; PG8_WAIT_L(0); PG8_MMA(0, 1, At, B1); PG8_BAR;
            PG8_LDAX(At, 1, 1); PG8_STAGE(PG8_SA(1, 0), a3, voffA);
            PG8_BAR; PG8_WAIT_L(0); PG8_MMA(1, 0, At, B0); PG8_BAR; PG8_SCHED;
            PG8_STAGE(PG8_SB(1, 1), b3 + hstep, voffB);
            PG8_WAIT_V(6); PG8_BAR; PG8_MMA(1, 1, At, B1); PG8_BAR;
            }
        }
        if constexpr (ALIGN_EPI) { if (wr == 0) PG8_BAR; }
        if constexpr (FP8) asm volatile("s_nop 15\n\ts_nop 15\n\ts_nop 15\n\ts_nop 15\n\ts_nop 15" ::: "memory");
        if constexpr (!Epi::AFTER_DRAIN) { Unit eu = cur; int fr_ = fr, fq_ = fq; asm volatile("" : "+v"(eu.pm), "+v"(eu.pn), "+v"(fr_), "+v"(fq_));
            E(acc, eu, wr, wc, fr_, fq_, ui & 1); S.done(cur); }
        if (!has_next) break;
#pragma unroll
        for (int a = 0; a < 2; ++a)
#pragma unroll
            for (int b = 0; b < 2; ++b)
#pragma unroll
                for (int m = 0; m < 4; ++m)
#pragma unroll
                    for (int n = 0; n < 2; ++n) acc[a][b][m][n] = (f32x4){0.f, 0.f, 0.f, 0.f};
        cur = nxt; cA = nA; cB = nB; ++ui;
        E.pre(cur, wid, lane, ui & 1);
        if constexpr (GATHER) { _Pragma("unroll") for (int i_ = 0; i_ < 2; ++i_) { gC0[i_] = gN0[i_]; gC1[i_] = gN1[i_]; } }
        if constexpr (ALIGN_EPI) { if (wr == 1) PG8_BAR; }
    }
    PG8_WAIT_V(0);
    if constexpr (!ALIGN_EPI) { if (wr == 0) PG8_BAR; }
    PG8_BAR;
    if constexpr (Epi::AFTER_DRAIN) { E.fused(acc, cur, wr, wc, fr, fq, lds, wid, lane); S.done(cur); }
#undef PG8_SA
#undef PG8_SB
#undef PG8_STAGE
#undef PG8_STAGE_A
#undef PG8_GOFF
#undef PG8_LDA
#undef PG8_LDB
#undef PG8_MMA
#undef PG8_MMA16
#undef PG8_MMA8
#undef PG8_LDA8
#undef PG8_LDB8
#undef PG8_LDAX
#undef PG8_LDBX
#undef PG8_WAIT_V
#undef PG8_WAIT_L
#undef PG8_BAR
#undef PG8_SCHED
}
}

#ifndef MK_PER_PHASE
#define MK_PER_PHASE 0
#endif
#ifndef PROBE_TWICE
#define PROBE_TWICE -1
#endif
#ifndef DBG_SEL
#define DBG_SEL 9
#endif
#ifndef DBG_MODE
#define DBG_MODE 0
#endif
#if 0
#endif

#define GAS __attribute__((address_space(1)))
#define LAS __attribute__((address_space(3)))
typedef unsigned short bf16;
typedef float f32x4 __attribute__((ext_vector_type(4)));
typedef short bf16x8 __attribute__((ext_vector_type(8)));
typedef unsigned u32x4 __attribute__((ext_vector_type(4)));
typedef unsigned u32x2 __attribute__((ext_vector_type(2)));

constexpr int NB = 2, SEQ = 16384, D = 1024, T = NB * SEQ, CTXL = 256, TC = NB * CTXL, TALL = T + TC;
constexpr int NPROJ = 3328, NPROJ_SRC = 3088;
constexpr int PC_Z = 1536, PC_U = 2048, PC_V = 2560, PC_BA = 3072;
constexpr int NH = 4, NE = 32, NCH = 260;
constexpr int MAXPAN = 544, MAXROWS = MAXPAN * 256;
constexpr float EPS = 1e-6f;
constexpr int NWAVES = 8, NTHR = 512;
constexpr int NPHASE = 12;
constexpr int CV_A0 = 0, CV_A1 = 5712, CV_B1 = CV_A1 + 5376, CV_C1 = CV_B1 + 2304, CV_D0 = NE * 768 - 3072;

constexpr size_t MiB = 1ull << 20;
constexpr size_t WS_CTL = 0, CTL_BYTES = 1 * MiB;
constexpr size_t WS_MOD = 1 * MiB;
constexpr size_t WS_WRT = 1 * MiB + 128 * 1024;
constexpr size_t WS_BGUP = 1 * MiB + 256 * 1024;
constexpr size_t WS_TKE = 2 * MiB, WS_TKRANK = 2 * MiB + 512 * 1024, WS_TKGATE = 3 * MiB, WS_TKROW = 3 * MiB + 512 * 1024;
constexpr size_t WS_ROWGATE = 4 * MiB;
constexpr size_t WS_WINT = 6 * MiB;
constexpr size_t WS_WOUTT = 13 * MiB;
constexpr size_t WS_WGUT = 16 * MiB;
constexpr size_t WS_WDT = 144 * MiB;
constexpr size_t WS_X1 = 208 * MiB;
constexpr size_t WS_MIX = WS_X1;
constexpr size_t WS_H2 = 336 * MiB;
constexpr size_t WS_R1 = 400 * MiB;
constexpr size_t WS_P = WS_R1, WS_ACT = WS_R1;
constexpr size_t WS_R2 = 672 * MiB;
constexpr size_t WS_HALL = WS_R2, WS_O = WS_R2;
constexpr size_t WS_PREP = WS_R2 + 65 * MiB;
constexpr size_t WS_R = WS_PREP;
constexpr size_t WS_VEC = WS_R2 + 261 * MiB;
constexpr size_t WS_ROWTOK = WS_R2;
constexpr size_t WS_XS = WS_R2, WS_Y = WS_R2;
constexpr size_t WS_END = 944 * MiB;
constexpr size_t PREP_UNIT = 98304;
constexpr int PO_KQ = 0, PO_KT = 32768, PO_V = 49152, PO_T = 65536, PO_A = 81920;
constexpr int CW_BAR = 4096, CW_GCNT = 8192;

constexpr int LDS_BYTES = 163840;
constexpr int LDS_TAB = 131072;
constexpr int LDS_GMAP = LDS_TAB + 4096;
constexpr int LDS_EPI = LDS_GMAP + 17 * 1024 + 1024;
constexpr int LDS_MISC = LDS_BYTES - 64;

#define LDS_WAIT() asm volatile("s_waitcnt lgkmcnt(0)" ::: "memory")
#define VM_WAIT() asm volatile("s_waitcnt vmcnt(0)" ::: "memory")

__device__ __forceinline__ float bf2f(unsigned b) { return __uint_as_float(b << 16); }
__device__ __forceinline__ float bflo(unsigned w) { return __uint_as_float(w << 16); }
__device__ __forceinline__ float bfhi(unsigned w) { return __uint_as_float(w & 0xffff0000u); }
typedef __bf16 bf16x2_t __attribute__((ext_vector_type(2)));
typedef float f32x2_t __attribute__((ext_vector_type(2)));
__device__ __forceinline__ unsigned pk2(float lo, float hi) { const f32x2_t f = {lo, hi}; const bf16x2_t v = __builtin_convertvector(f, bf16x2_t); return __builtin_bit_cast(unsigned, v); }
__device__ __forceinline__ float sat8(float x) { return __builtin_amdgcn_fmed3f(x, -448.f, 448.f); }
__device__ __forceinline__ unsigned pk_fp8x4(float a, float b, float c, float d) { a = sat8(a); b = sat8(b); c = sat8(c); d = sat8(d); int w = 0; w = __builtin_amdgcn_cvt_pk_fp8_f32(a, b, w, false); w = __builtin_amdgcn_cvt_pk_fp8_f32(c, d, w, true); return (unsigned)w; }
__device__ __forceinline__ unsigned pk_fp8x4_ns(float a, float b, float c, float d) { int w = 0; w = __builtin_amdgcn_cvt_pk_fp8_f32(a, b, w, false); w = __builtin_amdgcn_cvt_pk_fp8_f32(c, d, w, true); return (unsigned)w; }
constexpr float W8_SCALE = 32.f, W8_INV = 1.f / 32.f;
__device__ __forceinline__ float frcp(float x) { return __builtin_amdgcn_rcpf(x); }
__device__ __forceinline__ float sigm(float x) { return frcp(1.f + __expf(-x)); }
__device__ __forceinline__ float silu_(float x) { return x * frcp(1.f + __expf(-x)); }
__device__ __forceinline__ float gelu_t(float x) { const float y = 0.7978845608028654f * (x + 0.044715f * x * x * x); const float t = 1.f - 2.f * frcp(__expf(2.f * y) + 1.f); return 0.5f * x * (1.f + t); }
#define DPP_MOV(v, ctrl) __builtin_bit_cast(float, __builtin_amdgcn_update_dpp(0, __builtin_bit_cast(int, (v)), (ctrl), 0xf, 0xf, true))
__device__ __forceinline__ float sum16(float v) { v += DPP_MOV(v, 0xB1); v += DPP_MOV(v, 0x4E); v += DPP_MOV(v, 0x124); v += DPP_MOV(v, 0x128); return v; }
__device__ __forceinline__ float wave_sum(float v) {
    v = sum16(v); const int iv = __builtin_bit_cast(int, v);
    return (__builtin_bit_cast(float, __builtin_amdgcn_readlane(iv, 0)) + __builtin_bit_cast(float, __builtin_amdgcn_readlane(iv, 16))) + (__builtin_bit_cast(float, __builtin_amdgcn_readlane(iv, 32)) + __builtin_bit_cast(float, __builtin_amdgcn_readlane(iv, 48)));
}
#define XB_TMO      128
#define XB_XCNT(j)  (256  + 64 * (j))
#define XB_XSUB(j)  (1280 + 64 * (j))
#define XB_XGEN(j)  (2304 + 64 * (j))
#define XB_TOP      3328
#define XB_TOPGEN   3392
#define XCD_BAR_WORDS 3456
#define XB_SPIN_CAP (1u << 18)
__device__ __forceinline__ unsigned xb_ld(unsigned* p)              { return __hip_atomic_load(p, __ATOMIC_RELAXED, __HIP_MEMORY_SCOPE_AGENT); }
__device__ __forceinline__ unsigned xb_add(unsigned* p, unsigned v) { return __hip_atomic_fetch_add(p, v, __ATOMIC_RELAXED, __HIP_MEMORY_SCOPE_AGENT); }
__device__ __forceinline__ unsigned xb_xcc_id() { return (unsigned)__builtin_amdgcn_s_getreg((3 << 11) | 20) & 0xFu; }
#define XB_SPIN(cond, bar) do { unsigned _sp = 0; while (cond) { __builtin_amdgcn_s_sleep(1); \
    if ((++_sp & 255u) == 0u) { if (xb_ld(&(bar)[XB_TMO])) break; if (_sp > XB_SPIN_CAP) { atomicAdd(&(bar)[XB_TMO], 1u); break; } } } } while (0)
struct XcdBarrier { unsigned* bar; unsigned x; volatile LAS unsigned* st; };
__device__ __forceinline__ XcdBarrier xcd_barrier_post(unsigned* bar, volatile LAS unsigned* st) {
    XcdBarrier b; b.bar = bar; b.x = xb_xcc_id(); b.st = st;
    if (threadIdx.x == 0) (void)xb_add(&bar[XB_XCNT(b.x)], 1u);
    return b;
}
__device__ __forceinline__ void xcd_barrier_complete(unsigned* bar, unsigned x, unsigned& nloc, unsigned& nx) {
    const unsigned G = gridDim.x * gridDim.y * gridDim.z;
    unsigned sum, cnt, mine, sp = 0u;
    for (;;) {
        sum = 0u; cnt = 0u; mine = 0u;
#pragma unroll
        for (unsigned j = 0; j < 16; ++j) { const unsigned c = xb_ld(&bar[XB_XCNT(j)]); sum += c; cnt += (c > 0u) ? 1u : 0u; mine = (j == x) ? c : mine; }
        if (sum == G) break;
        __builtin_amdgcn_s_sleep(1);
        if ((++sp & 255u) == 0u) { if (xb_ld(&bar[XB_TMO])) break; if (sp > XB_SPIN_CAP) { atomicAdd(&bar[XB_TMO], 1u); break; } }
    }
    nloc = mine > 0u ? mine : 1u; nx = cnt > 0u ? cnt : 1u;
}
__device__ __forceinline__ void xcd_barrier(const XcdBarrier& b) {
    asm volatile("s_waitcnt vmcnt(0)" ::: "memory");
    __syncthreads();
    if (threadIdx.x == 0) {
        unsigned* bar = b.bar;
        __builtin_amdgcn_s_waitcnt(0);
        unsigned nloc = b.st[0], nx = b.st[1];
        if (nloc == 0u) { xcd_barrier_complete(bar, b.x, nloc, nx); b.st[0] = nloc; b.st[1] = nx; }
        const unsigned old = xb_add(&bar[XB_XSUB(b.x)], 1u);
        const unsigned gen = old / nloc;
        if (old + 1u == (gen + 1u) * nloc) {
            __builtin_amdgcn_fence(__ATOMIC_RELEASE, "agent");
            asm volatile("s_waitcnt vmcnt(0)" ::: "memory");
            const unsigned og = xb_add(&bar[XB_TOP], 1u);
            const unsigned tg = og / nx;
            if (og + 1u == (tg + 1u) * nx) xb_add(&bar[XB_TOPGEN], 1u);
            else XB_SPIN(xb_ld(&bar[XB_TOPGEN]) == tg, bar);
            __builtin_amdgcn_fence(__ATOMIC_ACQUIRE, "agent");
            xb_add(&bar[XB_XGEN(b.x)], 1u);
            asm volatile("s_waitcnt vmcnt(0)" ::: "memory");
        } else {
            XB_SPIN(xb_ld(&bar[XB_XGEN(b.x)]) == gen, bar);
            __builtin_amdgcn_fence(__ATOMIC_ACQUIRE, "agent");
            asm volatile("s_waitcnt vmcnt(0)" ::: "memory");
        }
    }
    __syncthreads();
}

struct Fr {
    LAS unsigned char* lds; unsigned char* ws; const float* in[23]; float* out;
    int tid, lane, wave, wg, G;
};
#define WSP(T_, off) ((T_*)(F.ws + (off)))

struct MapId { __device__ __forceinline__ int operator()(int n) const { return n; } };
struct MapIn { __device__ __forceinline__ int operator()(int n) const { return n < 1536 ? n : (n < 1552 ? PC_BA + (n - 1536) : n - 16); } };
struct MapGu { __device__ __forceinline__ int operator()(int s) const { const int a = s >> 1; return 32 * (a >> 4) + 16 * (s & 1) + (a & 15); } };
template <class RM> __device__ __forceinline__ void tr_item(const float* W, int N, int k0, int n0, bf16* WT, RM rm, LAS float* scr, int lane) {
    const int cq = lane & 15, rq = lane >> 4;
#pragma unroll
    for (int i = 0; i < 16; ++i) { const int kk = 4 * i + rq, n = n0 + 4 * cq; f32x4 v = (f32x4){0.f, 0.f, 0.f, 0.f};
        if (n < N) v = *(const f32x4*)(W + (size_t)(k0 + kk) * N + n);
        *(LAS f32x4*)(scr + kk * 68 + 4 * cq) = v; }
    LDS_WAIT();
    const int c = lane & 7;
#pragma unroll
    for (int j = 0; j < 8; ++j) { const int n = 8 * j + (lane >> 3);
        if (n0 + n < N) { const LAS float* s = scr + (8 * c) * 68 + n;
            u32x4 o; o.x = pk2(s[0], s[68]); o.y = pk2(s[136], s[204]); o.z = pk2(s[272], s[340]); o.w = pk2(s[408], s[476]);
            *(u32x4*)(WT + (size_t)rm(n0 + n) * 1024 + k0 + 8 * c) = o; } }
    LDS_WAIT();
}
struct MapGu8 { __device__ __forceinline__ int operator()(int s) const { const int a = s >> 1, n = s & 1, pn = a >> 7, al = a & 127; return 256 * pn + 128 * ((al >> 2) & 1) + 32 * (al >> 5) + 16 * n + 4 * ((al >> 3) & 3) + (al & 3); } };
struct MapDn8 { __device__ __forceinline__ int operator()(int o) const { const int pn = o >> 8, ol = o & 255; return 256 * pn + 128 * ((ol >> 3) & 1) + 32 * (ol >> 6) + 8 * ((ol >> 4) & 3) + (ol & 7); } };
template <class RM> __device__ __forceinline__ void tr_item8(const float* W, int N, int k0, int n0, unsigned char* WT, RM rm, LAS float* scr, int lane) {
    const int cq = lane & 15, rq = lane >> 4;
#pragma unroll
    for (int i = 0; i < 16; ++i) { const int kk = 4 * i + rq, n = n0 + 4 * cq; *(LAS f32x4*)(scr + kk * 68 + 4 * cq) = *(const f32x4*)(W + (size_t)(k0 + kk) * N + n); }
    LDS_WAIT();
    const int c = lane & 7;
#pragma unroll
    for (int j = 0; j < 8; ++j) { const int n = 8 * j + (lane >> 3); const LAS float* sp = scr + (8 * c) * 68 + n;
        u32x2 o; o.x = pk_fp8x4(sp[0] * W8_SCALE, sp[68] * W8_SCALE, sp[136] * W8_SCALE, sp[204] * W8_SCALE); o.y = pk_fp8x4(sp[272] * W8_SCALE, sp[340] * W8_SCALE, sp[408] * W8_SCALE, sp[476] * W8_SCALE);
        *(u32x2*)(WT + (size_t)rm(n0 + n) * 1024 + k0 + 8 * c) = o; }
    LDS_WAIT();
}
__device__ __forceinline__ void p0_prologue(const Fr& F) {
    const float* c = F.in[1]; const float* cc = F.in[3]; const float* wada = F.in[4]; const float* bada = F.in[5];
    {
        LAS float* SIL = (LAS float*)F.lds; LAS float* RED = SIL + 3072; float* MOD = WSP(float, WS_MOD);
        for (int u = F.wg; u < 96; u += F.G) {
            for (int i = F.tid; i < 3072; i += NTHR) { const int r = i >> 10, k = i & 1023; const float x = r == 0 ? c[k] : (r == 1 ? c[1024 + k] : cc[k]); SIL[i] = silu_(x); }
            __syncthreads();
            const int n0 = u * 64, kb = F.wave * 128; float a0 = 0.f, a1 = 0.f, a2 = 0.f;
#pragma unroll 8
            for (int k = 0; k < 128; ++k) { const float w = wada[(size_t)(kb + k) * 6144 + n0 + F.lane]; a0 += SIL[kb + k] * w; a1 += SIL[1024 + kb + k] * w; a2 += SIL[2048 + kb + k] * w; }
            RED[(F.wave * 3 + 0) * 64 + F.lane] = a0; RED[(F.wave * 3 + 1) * 64 + F.lane] = a1; RED[(F.wave * 3 + 2) * 64 + F.lane] = a2;
            __syncthreads();
            if (F.tid < 192) { const int r = F.tid >> 6, l = F.tid & 63; float s = bada[n0 + l];
#pragma unroll
                for (int w = 0; w < 8; ++w) s += RED[(w * 3 + r) * 64 + l];
                MOD[r * 6144 + n0 + l] = s; }
            __syncthreads();
        }
    }
    {
        LAS float* scr = (LAS float*)(F.lds + F.wave * 17408);
        const int gw = F.wg * NWAVES + F.wave, NGW = F.G * NWAVES;
        constexpr int I_IN = 16 * 49, I_OUT = 16 * 16;
        for (int it = gw; it < I_IN + I_OUT; it += NGW) {
            int r = it;
            if (r < I_IN) { tr_item(F.in[7], NPROJ_SRC, (r / 49) * 64, (r % 49) * 64, WSP(bf16, WS_WINT), MapIn{}, scr, F.lane); continue; } r -= I_IN;
            tr_item(F.in[16], 1024, (r / 16) * 64, (r % 16) * 64, WSP(bf16, WS_WOUTT), MapId{}, scr, F.lane);
        }
    }
    {
        const int gt = F.wg * NTHR + F.tid, NGT = F.G * NTHR;
        float* WRT = WSP(float, WS_WRT); const float* rw = F.in[17];
        for (int i = gt; i < NE * 1024; i += NGT) { const int e = i >> 10, k = i & 1023; WRT[i] = rw[k * NE + e]; }
        float* BG = WSP(float, WS_BGUP); const float* bgu = F.in[20]; MapGu8 mg;
        for (int i = gt; i < NE * 2048; i += NGT) { const int e = i >> 11, s = i & 2047; BG[e * 2048 + mg(s)] = bgu[i] + ((s & 1) ? 1.f : 0.f); }
        u32x4* z = (u32x4*)(WSP(bf16, WS_WINT) + (size_t)NPROJ_SRC * 1024);
        for (int i = gt; i < (NPROJ - NPROJ_SRC) * 1024 / 8; i += NGT) z[i] = (u32x4){0u, 0u, 0u, 0u};
    }
}

__device__ __forceinline__ void p4_convert(const Fr& F, int worker, int nworkers, int it_lo, int it_hi) {
    LAS float* scr = (LAS float*)(F.lds + F.wave * 17408);
    const int gw = worker * NWAVES + F.wave, NGW = nworkers * NWAVES;
    constexpr int I_GU = NE * 16 * 32, I_DN = NE * 16 * 16;
    for (int it = it_lo + gw; it < it_hi; it += NGW) {
        int r = it;
        if (r < I_GU) { const int e = r / 512, rr = r % 512; tr_item8(F.in[19] + (size_t)e * 1024 * 2048, 2048, (rr / 32) * 64, (rr % 32) * 64, WSP(unsigned char, WS_WGUT) + (size_t)e * 2048 * 1024, MapGu8{}, scr, F.lane); continue; } r -= I_GU;
        { const int e = r / 256, rr = r % 256; tr_item8(F.in[21] + (size_t)e * 1024 * 1024, 1024, (rr / 16) * 64, (rr % 16) * 64, WSP(unsigned char, WS_WDT) + (size_t)e * 1024 * 1024, MapDn8{}, scr, F.lane); }
    }
}
__device__ __forceinline__ void p1_norm(const Fr& F) {
    const float* x = F.in[0]; const float* ctx = F.in[2]; const float* ng = F.in[6]; const float* MOD = WSP(float, WS_MOD); bf16* H = WSP(bf16, WS_HALL);
    const int gw = F.wg * NWAVES + F.wave, NGW = F.G * NWAVES, lane = F.lane;
    for (int blk = gw; blk < TALL / 4; blk += NGW) {
        const int r0 = blk * 4; const float* xb = r0 < T ? x + (size_t)r0 * D : ctx + (size_t)(r0 - T) * D; const int mi = r0 < T ? (r0 >> 14) : 2;
        const float* m0 = MOD + mi * 6144; const float* m1 = m0 + 1024;
        f32x4 sc[4], sh[4];
#pragma unroll
        for (int j = 0; j < 4; ++j) { const int k = 256 * j + 4 * lane; sc[j] = *(const f32x4*)(ng + k) * (*(const f32x4*)(m1 + k) + 1.f); sh[j] = *(const f32x4*)(m0 + k); }
        f32x4 cur[4], nxt[4];
#pragma unroll
        for (int j = 0; j < 4; ++j) cur[j] = *(const f32x4*)(xb + 256 * j + 4 * lane);
#pragma clang loop unroll(disable)
        for (int i = 0; i < 4; ++i) {
            const int in = i + 1 < 4 ? i + 1 : i;
#pragma unroll
            for (int j = 0; j < 4; ++j) nxt[j] = *(const f32x4*)(xb + (size_t)in * D + 256 * j + 4 * lane);
            float ss = 0.f;
#pragma unroll
            for (int j = 0; j < 4; ++j) ss += (cur[j].x * cur[j].x + cur[j].y * cur[j].y) + (cur[j].z * cur[j].z + cur[j].w * cur[j].w);
            const float rstd = rsqrtf(wave_sum(ss) * (1.f / D) + EPS);
#pragma unroll
            for (int j = 0; j < 4; ++j) { const f32x4 h = cur[j] * rstd * sc[j] + sh[j];
                u32x2 o; o.x = pk2(h.x, h.y); o.y = pk2(h.z, h.w); *(u32x2*)(H + (size_t)(r0 + i) * D + 256 * j + 4 * lane) = o; cur[j] = nxt[j]; }
        }
    }
}

__device__ __forceinline__ void p3_prep(const Fr& F) {
    const bf16* P = WSP(bf16, WS_P); const float* convw = F.in[8]; const float* alog = F.in[9]; const float* dtb = F.in[10];
    LAS bf16* QL = (LAS bf16*)F.lds; LAS bf16* KL = QL + 64 * 136; LAS bf16* VL = KL + 64 * 136;
    LAS float* AM = (LAS float*)(F.lds + 52224); LAS float* XM = AM + 2 * 64 * 65; LAS bf16* AT = (LAS bf16*)(F.lds + 118784);
    LAS float* TMPW = (LAS float*)(F.lds + 137216); LAS float* GV = (LAS float*)(F.lds + 139392);
    for (int u = F.wg; u < NB * NCH * NH; u += F.G) {
        int tid = F.tid; asm volatile("" : "+v"(tid));
        const int lane = tid & 63, wave = __builtin_amdgcn_readfirstlane(tid >> 6), l16 = lane & 15, q4 = lane >> 4;
        const int b = u / (NCH * NH), rem = u % (NCH * NH), cn = rem >> 2, h = rem & 3;
        int rowbase, lo, hi;
        if (cn < 4) { lo = T + b * CTXL; hi = lo + CTXL; rowbase = lo + cn * 64; } else { rowbase = b * SEQ + (cn - 4) * 64; lo = rowbase; hi = rowbase + 64; }
        unsigned char* pu = F.ws + WS_PREP + (size_t)u * PREP_UNIT; float* vec = WSP(float, WS_VEC) + (size_t)u * 512;
        u32x4 xc[6], xn[6]; f32x4 cwc[6], cwn[6];
#define P3_LOAD(XD, WD, part_) do { const int cg_ = tid & 15, col_ = (part_) * 512 + h * 128 + cg_ * 8; \
            _Pragma("unroll") for (int sub_ = 0; sub_ < 2; ++sub_) { const int row_ = rowbase + (sub_ << 5) + (tid >> 4); const u32x4 zero_ = (u32x4){0u, 0u, 0u, 0u}; \
                XD[sub_ * 3 + 1] = *(const u32x4*)(P + (size_t)row_ * NPROJ + col_); XD[sub_ * 3 + 0] = zero_; XD[sub_ * 3 + 2] = zero_; \
                if (row_ - 1 >= lo) XD[sub_ * 3 + 0] = *(const u32x4*)(P + (size_t)(row_ - 1) * NPROJ + col_); \
                if (row_ + 1 < hi) XD[sub_ * 3 + 2] = *(const u32x4*)(P + (size_t)(row_ + 1) * NPROJ + col_); } \
            _Pragma("unroll") for (int hh_ = 0; hh_ < 2; ++hh_) { WD[hh_ * 3 + 0] = *(const f32x4*)(convw + col_ + 4 * hh_); WD[hh_ * 3 + 1] = *(const f32x4*)(convw + 1536 + col_ + 4 * hh_); WD[hh_ * 3 + 2] = *(const f32x4*)(convw + 3072 + col_ + 4 * hh_); } } while (0)
        P3_LOAD(xc, cwc, 0);
#pragma unroll
        for (int part = 0; part < 3; ++part) {
            const int cg = tid & 15;
            if (part < 2) P3_LOAD(xn, cwn, part + 1);
#pragma unroll
            for (int sub = 0; sub < 2; ++sub) {
                const int i = (sub << 5) + (tid >> 4);
                const u32x4 xm = xc[sub * 3 + 0], x0 = xc[sub * 3 + 1], xp = xc[sub * 3 + 2];
                float val[8];
#pragma unroll
                for (int hh = 0; hh < 2; ++hh) {
                    const f32x4 w0 = cwc[hh * 3 + 0], w1 = cwc[hh * 3 + 1], w2 = cwc[hh * 3 + 2];
                    const unsigned m0 = hh ? xm.z : xm.x, m1 = hh ? xm.w : xm.y, c0 = hh ? x0.z : x0.x, c1 = hh ? x0.w : x0.y, p0 = hh ? xp.z : xp.x, p1 = hh ? xp.w : xp.y;
                    val[4 * hh + 0] = w0.x * bflo(m0) + w1.x * bflo(c0) + w2.x * bflo(p0);
                    val[4 * hh + 1] = w0.y * bfhi(m0) + w1.y * bfhi(c0) + w2.y * bfhi(p0);
                    val[4 * hh + 2] = w0.z * bflo(m1) + w1.z * bflo(c1) + w2.z * bflo(p1);
                    val[4 * hh + 3] = w0.w * bfhi(m1) + w1.w * bfhi(c1) + w2.w * bfhi(p1);
                }
                float ss = 0.f;
#pragma unroll
                for (int e = 0; e < 8; ++e) { val[e] = silu_(val[e]); ss += val[e] * val[e]; }
                if (part < 2) { ss = sum16(ss); const float sc = rsqrtf(ss + EPS) * (part == 0 ? 0.08838834764831845f : 1.f);
#pragma unroll
                    for (int e = 0; e < 8; ++e) val[e] *= sc; }
                u32x4 w; w.x = pk2(val[0], val[1]); w.y = pk2(val[2], val[3]); w.z = pk2(val[4], val[5]); w.w = pk2(val[6], val[7]);
                LAS bf16* dst = part == 0 ? QL : (part == 1 ? KL : VL);
                *(LAS u32x4*)(dst + i * 136 + cg * 8) = w;
                if (part < 2) { const int rb = (part == 0 ? 4 : 0) + (i >> 4), ks = cg >> 2, ln = (i & 15) + 16 * (cg & 3);
                    *(u32x4*)(pu + PO_KQ + ((rb * 4 + ks) * 64 + ln) * 16) = w; }
            }
#pragma unroll
            for (int e = 0; e < 6; ++e) { cwc[e] = cwn[e]; xc[e] = xn[e]; }
        }
#undef P3_LOAD
        if (wave < 2) {
            const int d = wave, row = rowbase + lane;
            const float bb = bf2f(P[(size_t)row * NPROJ + PC_BA + d * 4 + h]), aa = bf2f(P[(size_t)row * NPROJ + PC_BA + 8 + d * 4 + h]);
            const float beta = sigm(bb), xx = aa + dtb[d * 4 + h];
            const float sp = xx > 20.f ? xx : log1pf(expf(xx));
            float Gc = -expf(alog[d * 4 + h]) * sp;
#pragma unroll
            for (int o = 1; o < 64; o <<= 1) { const float up = __shfl_up(Gc, o), dn = __shfl_down(Gc, o);
                if (d == 0) { if (lane >= o) Gc += up; } else { if (lane + o < 64) Gc += dn; } }
            const float glast = __shfl(Gc, d == 0 ? 63 : 0);
            GV[d * 64 + lane] = Gc; GV[128 + d * 64 + lane] = beta;
            float* vd = vec + d * 256;
            vd[lane] = expf(Gc); vd[64 + lane] = beta; vd[128 + lane] = expf(glast - Gc); vd[192 + lane] = expf(glast);
        }
        __syncthreads();
#pragma unroll
        for (int jj = 0; jj < 4; ++jj) {
            const int job = wave * 4 + jj, mat = job >> 4, ti = (job >> 2) & 3, tj = job & 3;
            const LAS bf16* Ap = (mat == 0 ? KL : QL) + (ti * 16 + l16) * 136 + q4 * 8;
            const LAS bf16* Bp = KL + (tj * 16 + l16) * 136 + q4 * 8;
            f32x4 acc = (f32x4){0.f, 0.f, 0.f, 0.f};
#pragma unroll
            for (int ks = 0; ks < 4; ++ks) acc = __builtin_amdgcn_mfma_f32_16x16x32_bf16(*(const LAS bf16x8*)(Ap + ks * 32), *(const LAS bf16x8*)(Bp + ks * 32), acc, 0, 0, 0);
            const int j = tj * 16 + l16;
#pragma unroll
            for (int d = 0; d < 2; ++d) {
                const float Gj = GV[d * 64 + j];
#pragma unroll
                for (int r = 0; r < 4; ++r) { const int i = ti * 16 + 4 * q4 + r; const float Gi = GV[d * 64 + i];
                    const float dec = __expf(fminf(Gi - Gj, 0.f));
                    if (mat == 0) { const bool ok = d == 0 ? (j < i) : (j > i); const float v = ok ? GV[128 + d * 64 + i] * acc[r] * dec : 0.f;
                        const int ii = d == 0 ? i : 63 - i, jx = d == 0 ? j : 63 - j; AM[d * 4160 + ii * 65 + jx] = v; }
                    else { const bool ok = d == 0 ? (j <= i) : (j >= i); const float v = ok ? acc[r] * dec : 0.f; AT[d * 4608 + i * 72 + j] = (bf16)(pk2(v, 0.f) & 0xffffu); }
                }
            }
        }
        __syncthreads();
        if (wave < 2) {
            const int d = wave; LAS float* A = AM + d * 4160; LAS float* X = XM + d * 4160; LAS float* TW = TMPW + d * 272;
            for (int r = 0; r < 64; ++r) X[r * 65 + lane] = 0.f;
            LDS_WAIT();
            { const int blk = q4, c = l16; const LAS float* Ab = A + (blk * 16) * 65 + blk * 16; float xv[16];
#pragma unroll
                for (int r = 0; r < 16; ++r) { float s = (r == c) ? 1.f : 0.f;
#pragma unroll
                    for (int m = 0; m < r; ++m) s -= Ab[r * 65 + m] * xv[m];
                    xv[r] = s; }
#pragma unroll
                for (int r = 0; r < 16; ++r) X[(blk * 16 + r) * 65 + blk * 16 + c] = xv[r];
            }
            LDS_WAIT();
#pragma unroll
            for (int dd = 1; dd <= 3; ++dd)
#pragma unroll
                for (int a = dd; a <= 3; ++a) { const int bq = a - dd;
                    f32x4 acc = (f32x4){0.f, 0.f, 0.f, 0.f};
#pragma unroll
                    for (int cc2 = bq; cc2 < a; ++cc2)
#pragma unroll
                        for (int kk = 0; kk < 4; ++kk) { const float av = A[(a * 16 + l16) * 65 + cc2 * 16 + 4 * kk + q4], bv = X[(cc2 * 16 + 4 * kk + q4) * 65 + bq * 16 + l16];
                            acc = __builtin_amdgcn_mfma_f32_16x16x4f32(av, bv, acc, 0, 0, 0); }
#pragma unroll
                    for (int r = 0; r < 4; ++r) TW[(4 * q4 + r) * 17 + l16] = acc[r];
                    LDS_WAIT();
                    f32x4 acc2 = (f32x4){0.f, 0.f, 0.f, 0.f};
#pragma unroll
                    for (int kk = 0; kk < 4; ++kk) { const float av = X[(a * 16 + l16) * 65 + a * 16 + 4 * kk + q4], bv = TW[(4 * kk + q4) * 17 + l16];
                        acc2 = __builtin_amdgcn_mfma_f32_16x16x4f32(av, bv, acc2, 0, 0, 0); }
#pragma unroll
                    for (int r = 0; r < 4; ++r) X[(a * 16 + 4 * q4 + r) * 65 + bq * 16 + l16] = -acc2[r];
                    LDS_WAIT();
                }
        } else {
            const int t6 = tid - 128;
            for (int idx = t6; idx < 1024; idx += 384) { const int d = idx >> 9, e = idx & 511, rb = e >> 7, ks = (e >> 6) & 1, ln = e & 63, i = rb * 16 + (ln & 15), j0 = ks * 32 + (ln >> 4) * 8;
                *(u32x4*)(pu + PO_A + d * 8192 + e * 16) = *(const LAS u32x4*)(AT + d * 4608 + i * 72 + j0); }
            for (int e = t6; e < 1024; e += 384) { const int mb = e >> 7, ks = (e >> 6) & 1, ln = e & 63, m = mb * 16 + (ln & 15), kk0 = ks * 32 + (ln >> 4) * 8;
                unsigned short kv[8];
#pragma unroll
                for (int jj = 0; jj < 8; ++jj) kv[jj] = KL[(kk0 + jj) * 136 + m];
                u32x4 w; w.x = kv[0] | ((unsigned)kv[1] << 16); w.y = kv[2] | ((unsigned)kv[3] << 16); w.z = kv[4] | ((unsigned)kv[5] << 16); w.w = kv[6] | ((unsigned)kv[7] << 16);
                *(u32x4*)(pu + PO_KT + e * 16) = w; }
            for (int e = t6; e < 2048; e += 384) { const int nt = e >> 8, rb = (e >> 6) & 3, ln = e & 63, col = nt * 16 + (ln & 15), row0 = rb * 16 + 4 * (ln >> 4);
                const unsigned v0 = VL[(row0 + 0) * 136 + col], v1 = VL[(row0 + 1) * 136 + col], v2 = VL[(row0 + 2) * 136 + col], v3 = VL[(row0 + 3) * 136 + col];
                u32x2 w; w.x = v0 | (v1 << 16); w.y = v2 | (v3 << 16);
                *(u32x2*)(pu + PO_V + e * 8) = w; }
        }
        __syncthreads();
#pragma unroll
        for (int rep = 0; rep < 2; ++rep) { const int idx = rep * NTHR + tid, d = idx >> 9, e = idx & 511, rb = e >> 7, ks = (e >> 6) & 1, ln = e & 63, i = rb * 16 + (ln & 15), j0 = ks * 32 + (ln >> 4) * 8;
            float tv[8];
#pragma unroll
            for (int jj = 0; jj < 8; ++jj) tv[jj] = d == 0 ? XM[i * 65 + j0 + jj] : XM[4160 + (63 - i) * 65 + (63 - (j0 + jj))];
            u32x4 w; w.x = pk2(tv[0], tv[1]); w.y = pk2(tv[2], tv[3]); w.z = pk2(tv[4], tv[5]); w.w = pk2(tv[6], tv[7]);
            *(u32x4*)(pu + PO_T + d * 8192 + e * 16) = w;
        }
        __syncthreads();
    }
}

constexpr int SNT = 8;
constexpr size_t WS_SLOC = WS_R1 + 212 * MiB, WS_PMAT = WS_SLOC + 16 * MiB, WS_SST = WS_PMAT + 16 * MiB;
__device__ __forceinline__ int sb_lo(int j) { return j < 4 ? 17 * j : 68 + 16 * (j - 4); }
struct ScanRegs { bf16x8 kqA[4], kqB[4]; bf16x8 kt[2], ta[2]; f32x4 eg; float gl; u32x2 vv[SNT]; f32x4 be, kd; };
struct ScanAddr { const unsigned char* pu; const float* vd; };
__device__ __forceinline__ ScanAddr scan_addr(const unsigned char* ws, int d, int b, int h, int s) {
    const int cn = d == 0 ? s : (s < 4 ? 3 - s : 263 - s);
    const int u = (b * NCH + cn) * NH + h;
    ScanAddr a; a.pu = ws + WS_PREP + (size_t)u * PREP_UNIT; a.vd = (const float*)(ws + WS_VEC) + (size_t)u * 512 + d * 256; return a;
}
template <bool OUT> __device__ __forceinline__ void ld_kq(bf16x8 (&kq)[4], const ScanAddr& a, int w, int lane) {
    const int rb = OUT ? w : (w & 3);
#pragma unroll
    for (int ks = 0; ks < 4; ++ks) kq[ks] = *(const bf16x8*)(a.pu + PO_KQ + ((rb * 4 + ks) * 64 + lane) * 16);
}
template <bool HASV, bool OUT> __device__ __forceinline__ void ld_p1(ScanRegs& R, const ScanAddr& a, int w, int lane) {
    const int r0 = 16 * (w & 3) + 4 * (lane >> 4);
    R.eg = *(const f32x4*)(a.vd + r0); R.be = *(const f32x4*)(a.vd + 64 + r0);
    if (HASV) { const int nt0 = OUT ? 0 : 4 * (w >> 2);
#pragma unroll
        for (int i = 0; i < (OUT ? SNT : SNT / 2); ++i) R.vv[i] = *(const u32x2*)(a.pu + PO_V + (((nt0 + i) * 4 + (w & 3)) * 64 + lane) * 8); }
}
template <bool OUT> __device__ __forceinline__ void ld_ta(ScanRegs& R, const ScanAddr& a, int d, int w, int lane) {
    const int tao = ((OUT && w >= 4) ? PO_A : PO_T) + d * 8192;
#pragma unroll
    for (int ks = 0; ks < 2; ++ks) R.ta[ks] = *(const bf16x8*)(a.pu + tao + (((w & 3) * 2 + ks) * 64 + lane) * 16);
}
__device__ __forceinline__ void ld_p3(ScanRegs& R, const ScanAddr& a, int w, int lane) {
#pragma unroll
    for (int ks = 0; ks < 2; ++ks) R.kt[ks] = *(const bf16x8*)(a.pu + PO_KT + ((w * 2 + ks) * 64 + lane) * 16);
    R.gl = a.vd[192];
}
template <bool HASV, bool OUT, int PAR>
__device__ __forceinline__ void scan_step(ScanRegs& R, f32x4 (&S)[SNT], LAS bf16* ST, LAS bf16* TT, LAS bf16* VN, LAS bf16* VS, bf16* Od, int col0,
                                          const unsigned char* ws, int d, int b, int h, int s, int s1, int w, int lane) {
    constexpr int NTW = OUT ? SNT : SNT / 2;
    const int l16 = lane & 15, q4 = lane >> 4, rowo = 16 * (w & 3) + 4 * q4, nt0 = OUT ? 0 : 4 * (w >> 2);
    const bool kwave = !OUT || w < 4;
    const int sn1 = s + 1 < s1 ? s + 1 : s1 - 1, sn2 = s + 2 < s1 ? s + 2 : s1 - 1;
    const ScanAddr a1 = scan_addr(ws, d, b, h, sn1);
    bf16x8 (&kq)[4] = PAR ? R.kqB : R.kqA;
    bf16x8 fb[2][8];
    f32x4 a1v[NTW];
    {
#define RD1(c_) do { _Pragma("unroll") for (int i_ = 0; i_ < 8; ++i_) fb[(c_) & 1][i_] = *(const LAS bf16x8*)(ST + ((nt0 + 2 * (c_) + (i_ >> 2)) * 16 + l16) * 136 + (i_ & 3) * 32 + q4 * 8); } while (0)
        RD1(0);
#pragma unroll
        for (int c = 0; c < NTW / 2; ++c) {
            if (c + 1 < NTW / 2) RD1(c + 1);
            __builtin_amdgcn_sched_barrier(0);
#pragma unroll
            for (int j = 0; j < 2; ++j) { f32x4 acc = (f32x4){0.f, 0.f, 0.f, 0.f};
#pragma unroll
                for (int ks = 0; ks < 4; ++ks) acc = __builtin_amdgcn_mfma_f32_16x16x32_bf16(kq[ks], fb[c & 1][j * 4 + ks], acc, 0, 0, 0);
                a1v[2 * c + j] = acc; }
            __builtin_amdgcn_sched_barrier(0);
        }
#undef RD1
    }
    if (kwave) {
#pragma unroll
        for (int i = 0; i < NTW; ++i) { f32x4 t;
            if (HASV) { const f32x4 v = (f32x4){bflo(R.vv[i].x), bfhi(R.vv[i].x), bflo(R.vv[i].y), bfhi(R.vv[i].y)}; t = R.be * (v - R.eg * a1v[i]); }
            else t = R.be * (R.eg * a1v[i]) * -1.f;
            u32x2 pw; pw.x = pk2(t.x, t.y); pw.y = pk2(t.z, t.w); *(LAS u32x2*)(TT + ((nt0 + i) * 16 + l16) * 72 + rowo) = pw; }
    } else {
#pragma unroll
        for (int i = 0; i < NTW; ++i) a1v[i] = R.eg * a1v[i];
    }
    { const ScanAddr a2 = scan_addr(ws, d, b, h, sn2); ld_kq<OUT>(kq, a2, w, lane); ld_p1<HASV, OUT>(R, a1, w, lane); }
    __syncthreads();
#define RD2(BUF, t0_, c_) do { _Pragma("unroll") for (int i_ = 0; i_ < 8; ++i_) fb[(c_) & 1][i_] = *(const LAS bf16x8*)(BUF + (((t0_) + 4 * (c_) + (i_ >> 1)) * 16 + l16) * 72 + (i_ & 1) * 32 + q4 * 8); } while (0)
    if (kwave) {
        RD2(TT, nt0, 0);
#pragma unroll
        for (int c = 0; c < NTW / 4; ++c) {
            if (c + 1 < NTW / 4) RD2(TT, nt0, c + 1);
            __builtin_amdgcn_sched_barrier(0);
#pragma unroll
            for (int j = 0; j < 4; ++j) { const int nt = nt0 + 4 * c + j; f32x4 vn = (f32x4){0.f, 0.f, 0.f, 0.f};
#pragma unroll
                for (int ks = 0; ks < 2; ++ks) vn = __builtin_amdgcn_mfma_f32_16x16x32_bf16(R.ta[ks], fb[c & 1][j * 2 + ks], vn, 0, 0, 0);
                const f32x4 vs = R.kd * vn;
                u32x2 pw; pw.x = pk2(vn.x, vn.y); pw.y = pk2(vn.z, vn.w); *(LAS u32x2*)(VN + (nt * 16 + l16) * 72 + rowo) = pw;
                u32x2 ps; ps.x = pk2(vs.x, vs.y); ps.y = pk2(vs.z, vs.w); *(LAS u32x2*)(VS + (nt * 16 + l16) * 72 + rowo) = ps; }
            __builtin_amdgcn_sched_barrier(0);
        }
        ld_ta<OUT>(R, a1, d, w, lane); R.kd = *(const f32x4*)(a1.vd + 128 + rowo);
    }
    __syncthreads();
    if (!kwave) {
        RD2(VN, 0, 0);
#pragma unroll
        for (int c = 0; c < 2; ++c) {
            if (c + 1 < 2) RD2(VN, 0, c + 1);
            __builtin_amdgcn_sched_barrier(0);
#pragma unroll
            for (int j = 0; j < 4; ++j) { const int nt = 4 * c + j;
#pragma unroll
                for (int ks = 0; ks < 2; ++ks) a1v[nt < NTW ? nt : 0] = __builtin_amdgcn_mfma_f32_16x16x32_bf16(R.ta[ks], fb[c & 1][j * 2 + ks], a1v[nt < NTW ? nt : 0], 0, 0, 0); }
            __builtin_amdgcn_sched_barrier(0);
        }
        ld_ta<OUT>(R, a1, d, w, lane);
    }
    RD2(VS, 0, 0);
#pragma unroll
    for (int c = 0; c < 2; ++c) {
        if (c + 1 < 2) RD2(VS, 0, c + 1);
        __builtin_amdgcn_sched_barrier(0);
#pragma unroll
        for (int j = 0; j < 4; ++j) { const int nt = 4 * c + j; f32x4 sv = S[nt] * R.gl;
#pragma unroll
            for (int ks = 0; ks < 2; ++ks) sv = __builtin_amdgcn_mfma_f32_16x16x32_bf16(R.kt[ks], fb[c & 1][j * 2 + ks], sv, 0, 0, 0);
            S[nt] = sv;
            u32x2 pw; pw.x = pk2(sv.x, sv.y); pw.y = pk2(sv.z, sv.w); *(LAS u32x2*)(ST + (nt * 16 + l16) * 136 + 16 * w + 4 * q4) = pw; }
        __builtin_amdgcn_sched_barrier(0);
    }
#undef RD2
    ld_p3(R, a1, w, lane);
    if (OUT && w >= 4 && s >= 4) {
        const int n = d == 0 ? s - 4 : 259 - s, trow0 = b * SEQ + n * 64;
#pragma unroll
        for (int nt = 0; nt < NTW; ++nt)
#pragma unroll
            for (int r = 0; r < 4; ++r) Od[(size_t)(trow0 + rowo + r) * 512 + col0 + nt * 16 + l16] = (bf16)(pk2(a1v[nt][r], 0.f) & 0xffffu); }
    __syncthreads();
}
template <int KIND>
__device__ __forceinline__ void scan_run(const Fr& F, int chain, int j) {
    int tid_ = F.tid; asm volatile("" : "+v"(tid_));
    const int d = chain >> 3, b = (chain >> 2) & 1, h = chain & 3, w = __builtin_amdgcn_readfirstlane(tid_ >> 6), lane = tid_ & 63, l16 = lane & 15, q4 = lane >> 4;
    LAS bf16* ST = (LAS bf16*)F.lds; LAS bf16* TT = ST + SNT * 16 * 136; LAS bf16* VN = TT + SNT * 16 * 72; LAS bf16* VS = VN + SNT * 16 * 72;
    f32x4 S[SNT];
    const size_t sidx = ((size_t)chain * 16 + j) * 16384;
#pragma unroll
    for (int nt = 0; nt < SNT; ++nt) {
        if (KIND == 0) S[nt] = (f32x4){0.f, 0.f, 0.f, 0.f};
        else if (KIND == 1) { const int col = nt * 16 + l16;
#pragma unroll
            for (int r = 0; r < 4; ++r) S[nt][r] = (16 * w + 4 * q4 + r == col) ? 1.f : 0.f; }
        else S[nt] = j == 0 ? (f32x4){0.f, 0.f, 0.f, 0.f} : *(const f32x4*)(WSP(float, WS_SST) + sidx + ((nt * 8 + w) * 64 + lane) * 4);
        u32x2 pw; pw.x = pk2(S[nt].x, S[nt].y); pw.y = pk2(S[nt].z, S[nt].w); *(LAS u32x2*)(ST + (nt * 16 + l16) * 136 + 16 * w + 4 * q4) = pw; }
    __syncthreads();
    bf16* Od = WSP(bf16, WS_O) + (size_t)d * T * 512; const int col0 = h * 128;
    const int s0 = sb_lo(j), s1 = sb_lo(j + 1);
    ScanRegs R;
    { const ScanAddr a0 = scan_addr(F.ws, d, b, h, s0), a1 = scan_addr(F.ws, d, b, h, s0 + 1 < s1 ? s0 + 1 : s1 - 1);
        ld_kq<KIND == 2>(R.kqA, a0, w, lane); ld_p1<KIND != 1, KIND == 2>(R, a0, w, lane); ld_ta<KIND == 2>(R, a0, d, w, lane); R.kd = *(const f32x4*)(a0.vd + 128 + 16 * (w & 3) + 4 * q4); ld_p3(R, a0, w, lane);
        ld_kq<KIND == 2>(R.kqB, a1, w, lane); }
    for (int s = s0; s < s1; s += 2) {
        scan_step<KIND != 1, KIND == 2, 0>(R, S, ST, TT, VN, VS, Od, col0, F.ws, d, b, h, s, s1, w, lane);
        if (s + 1 < s1) scan_step<KIND != 1, KIND == 2, 1>(R, S, ST, TT, VN, VS, Od, col0, F.ws, d, b, h, s + 1, s1, w, lane);
    }
    if (KIND == 0) {
#pragma unroll
        for (int nt = 0; nt < SNT; ++nt) *(f32x4*)(WSP(float, WS_SLOC) + sidx + ((nt * 8 + w) * 64 + lane) * 4) = S[nt];
    } else if (KIND == 1) { bf16* Pm = WSP(bf16, WS_PMAT) + sidx;
#pragma unroll
        for (int nt = 0; nt < SNT; ++nt)
#pragma unroll
            for (int r = 0; r < 4; ++r) Pm[(16 * w + 4 * q4 + r) * 128 + nt * 16 + l16] = (bf16)(pk2(S[nt][r], 0.f) & 0xffffu);
    }
    __syncthreads();
}
__device__ __forceinline__ void scan_combine(const Fr& F, int cu) {
    const int chain = cu >> 3, nt = cu & 7, w = F.wave, lane = F.lane, l16 = lane & 15, q4 = lane >> 4;
    LAS bf16* ST = (LAS bf16*)F.lds;
    f32x4 S = (f32x4){0.f, 0.f, 0.f, 0.f};
    { u32x2 z; z.x = 0u; z.y = 0u; *(LAS u32x2*)(ST + l16 * 136 + 16 * w + 4 * q4) = z; }
    __syncthreads();
    bf16x8 pa[4]; f32x4 sl;
#define SC2_LOAD(j_) do { const size_t si_ = ((size_t)chain * 16 + (j_)) * 16384; const bf16* Pm_ = WSP(bf16, WS_PMAT) + si_; \
        _Pragma("unroll") for (int ks = 0; ks < 4; ++ks) pa[ks] = *(const bf16x8*)(Pm_ + (16 * w + l16) * 128 + ks * 32 + q4 * 8); \
        sl = *(const f32x4*)(WSP(float, WS_SLOC) + si_ + ((nt * 8 + w) * 64 + lane) * 4); } while (0)
    SC2_LOAD(0);
    for (int j = 0; j < 15; ++j) {
        f32x4 acc = sl;
#pragma unroll
        for (int ks = 0; ks < 4; ++ks) acc = __builtin_amdgcn_mfma_f32_16x16x32_bf16(pa[ks], *(const LAS bf16x8*)(ST + l16 * 136 + ks * 32 + q4 * 8), acc, 0, 0, 0);
        S = acc;
        if (j + 1 < 15) SC2_LOAD(j + 1);
        *(f32x4*)(WSP(float, WS_SST) + ((size_t)chain * 16 + j + 1) * 16384 + ((nt * 8 + w) * 64 + lane) * 4) = S;
        __syncthreads();
        { u32x2 pw; pw.x = pk2(S.x, S.y); pw.y = pk2(S.z, S.w); *(LAS u32x2*)(ST + l16 * 136 + 16 * w + 4 * q4) = pw; }
        __syncthreads();
    }
#undef SC2_LOAD
}
__device__ __forceinline__ void p4_sgu(const Fr& F, int worker, int nworkers, int u_lo, int u_hi) {
    const bf16* P = WSP(bf16, WS_P); bf16* MIX = WSP(bf16, WS_MIX);
    const float* lng = F.in[12]; const float* lnb = F.in[13]; const float* sw = F.in[14]; const float* sb = F.in[15];
    LAS bf16* VT = (LAS bf16*)F.lds;
    for (int u = u_lo + worker; u < u_hi; u += nworkers) {
        int tid = F.tid; asm volatile("" : "+v"(tid));
        const int lane = tid & 63, wave = __builtin_amdgcn_readfirstlane(tid >> 6), l16 = lane & 15, q4 = lane >> 4;
        const int g = u & 3, ch = u >> 2, row00 = ch * 128;
#pragma unroll
        for (int it = 0; it < 4; ++it) { const int item = it * NTHR + tid, cg = item & 15, row = item >> 4;
            const u32x4 xv = *(const u32x4*)(P + (size_t)(row00 + row) * NPROJ + PC_V + g * 128 + cg * 8);
            float v[8]; v[0] = bflo(xv.x); v[1] = bfhi(xv.x); v[2] = bflo(xv.y); v[3] = bfhi(xv.y); v[4] = bflo(xv.z); v[5] = bfhi(xv.z); v[6] = bflo(xv.w); v[7] = bfhi(xv.w);
            float s = 0.f;
#pragma unroll
            for (int e = 0; e < 8; ++e) { v[e] = gelu_t(v[e]); s += v[e]; }
            const float mean = sum16(s) * (1.f / 128.f); float q = 0.f;
#pragma unroll
            for (int e = 0; e < 8; ++e) { v[e] -= mean; q += v[e] * v[e]; }
            const float rstd = rsqrtf(sum16(q) * (1.f / 128.f) + EPS);
#pragma unroll
            for (int e = 0; e < 8; ++e) { const int c = cg * 8 + e; const float y = v[e] * rstd * lng[g * 128 + c] + lnb[g * 128 + c]; VT[c * 136 + ((((row >> 3) ^ cg) << 3) | (row & 7))] = (bf16)(pk2(y, 0.f) & 0xffffu); }
        }
        __syncthreads();
        bf16x8 wf[4];
#pragma unroll
        for (int ks = 0; ks < 4; ++ks) { const float* wp = sw + (size_t)g * 16384 + (wave * 16 + l16) * 128 + ks * 32 + q4 * 8; const f32x4 a = *(const f32x4*)wp, bq = *(const f32x4*)(wp + 4);
            u32x4 t; t.x = pk2(a.x, a.y); t.y = pk2(a.z, a.w); t.z = pk2(bq.x, bq.y); t.w = pk2(bq.z, bq.w); wf[ks] = __builtin_bit_cast(bf16x8, t); }
        const int prow = wave * 16 + l16; const float bs = sb[g * 128 + prow];
        u32x2 uq[8];
#pragma unroll
        for (int ct = 0; ct < 8; ++ct) uq[ct] = *(const u32x2*)(P + (size_t)(row00 + prow) * NPROJ + PC_U + g * 128 + ct * 16 + 4 * q4);
#pragma unroll
        for (int ct = 0; ct < 8; ++ct) { f32x4 acc = (f32x4){0.f, 0.f, 0.f, 0.f};
#pragma unroll
            for (int ks = 0; ks < 4; ++ks) acc = __builtin_amdgcn_mfma_f32_16x16x32_bf16(*(const LAS bf16x8*)(VT + (ct * 16 + l16) * 136 + (((ks * 4 + q4) ^ (ct * 2 + (l16 >> 3))) << 3)), wf[ks], acc, 0, 0, 0);
            const int c0 = ct * 16 + 4 * q4;
            const u32x2 uv = uq[ct];
            const float o0 = gelu_t(bflo(uv.x)) * (acc[0] + bs), o1 = gelu_t(bfhi(uv.x)) * (acc[1] + bs), o2 = gelu_t(bflo(uv.y)) * (acc[2] + bs), o3 = gelu_t(bfhi(uv.y)) * (acc[3] + bs);
            u32x2 w; w.x = pk2(o0, o1); w.y = pk2(o2, o3); if (DBG_MODE == 3) w = (u32x2){0u, 0u}; *(u32x2*)(MIX + (size_t)(row00 + prow) * D + 512 + g * 128 + c0) = w; }
        __syncthreads();
    }
}

__device__ __forceinline__ void p5_gdn_out(const Fr& F) {
    const bf16* P = WSP(bf16, WS_P); const bf16* O = WSP(bf16, WS_O); bf16* MIX = WSP(bf16, WS_MIX); const float* gng = F.in[11];
    const int gw = F.wg * NWAVES + F.wave, NGW = F.G * NWAVES, lane = F.lane;
    const f32x4 g0 = *(const f32x4*)(gng + (lane & 15) * 8), g1 = *(const f32x4*)(gng + (lane & 15) * 8 + 4);
    const float gg[8] = {g0.x, g0.y, g0.z, g0.w, g1.x, g1.y, g1.z, g1.w};
    for (int blk = gw; blk < T / 16; blk += NGW) {
        const int t0 = blk * 16;
        u32x4 a = *(const u32x4*)(O + (size_t)t0 * 512 + lane * 8), bq = *(const u32x4*)(O + (size_t)(T + t0) * 512 + lane * 8), z = *(const u32x4*)(P + (size_t)t0 * NPROJ + PC_Z + lane * 8);
#pragma clang loop unroll(disable)
        for (int i = 0; i < 16; ++i) {
            const int t = t0 + i, tn = t0 + (i + 1 < 16 ? i + 1 : i);
            const u32x4 an = *(const u32x4*)(O + (size_t)tn * 512 + lane * 8), bn = *(const u32x4*)(O + (size_t)(T + tn) * 512 + lane * 8), zn = *(const u32x4*)(P + (size_t)tn * NPROJ + PC_Z + lane * 8);
            float o[8]; o[0] = bflo(a.x) + bflo(bq.x); o[1] = bfhi(a.x) + bfhi(bq.x); o[2] = bflo(a.y) + bflo(bq.y); o[3] = bfhi(a.y) + bfhi(bq.y);
            o[4] = bflo(a.z) + bflo(bq.z); o[5] = bfhi(a.z) + bfhi(bq.z); o[6] = bflo(a.w) + bflo(bq.w); o[7] = bfhi(a.w) + bfhi(bq.w);
            float ss = 0.f;
#pragma unroll
            for (int e = 0; e < 8; ++e) ss += o[e] * o[e];
            const float rstd = rsqrtf(sum16(ss) * (1.f / 128.f) + EPS);
            const float zz[8] = {bflo(z.x), bfhi(z.x), bflo(z.y), bfhi(z.y), bflo(z.z), bfhi(z.z), bflo(z.w), bfhi(z.w)};
            float r[8];
#pragma unroll
            for (int e = 0; e < 8; ++e) r[e] = o[e] * rstd * gg[e] * silu_(zz[e]);
            u32x4 w; w.x = pk2(r[0], r[1]); w.y = pk2(r[2], r[3]); w.z = pk2(r[4], r[5]); w.w = pk2(r[6], r[7]);
            if (DBG_MODE == 2) w = (u32x4){0u, 0u, 0u, 0u};
            *(u32x4*)(MIX + (size_t)t * D + lane * 8) = w;
            a = an; bq = bn; z = zn;
        }
    }
}

__device__ __forceinline__ void p7_mid(const Fr& F) {
    const float* x = F.in[0]; const float* ng = F.in[6]; const float* MOD = WSP(float, WS_MOD); const bf16* R = WSP(bf16, WS_R); const float* rbias = F.in[18];
    bf16* X1 = WSP(bf16, WS_X1); unsigned char* H2 = WSP(unsigned char, WS_H2);
    LAS bf16* HI = (LAS bf16*)F.lds; LAS bf16* LO = HI + 16 * 1032; LAS float* PART = (LAS float*)(F.lds + 66048);
    LAS int* ENT_E = (LAS int*)(F.lds + 83968); LAS int* ENT_R = ENT_E + 1024; LAS int* CNT = ENT_R + 1024; LAS int* BASE = CNT + 32;
    const int tid = F.tid, lane = F.lane, wave = F.wave, l16 = lane & 15, q4 = lane >> 4;
    if (tid < 32) CNT[tid] = 0;
    { int* RT = WSP(int, WS_ROWTOK); const int per = (MAXROWS + F.G - 1) / F.G; for (int i = tid; i < per; i += NTHR) { const int r = F.wg * per + i; if (r < MAXROWS) RT[r] = 0; } }
    const int TPW = T / F.G, t0 = F.wg * TPW;
    LAS float* AV = (LAS float*)(F.lds + 92672); LAS float* BV = AV + 1024; LAS float* CV = BV + 1024;
    { const float* mb = MOD + (t0 >> 14) * 6144;
        for (int k = tid; k < 1024; k += NTHR) { AV[k] = mb[2048 + k] * ng[1024 + k]; BV[k] = ng[2048 + k] * (mb[4096 + k] + 1.f); CV[k] = mb[3072 + k]; } }
    const float my_rbias = rbias[tid & 31];
    bf16x8 wh[4][2], wl[4][2];
    { const float* WRT = WSP(float, WS_WRT);
#pragma unroll
        for (int ks = 0; ks < 4; ++ks)
#pragma unroll
            for (int nt = 0; nt < 2; ++nt) { const float* wp = WRT + (size_t)(nt * 16 + l16) * 1024 + wave * 128 + ks * 32 + q4 * 8; const f32x4 a = *(const f32x4*)wp, b = *(const f32x4*)(wp + 4);
                u32x4 h; h.x = pk2(a.x, a.y); h.y = pk2(a.z, a.w); h.z = pk2(b.x, b.y); h.w = pk2(b.z, b.w);
                u32x4 l; l.x = pk2(a.x - bflo(h.x), a.y - bfhi(h.x)); l.y = pk2(a.z - bflo(h.y), a.w - bfhi(h.y)); l.z = pk2(b.x - bflo(h.z), b.y - bfhi(h.z)); l.w = pk2(b.z - bflo(h.w), b.w - bfhi(h.w));
                wh[ks][nt] = __builtin_bit_cast(bf16x8, h); wl[ks][nt] = __builtin_bit_cast(bf16x8, l); } }
    __syncthreads();
    u32x2 rq[2][4]; f32x4 xq[2][4];
#define P7_LOAD(tile_) do { _Pragma("unroll") for (int sub_ = 0; sub_ < 2; ++sub_) { const int t_ = t0 + (tile_) * 16 + 2 * wave + sub_; \
        _Pragma("unroll") for (int j_ = 0; j_ < 4; ++j_) { rq[sub_][j_] = *(const u32x2*)(R + (size_t)t_ * D + 256 * j_ + 4 * lane); xq[sub_][j_] = *(const f32x4*)(x + (size_t)t_ * D + 256 * j_ + 4 * lane); } } } while (0)
    P7_LOAD(0);
    for (int tile = 0; tile < TPW / 16; ++tile) {
        f32x4 hq[2][4];
#pragma unroll
        for (int sub = 0; sub < 2; ++sub) {
            f32x4 rv[4]; float ss = 0.f;
#pragma unroll
            for (int j = 0; j < 4; ++j) { const u32x2 rw = rq[sub][j]; rv[j] = (f32x4){bflo(rw.x), bfhi(rw.x), bflo(rw.y), bfhi(rw.y)};
                ss += (rv[j].x * rv[j].x + rv[j].y * rv[j].y) + (rv[j].z * rv[j].z + rv[j].w * rv[j].w); }
            const float rstd1 = rsqrtf(wave_sum(ss) * (1.f / D) + EPS);
            f32x4 xv[4]; float s2 = 0.f;
#pragma unroll
            for (int j = 0; j < 4; ++j) { const int k = 256 * j + 4 * lane; const f32x4 av = *(const LAS f32x4*)(AV + k);
                xv[j] = xq[sub][j] + av * (rv[j] * rstd1);
                s2 += (xv[j].x * xv[j].x + xv[j].y * xv[j].y) + (xv[j].z * xv[j].z + xv[j].w * xv[j].w); }
            const float rstd2 = rsqrtf(wave_sum(s2) * (1.f / D) + EPS);
#pragma unroll
            for (int j = 0; j < 4; ++j) { const int k = 256 * j + 4 * lane; const f32x4 bv = *(const LAS f32x4*)(BV + k), cv = *(const LAS f32x4*)(CV + k);
                hq[sub][j] = xv[j] * rstd2 * bv + cv; xq[sub][j] = xv[j]; }
        }
#pragma unroll
        for (int sub = 0; sub < 2; ++sub) { const int tr = 2 * wave + sub, t = t0 + tile * 16 + tr;
#pragma unroll
            for (int j = 0; j < 4; ++j) { const int k = 256 * j + 4 * lane; const f32x4 hv = hq[sub][j];
                { u32x2 x1w; x1w.x = pk2(xq[sub][j].x, xq[sub][j].y); x1w.y = pk2(xq[sub][j].z, xq[sub][j].w); *(u32x2*)(X1 + (size_t)t * D + k) = x1w; }
                u32x2 o; o.x = pk2(hv.x, hv.y); o.y = pk2(hv.z, hv.w); *(unsigned*)(H2 + (size_t)t * D + k) = pk_fp8x4(hv.x, hv.y, hv.z, hv.w);
                u32x2 lo; lo.x = pk2(hv.x - bflo(o.x), hv.y - bfhi(o.x)); lo.y = pk2(hv.z - bflo(o.y), hv.w - bfhi(o.y));
                *(LAS u32x2*)(HI + tr * 1032 + k) = o; *(LAS u32x2*)(LO + tr * 1032 + k) = lo; } }
        if (tile + 1 < TPW / 16) P7_LOAD(tile + 1);
        __syncthreads();
        { f32x4 acc[2]; acc[0] = (f32x4){0.f, 0.f, 0.f, 0.f}; acc[1] = acc[0];
#pragma unroll
            for (int ks = 0; ks < 4; ++ks) { const int ko = l16 * 1032 + wave * 128 + ks * 32 + q4 * 8;
                const bf16x8 ah = *(const LAS bf16x8*)(HI + ko), al = *(const LAS bf16x8*)(LO + ko);
#pragma unroll
                for (int nt = 0; nt < 2; ++nt) { acc[nt] = __builtin_amdgcn_mfma_f32_16x16x32_bf16(ah, wh[ks][nt], acc[nt], 0, 0, 0);
                    acc[nt] = __builtin_amdgcn_mfma_f32_16x16x32_bf16(al, wh[ks][nt], acc[nt], 0, 0, 0);
                    acc[nt] = __builtin_amdgcn_mfma_f32_16x16x32_bf16(ah, wl[ks][nt], acc[nt], 0, 0, 0); } }
#pragma unroll
            for (int nt = 0; nt < 2; ++nt)
#pragma unroll
                for (int r = 0; r < 4; ++r) PART[(wave * 16 + 4 * q4 + r) * 33 + nt * 16 + l16] = acc[nt][r]; }
        __syncthreads();
        { const int tok = tid >> 5, me = tid & 31, t = t0 + tile * 16 + tok;
            float logit = my_rbias;
#pragma unroll
            for (int w = 0; w < 8; ++w) logit += PART[(w * 16 + tok) * 33 + me];
            float tv[4]; int ti[4];
#pragma unroll
            for (int k = 0; k < 4; ++k) { float bv = logit; int bi = me;
#define P7_AMAX(OV, OI) do { const float ov_ = (OV); const int oi_ = (OI); const bool tk_ = (ov_ > bv) | ((ov_ == bv) & (oi_ < bi)); bv = tk_ ? ov_ : bv; bi = tk_ ? oi_ : bi; } while (0)
                P7_AMAX(DPP_MOV(bv, 0xB1), __builtin_amdgcn_update_dpp(0, bi, 0xB1, 0xf, 0xf, true));
                P7_AMAX(DPP_MOV(bv, 0x4E), __builtin_amdgcn_update_dpp(0, bi, 0x4E, 0xf, 0xf, true));
                P7_AMAX(DPP_MOV(bv, 0x124), __builtin_amdgcn_update_dpp(0, bi, 0x124, 0xf, 0xf, true));
                P7_AMAX(DPP_MOV(bv, 0x128), __builtin_amdgcn_update_dpp(0, bi, 0x128, 0xf, 0xf, true));
                P7_AMAX(__shfl_xor(bv, 16), __shfl_xor(bi, 16));
#undef P7_AMAX
                tv[k] = bv; ti[k] = bi; if (me == bi) logit = -3.0e38f; }
            const float e1 = __expf(tv[1] - tv[0]), e2 = __expf(tv[2] - tv[0]), e3 = __expf(tv[3] - tv[0]), inv = 1.f / (1.f + e1 + e2 + e3);
            if (me == 0) { const float gt[4] = {inv, e1 * inv, e2 * inv, e3 * inv}; float* TG = WSP(float, WS_TKGATE); const int tl = tile * 16 + tok;
#pragma unroll
                for (int k = 0; k < 4; ++k) { const int rk = atomicAdd((int*)&CNT[ti[k]], 1); ENT_E[tl * 4 + k] = ti[k]; ENT_R[tl * 4 + k] = rk; TG[(size_t)t * 4 + k] = gt[k]; } }
        }
    }
#undef P7_LOAD
    __syncthreads();
    if (tid < 32) BASE[tid] = (int)__hip_atomic_fetch_add(WSP(unsigned, WS_CTL) + CW_GCNT + 64 * tid, (unsigned)CNT[tid], __ATOMIC_RELAXED, __HIP_MEMORY_SCOPE_AGENT);
    __syncthreads();
    int* TE = WSP(int, WS_TKE); int* TR = WSP(int, WS_TKRANK);
    for (int i = tid; i < TPW * 4; i += NTHR) { const int e = ENT_E[i]; TE[(size_t)t0 * 4 + i] = e; TR[(size_t)t0 * 4 + i] = BASE[e] + ENT_R[i]; }
}

__device__ __forceinline__ void moe_tables(const Fr& F) {
    LAS int* NPL = (LAS int*)(F.lds + LDS_TAB); LAS int* RB = NPL + 32; LAS int* NPAN = NPL + 64; LAS int* PEXP = NPL + 128;
    if (F.tid < 32) NPL[F.tid] = ((int)__hip_atomic_load(WSP(unsigned, WS_CTL) + CW_GCNT + 64 * F.tid, __ATOMIC_RELAXED, __HIP_MEMORY_SCOPE_AGENT) + 255) >> 8;
    __syncthreads();
    if (F.tid < 32) { int s = 0; for (int e = 0; e < F.tid; ++e) s += NPL[e]; RB[F.tid] = s * 256; if (F.tid == 31) NPAN[0] = s + NPL[31];
        const int np = NPL[F.tid]; for (int p = 0; p < np; ++p) if (s + p < MAXPAN) PEXP[s + p] = F.tid; }
    __syncthreads();
}
__device__ __forceinline__ void p8_permute(const Fr& F) {
    moe_tables(F);
    const LAS int* RB = (const LAS int*)(F.lds + LDS_TAB) + 32;
    const int* TE = WSP(int, WS_TKE); const int* TR = WSP(int, WS_TKRANK); const float* TG = WSP(float, WS_TKGATE); int* TROW = WSP(int, WS_TKROW); float* RG = WSP(float, WS_ROWGATE);
    int* RT = WSP(int, WS_ROWTOK);
    const int gw = F.wg * NWAVES + F.wave, NGW = F.G * NWAVES, lane = F.lane;
    for (int blk = gw; blk < T / 16; blk += NGW) {
        const size_t a0 = (size_t)blk * 64;
        const int e = TE[a0 + lane]; int row = RB[e] + TR[a0 + lane]; row = row < MAXROWS ? row : MAXROWS - 1;
        TROW[a0 + lane] = row; RG[row] = TG[a0 + lane]; RT[row] = blk * 16 + (lane >> 2);
    }
}
struct MoeOrder {
    int nM, nN, nwg, G, c; const LAS int* pexp;
    __device__ __forceinline__ void init(int nM_, int nN_, int G_, int c_, const LAS int* pexp_) { nM = nM_; nN = nN_; nwg = nM * nN; G = G_; c = c_; pexp = pexp_; }
    __device__ __forceinline__ bool next(int i, pg8::Unit& u) const {
        const long L = (long)i * G + c; if (L >= nwg) return false;
        int wgid = (int)L; { const int q = nwg / pg8::NXCD, r = nwg % pg8::NXCD, xcd = wgid % pg8::NXCD, off = wgid / pg8::NXCD; wgid = (xcd < r ? xcd * (q + 1) : r * (q + 1) + (xcd - r) * q) + off; }
        const int nig = pg8::WGM * nN, gid = wgid / nig, fm = gid * pg8::WGM, gsz = (nM - fm) < pg8::WGM ? (nM - fm) : pg8::WGM;
        u.pm = fm + ((wgid % nig) % gsz); u.pn = pexp[u.pm] * nN + (wgid % nig) / gsz; return true;
    }
    __device__ __forceinline__ void a_ready(const pg8::Unit&) const {}
    __device__ __forceinline__ void done(const pg8::Unit&) const {}
};
struct EpiStore {
    static constexpr bool PERM = true, AFTER_DRAIN = false;
    bf16* O; int ldc;
    __device__ __forceinline__ void pre(const pg8::Unit&, int, int, int) const {}
    __device__ __forceinline__ void operator()(const pg8::f32x4 (&acc)[2][2][4][2], const pg8::Unit& u, int wr, int wc, int fr, int fq, int par) const {
        const int row0 = u.pm * 256 + wr * 64 + fr, col0 = u.pn * 256 + wc * 32 + 8 * fq;
#pragma unroll
        for (int ai = 0; ai < 2; ++ai)
#pragma unroll
            for (int m = 0; m < 4; ++m) { bf16* rowp = O + (size_t)(row0 + ai * 128 + m * 16) * ldc + col0;
#pragma unroll
                for (int bj = 0; bj < 2; ++bj) { const pg8::f32x4 v0 = acc[ai][bj][m][0], v1 = acc[ai][bj][m][1];
                    u32x4 w; w.x = pk2(v0[0], v0[1]); w.y = pk2(v0[2], v0[3]); w.z = pk2(v1[0], v1[1]); w.w = pk2(v1[2], v1[3]);
                    *(u32x4*)(rowp + bj * 128) = w; } }
    }
};
template <int EMODE = 0>
struct EpiSwiGLUT {
    static constexpr bool PERM = false, AFTER_DRAIN = false;
    unsigned char* ACT; const float* bias; LAS float* le;
    __device__ __forceinline__ void pre(const pg8::Unit& u, int wid, int lane, int par) const { if (EMODE == 3) return;
        if (wid < 4) __builtin_amdgcn_global_load_lds((const unsigned*)(bias + (u.pn >> 3) * 2048 + (u.pn & 7) * 256 + wid * 64 + lane), (LAS unsigned*)(le + par * 512 + wid * 64), 4, 0, 0); }
    __device__ __forceinline__ void operator()(const pg8::f32x4 (&acc)[2][2][4][2], const pg8::Unit& u, int wr, int wc, int fr, int fq, int par) const {
        if (EMODE == 3) return;
        const int e = u.pn >> 3, pnl = u.pn & 7, row0 = u.pm * 256 + wr * 64 + fr;
        const LAS float* bb = le + par * 512 + wc * 32 + 4 * fq; (void)e;
        pg8::f32x4 bg[2], bu[2];
#pragma unroll
        for (int bj = 0; bj < 2; ++bj) { bg[bj] = *(const LAS pg8::f32x4*)(bb + bj * 128); bu[bj] = *(const LAS pg8::f32x4*)(bb + bj * 128 + 16); }
#pragma unroll
        for (int ai = 0; ai < 2; ++ai)
#pragma unroll
            for (int m = 0; m < 4; ++m) { float a[8];
#pragma unroll
                for (int bj = 0; bj < 2; ++bj) { const pg8::f32x4 gv = acc[ai][bj][m][0] * W8_INV + bg[bj], uv = acc[ai][bj][m][1] * W8_INV + bu[bj];
#pragma unroll
                    for (int j = 0; j < 4; ++j) { const float gt = fminf(gv[j], 7.f), up1 = __builtin_amdgcn_fmed3f(uv[j], -6.f, 8.f);
                        a[4 * bj + j] = up1 * gt * frcp(1.f + __builtin_amdgcn_exp2f(gt * (-1.702f * 1.4426950408889634f))); } }
                u32x2 w; w.x = pk_fp8x4_ns(a[0], a[1], a[2], a[3]); w.y = pk_fp8x4_ns(a[4], a[5], a[6], a[7]);
                *(u32x2*)(ACT + (size_t)(row0 + ai * 128 + m * 16) * D + pnl * 128 + wc * 32 + 8 * fq) = w; }
    }
};
typedef EpiSwiGLUT<0> EpiSwiGLU;
constexpr float Y8_SCALE = 16.f, Y8_INV = 1.f / 16.f;
template <int EMODE = 0>
struct EpiDownT {
    static constexpr bool PERM = true, AFTER_DRAIN = false;
    unsigned char* Y; const float* bias; const float* rowgate; LAS float* le;
    __device__ __forceinline__ void pre(const pg8::Unit& u, int wid, int lane, int par) const { if (EMODE == 3) return;
        const float* src = wid < 4 ? rowgate + u.pm * 256 + wid * 64 + lane : bias + (u.pn >> 2) * 1024 + (u.pn & 3) * 256 + (wid - 4) * 64 + lane;
        __builtin_amdgcn_global_load_lds((const unsigned*)src, (LAS unsigned*)(le + par * 512 + wid * 64), 4, 0, 0); }
    __device__ __forceinline__ void operator()(const pg8::f32x4 (&acc)[2][2][4][2], const pg8::Unit& u, int wr, int wc, int fr, int fq, int par) const {
        if (EMODE == 3) return;
        const int e = u.pn >> 2, pnl = u.pn & 3, row0 = u.pm * 256 + wr * 64 + fr, col0 = pnl * 256 + wc * 64 + 16 * fq;
        pg8::f32x4 bv[2][2];
#pragma unroll
        for (int bj = 0; bj < 2; ++bj)
#pragma unroll
            for (int n = 0; n < 2; ++n) bv[bj][n] = *(const LAS pg8::f32x4*)(le + par * 512 + 256 + wc * 64 + 16 * fq + 8 * bj + 4 * n);
        (void)e;
        float gt[2][4];
#pragma unroll
        for (int ai = 0; ai < 2; ++ai)
#pragma unroll
            for (int m = 0; m < 4; ++m) gt[ai][m] = (EMODE == 1 ? 0.37f : le[par * 512 + ai * 128 + wr * 64 + m * 16 + fr]);
#pragma unroll
        for (int ai = 0; ai < 2; ++ai)
#pragma unroll
            for (int m = 0; m < 4; ++m) { const int row = row0 + ai * 128 + m * 16; const float g = gt[ai][m] * Y8_SCALE; unsigned char* rowp = Y + (size_t)row * D + col0;
                u32x4 w;
                { const pg8::f32x4 v0 = (acc[ai][0][m][0] * W8_INV + bv[0][0]) * g, v1 = (acc[ai][0][m][1] * W8_INV + bv[0][1]) * g; w.x = pk_fp8x4(v0[0], v0[1], v0[2], v0[3]); w.y = pk_fp8x4(v1[0], v1[1], v1[2], v1[3]); }
                { const pg8::f32x4 v0 = (acc[ai][1][m][0] * W8_INV + bv[1][0]) * g, v1 = (acc[ai][1][m][1] * W8_INV + bv[1][1]) * g; w.z = pk_fp8x4(v0[0], v0[1], v0[2], v0[3]); w.w = pk_fp8x4(v1[0], v1[1], v1[2], v1[3]); }
                *(u32x4*)rowp = w; }
    }
};
typedef EpiDownT<0> EpiDown;
__device__ __forceinline__ void p11_final(const Fr& F) {
    const float* ng = F.in[6]; const float* MOD = WSP(float, WS_MOD); const bf16* X1 = WSP(bf16, WS_X1); const unsigned char* Y = WSP(unsigned char, WS_Y); const int* TROW = WSP(int, WS_TKROW);
    const int gw = F.wg * NWAVES + F.wave, NGW = F.G * NWAVES, lane = F.lane;
    typedef float f32x2_ __attribute__((ext_vector_type(2)));
    for (int blk = gw; blk < T / 16; blk += NGW) {
        const int t0 = blk * 16, b = t0 >> 14; const float* mb = MOD + b * 6144 + 5120;
        const int myrow = TROW[(size_t)t0 * 4 + lane];
        f32x4 gm[4];
#pragma unroll
        for (int j = 0; j < 4; ++j) { const int k = 256 * j + 4 * lane; gm[j] = *(const f32x4*)(ng + 3072 + k) * *(const f32x4*)(mb + k); }
        int yq0[4][4], yq1[4][4]; u32x2 xq0[4], xq1[4];
#define P11_LOAD(YQ, XQ, tk_) do { _Pragma("unroll") for (int k_ = 0; k_ < 4; ++k_) { const int row_ = __builtin_amdgcn_readlane(myrow, 4 * (tk_) + k_); \
            _Pragma("unroll") for (int j_ = 0; j_ < 4; ++j_) YQ[k_][j_] = *(const int*)(Y + (size_t)row_ * D + 256 * j_ + 4 * lane); } \
            _Pragma("unroll") for (int j_ = 0; j_ < 4; ++j_) XQ[j_] = *(const u32x2*)(X1 + (size_t)(t0 + (tk_)) * D + 256 * j_ + 4 * lane); } while (0)
#define P11_DO(YQ, XQ, tk_) do { f32x4 y[4]; \
            _Pragma("unroll") for (int j = 0; j < 4; ++j) y[j] = (f32x4){0.f, 0.f, 0.f, 0.f}; \
            _Pragma("unroll") for (int k = 0; k < 4; ++k) _Pragma("unroll") for (int j = 0; j < 4; ++j) { const int w = YQ[k][j]; const f32x2_ lo = __builtin_amdgcn_cvt_pk_f32_fp8(w, false), hi = __builtin_amdgcn_cvt_pk_f32_fp8(w, true); y[j] += (f32x4){lo.x, lo.y, hi.x, hi.y}; } \
            float ss = 0.f; \
            _Pragma("unroll") for (int j = 0; j < 4; ++j) { y[j] = y[j] * Y8_INV; ss += (y[j].x * y[j].x + y[j].y * y[j].y) + (y[j].z * y[j].z + y[j].w * y[j].w); } \
            const float rstd = rsqrtf(wave_sum(ss) * (1.f / D) + EPS); \
            _Pragma("unroll") for (int j = 0; j < 4; ++j) { const int k = 256 * j + 4 * lane; const u32x2 xw = XQ[j]; const f32x4 x1 = (f32x4){bflo(xw.x), bfhi(xw.x), bflo(xw.y), bfhi(xw.y)}; \
                *(f32x4*)(F.out + (size_t)(t0 + (tk_)) * D + k) = (DBG_MODE >= 1) ? x1 : x1 + gm[j] * (y[j] * rstd); } } while (0)
        P11_LOAD(yq0, xq0, 0);
#pragma clang loop unroll(disable)
        for (int tk = 0; tk < 16; tk += 2) {
            P11_LOAD(yq1, xq1, tk + 1);
            P11_DO(yq0, xq0, tk);
            if (tk + 2 < 16) P11_LOAD(yq0, xq0, tk + 2);
            P11_DO(yq1, xq1, tk + 1);
        }
#undef P11_DO
#undef P11_LOAD
    }
}

struct Args { const float* in[23]; float* out; unsigned char* ws; int ph_lo, ph_hi; };
__global__ void __launch_bounds__(NTHR, 2) mk_fwd(Args args) {
    extern __shared__ __attribute__((aligned(16))) unsigned char lds_raw[];
    Fr F; F.lds = (LAS unsigned char*)lds_raw; F.ws = args.ws; F.out = args.out;
#pragma unroll
    for (int i = 0; i < 23; ++i) F.in[i] = args.in[i];
    F.tid = threadIdx.x; F.lane = F.tid & 63; F.wave = __builtin_amdgcn_readfirstlane(F.tid >> 6); F.wg = blockIdx.x; F.G = gridDim.x;
    volatile LAS unsigned* MISC = (volatile LAS unsigned*)(F.lds + LDS_MISC);
    if (F.tid < 16) MISC[F.tid] = 0u;
    __syncthreads();
    const int lo = args.ph_lo, hi = args.ph_hi;
    XcdBarrier bar; bar.bar = WSP(unsigned, WS_CTL) + CW_BAR; bar.x = 0; bar.st = nullptr;
    if (hi - lo > 1) bar = xcd_barrier_post(WSP(unsigned, WS_CTL) + CW_BAR, MISC + 8);
#define IN(k) (lo <= (k) && (k) < hi)
#define SEAM(k) do { if (IN(k) && IN((k) + 1)) xcd_barrier(bar); } while (0)
#define PH0 { p0_prologue(F); }
#define PH1 { p1_norm(F); }
#define PH2 { pg8::Gemm g{WSP(bf16, WS_HALL), WSP(bf16, WS_WINT), TALL, NPROJ, D}; pg8::StaticOrder S; S.init(TALL, NPROJ, F.G, F.wg); \
        EpiStore E{WSP(bf16, WS_P), NPROJ}; pg8::gemm_phase<EpiStore, pg8::StaticOrder, true, true>(F.lds, g, S, E); \
        if (F.wg >= 154 && F.G == 256) p4_convert(F, F.wg - 154, 102, CV_A0, CV_A1); }
#define PH3 { p3_prep(F); if (F.wg >= 32 && F.G == 256) p4_convert(F, F.wg - 32, 224, CV_A1, CV_B1); }
#define PH4 {   \
        if (F.wg < 240) { scan_run<0>(F, F.wg / 15, F.wg % 15); scan_run<1>(F, F.wg / 15, F.wg % 15); } else if (F.G == 256) p4_convert(F, F.wg - 240, 16, CV_B1, CV_C1);        \
        xcd_barrier(bar); \
        if (F.wg < 128) scan_combine(F, F.wg); else { p4_sgu(F, F.wg - 128, F.G - 128, 0, 256); }        \
        xcd_barrier(bar); \
        if (F.wg < 256) scan_run<2>(F, F.wg >> 4, F.wg & 15); \
        p4_sgu(F, F.wg, F.G, 256, NB * 128 * 4); p4_convert(F, F.wg, F.G, F.G == 256 ? CV_C1 : 0, CV_D0); }
#define PH5 { p5_gdn_out(F); }
#define PH6 { pg8::Gemm g{WSP(bf16, WS_MIX), WSP(bf16, WS_WOUTT), T, D, D}; pg8::StaticOrder S; S.init(T, D, F.G, F.wg); \
        EpiStore E{WSP(bf16, WS_R), D}; pg8::gemm_phase<EpiStore, pg8::StaticOrder, true, true>(F.lds, g, S, E); }
#define PH7 { p7_mid(F); }
#define PH8 { p8_permute(F); }
#define PH9 { moe_tables(F); const LAS int* tab = (const LAS int*)(F.lds + LDS_TAB); const int npan = tab[64] < MAXPAN ? tab[64] : MAXPAN; \
        pg8::Gemm g{WSP(bf16, WS_H2), WSP(bf16, WS_WGUT), npan * 256, 2048, D / 2}; MoeOrder S; S.init(npan, 8, F.G, F.wg, tab + 128); \
        { LAS int* gm = (LAS int*)(F.lds + LDS_GMAP); const int* RT = WSP(int, WS_ROWTOK); pg8::Unit uu; \
            for (int i = 0; i < 17 && S.next(i, uu); ++i) if (F.tid < 256) gm[i * 256 + F.tid] = RT[uu.pm * 256 + F.tid]; \
            __syncthreads(); } \
        EpiSwiGLU E{WSP(unsigned char, WS_ACT), WSP(float, WS_BGUP), (LAS float*)(F.lds + LDS_EPI)}; pg8::gemm_phase<EpiSwiGLU, MoeOrder, true, true, true, true>(F.lds, g, S, E, (const LAS int*)(F.lds + LDS_GMAP)); \
        { const int rem = (npan * 8) % F.G; if (rem == 0) p4_convert(F, F.wg, F.G, CV_D0, NE * 768); else if (F.wg >= rem) p4_convert(F, F.wg - rem, F.G - rem, CV_D0, NE * 768); } }
#define PH10 { moe_tables(F); const LAS int* tab = (const LAS int*)(F.lds + LDS_TAB); const int npan = tab[64] < MAXPAN ? tab[64] : MAXPAN; \
        pg8::Gemm g{WSP(bf16, WS_ACT), WSP(bf16, WS_WDT), npan * 256, 1024, D / 2}; MoeOrder S; S.init(npan, 4, F.G, F.wg, tab + 128); \
        EpiDown E{WSP(unsigned char, WS_Y), F.in[22], WSP(float, WS_ROWGATE), (LAS float*)(F.lds + LDS_EPI)}; pg8::gemm_phase<EpiDown, MoeOrder, true, true, true>(F.lds, g, S, E); }
#define RUN(k, BODY) do { if (IN(k)) BODY if (PROBE_TWICE == (k) && IN(k)) { xcd_barrier(bar); BODY } } while (0)
    RUN(0, PH0); SEAM(0);
    RUN(1, PH1); SEAM(1);
    RUN(2, PH2); SEAM(2);
    RUN(3, PH3); SEAM(3);
    RUN(4, PH4);
    if (PROBE_TWICE == 46 && IN(4)) { xcd_barrier(bar); if (F.wg < 240) scan_run<0>(F, F.wg / 15, F.wg % 15); else if (F.wg < 256) scan_run<1>(F, (F.wg - 240) / 15, (F.wg - 240) % 15); if (F.wg < 224) scan_run<1>(F, (F.wg + 16) / 15, (F.wg + 16) % 15); }
    if (PROBE_TWICE == 47 && IN(4)) { xcd_barrier(bar); if (F.wg < 256) scan_run<2>(F, F.wg >> 4, F.wg & 15); }
    if (PROBE_TWICE == 48 && IN(4)) { xcd_barrier(bar); p4_convert(F, F.wg, F.G, CV_C1, CV_D0); }
    if (PROBE_TWICE == 49 && IN(4)) { xcd_barrier(bar); if (F.wg < 128) scan_combine(F, F.wg); }
    SEAM(4);
    RUN(5, PH5); SEAM(5);
    RUN(6, PH6); SEAM(6);
    RUN(7, PH7); SEAM(7);
    RUN(8, PH8); SEAM(8);
    RUN(9, PH9);
#define PH9X(EM) { moe_tables(F); const LAS int* tab = (const LAS int*)(F.lds + LDS_TAB); const int npan = tab[64] < MAXPAN ? tab[64] : MAXPAN; \
        pg8::Gemm g{WSP(bf16, WS_H2), WSP(bf16, WS_WGUT), npan * 256, 2048, D / 2}; MoeOrder S; S.init(npan, 8, F.G, F.wg, tab + 128); \
        { LAS int* gm = (LAS int*)(F.lds + LDS_GMAP); const int* RT = WSP(int, WS_ROWTOK); pg8::Unit uu; \
            for (int i = 0; i < 17 && S.next(i, uu); ++i) if (F.tid < 256) gm[i * 256 + F.tid] = RT[uu.pm * 256 + F.tid]; \
            __syncthreads(); } \
        EpiSwiGLUT<EM> E{WSP(unsigned char, WS_Y), WSP(float, WS_BGUP), (LAS float*)(F.lds + LDS_EPI)}; pg8::gemm_phase<EpiSwiGLUT<EM>, MoeOrder, true, true, true, true>(F.lds, g, S, E, (const LAS int*)(F.lds + LDS_GMAP)); }
    if (PROBE_TWICE == 90 && IN(9)) { xcd_barrier(bar); PH9X(0) }
    if (PROBE_TWICE == 93 && IN(9)) { xcd_barrier(bar); PH9X(3) }
    SEAM(9);
    RUN(10, PH10);
#define PH10X(EM) { moe_tables(F); const LAS int* tab = (const LAS int*)(F.lds + LDS_TAB); const int npan = tab[64] < MAXPAN ? tab[64] : MAXPAN; \
        pg8::Gemm g{WSP(bf16, WS_ACT), WSP(bf16, WS_WDT), npan * 256, 1024, D / 2}; MoeOrder S; S.init(npan, 4, F.G, F.wg, tab + 128); \
        EpiDownT<EM> E{WSP(unsigned char, WS_R1) + 136 * MiB, F.in[22], WSP(float, WS_ROWGATE), (LAS float*)(F.lds + LDS_EPI)}; pg8::gemm_phase<EpiDownT<EM>, MoeOrder, true, true, true>(F.lds, g, S, E); }
    if (PROBE_TWICE == 100 && IN(10)) { xcd_barrier(bar); PH10X(0) }
    if (PROBE_TWICE == 101 && IN(10)) { xcd_barrier(bar); PH10X(1) }
    if (PROBE_TWICE == 103 && IN(10)) { xcd_barrier(bar); PH10X(3) }
    if (PROBE_TWICE == 104 && IN(10)) { xcd_barrier(bar); moe_tables(F); const LAS int* tab = (const LAS int*)(F.lds + LDS_TAB); const int npan = tab[64] < MAXPAN ? tab[64] : MAXPAN;
        pg8::Gemm g{WSP(bf16, WS_ACT), WSP(bf16, WS_WDT), npan * 256, 1024, D}; MoeOrder S; S.init(npan / 2, 4, F.G, F.wg, tab + 128);
        EpiDownT<3> E{WSP(unsigned char, WS_R1) + 136 * MiB, F.in[22], WSP(float, WS_ROWGATE), (LAS float*)(F.lds + LDS_EPI)}; pg8::gemm_phase<EpiDownT<3>, MoeOrder, true, true, true>(F.lds, g, S, E); }
    SEAM(10);
    if (IN(11)) {
        if (DBG_MODE == 10) { const unsigned short* src = (const unsigned short*)(F.ws + WS_PREP);
            for (size_t i = (size_t)F.wg * NTHR + F.tid; i < (size_t)T * D; i += (size_t)F.G * NTHR) { float v = bf2f(src[i * 3]); F.out[i] = (v == v && fabsf(v) < 1e30f) ? v : 0.f; } }
        else if (DBG_MODE == 11) { const unsigned short* src = (const unsigned short*)(F.ws + WS_O);
            for (size_t i = (size_t)F.wg * NTHR + F.tid; i < (size_t)T * D; i += (size_t)F.G * NTHR) { float v = bf2f(src[i]); F.out[i] = (v == v && fabsf(v) < 1e30f) ? v : 0.f; } }
        else { p11_final(F); if (PROBE_TWICE == 11) { xcd_barrier(bar); p11_final(F); } } }
#undef IN
#undef SEAM
}

extern "C" void kernel_launch(void* const* d_in, const int* in_sizes, int n_in, void* d_out, int out_size, void* d_ws, size_t ws_size, hipStream_t stream) {
    static int grid = 0;
    if (grid == 0) {
        if (n_in != 23 || out_size != T * D || ws_size < WS_END) { fprintf(stderr, "kernel_launch: unexpected problem (n_in %d, out %d, ws %zu)\n", n_in, out_size, ws_size); grid = -1; return; }
        int dev = 0, cus = 0;
        if (hipGetDevice(&dev) != hipSuccess || hipDeviceGetAttribute(&cus, hipDeviceAttributeMultiprocessorCount, dev) != hipSuccess) { grid = -1; return; }
        if (hipFuncSetAttribute((const void*)mk_fwd, hipFuncAttributeMaxDynamicSharedMemorySize, LDS_BYTES) != hipSuccess) { fprintf(stderr, "kernel_launch: hipFuncSetAttribute failed\n"); grid = -1; return; }
        int per_cu = 0;
        if (hipOccupancyMaxActiveBlocksPerMultiprocessor(&per_cu, (const void*)mk_fwd, NTHR, LDS_BYTES) != hipSuccess || per_cu < 1) fprintf(stderr, "kernel_launch: occupancy query says %d\n", per_cu);
        (void)hipGetLastError();
        grid = cus;
        if (T % grid != 0 || T / grid > 256 || (T / grid) % 16 != 0 || SEQ % (T / grid) != 0) { fprintf(stderr, "kernel_launch: grid %d unsupported\n", grid); grid = -1; return; }
    }
    if (grid < 0) return;
    (void)hipMemsetAsync((char*)d_ws + WS_CTL, 0, CTL_BYTES, stream);
    Args a{};
    for (int i = 0; i < 23; ++i) a.in[i] = (const float*)d_in[i];
    a.out = (float*)d_out; a.ws = (unsigned char*)d_ws;
#if MK_PER_PHASE
    for (int p = 0; p < NPHASE; ++p) { if (DBG_MODE >= 10 && p >= 5 && p <= 10) continue; a.ph_lo = p; a.ph_hi = p + 1; hipLaunchKernelGGL(mk_fwd, dim3(grid), dim3(NTHR), LDS_BYTES, stream, a); }
#else
    a.ph_lo = 0; a.ph_hi = NPHASE; hipLaunchKernelGGL(mk_fwd, dim3(grid), dim3(NTHR), LDS_BYTES, stream, a);
#endif
}
```

```cpp
#include <hip/hip_runtime.h>
#include <cstdio>
#include <cstdint>
namespace pg8 {
#define PG8_LAS __attribute__((address_space(3)))
typedef unsigned short bf16_t;
typedef short bf16x8 __attribute__((ext_vector_type(8)));
typedef float f32x4 __attribute__((ext_vector_type(4)));
typedef unsigned u32x4 __attribute__((ext_vector_type(4)));
constexpr int BM = 256, BK = 64, HALF = 128, HTB = HALF * BK * 2  , STAGE_BYTES = 8 * HTB, NXCD = 8, WGM = 8;

__host__ __device__ __forceinline__ int lds_byte(int r, int c) { const int st = (r >> 4) * 2 + (c >> 5), rr = r & 15, cc = c & 31, ob = rr * 64 + cc * 2; return st * 1024 + (ob ^ (((ob >> 9) & 1) << 5)); }
__host__ __device__ __forceinline__ void stage_rc(int b, int& R, int& C) { const int st = b / 1024, sb = b % 1024, swz = sb ^ (((sb >> 9) & 1) << 5); R = (st >> 1) * 16 + swz / 64; C = (st & 1) * 32 + (swz % 64) / 2; }
__host__ __device__ __forceinline__ int perm32(int rho) { const int n = rho >> 4, i = rho & 15; return 8 * (i >> 2) + 4 * n + (i & 3); }

struct Unit { int pm, pn; };
struct Gemm { const bf16_t* A; const bf16_t* Bt; int M, N, K; };

struct StaticOrder {
    int nM, nN, nwg, G, c;
    __host__ __device__ void init(int M, int N, int G_, int c_) { nM = M / BM; nN = N / BM; nwg = nM * nN; G = G_; c = c_; }
    __host__ __device__ bool next(int i, Unit& u) const {
        const long L = (long)i * G + c; if (L >= nwg) return false;
        int wgid = (int)L; { const int q = nwg / NXCD, r = nwg % NXCD, xcd = wgid % NXCD, off = wgid / NXCD; wgid = (xcd < r ? xcd * (q + 1) : r * (q + 1) + (xcd - r) * q) + off; }
        const int nig = WGM * nN, gid = wgid / nig, fm = gid * WGM, gsz = (nM - fm) < WGM ? (nM - fm) : WGM;
        u.pm = fm + ((wgid % nig) % gsz); u.pn = (wgid % nig) / gsz; return true;
    }
    __device__ __forceinline__ void a_ready(const Unit&) const {}
    __device__ __forceinline__ void done(const Unit&) const {}
};
__device__ __forceinline__ unsigned cvt_pk_bf16(float lo, float hi) { unsigned r; asm volatile("v_cvt_pk_bf16_f32 %0, %1, %2" : "=v"(r) : "v"(lo), "v"(hi)); return r; }
template <class Epi, class Sched, bool ALIGN_EPI = false, bool SP2 = false, bool FP8 = false, bool GATHER = false>
__device__ __forceinline__ void gemm_phase(PG8_LAS unsigned char* lds, const Gemm g, const Sched& S, const Epi& E, const PG8_LAS int* gmap = nullptr) {
    typedef int i32x8_ __attribute__((ext_vector_type(8))); typedef int i32x4_ __attribute__((ext_vector_type(4)));
    const int tid = threadIdx.x, wid = __builtin_amdgcn_readfirstlane(tid >> 6), lane = tid & 63, wr = wid >> 2, wc = wid & 3, fr = lane & 15, fq = lane >> 4;
    const int K = g.K, nt = K / BK;
    unsigned voffA[2], voffB[2];
    int gR[2]; unsigned gCb[2]; unsigned gC0[2], gC1[2], gN0[2], gN1[2];
#pragma unroll
    for (int i = 0; i < 2; ++i) { int R, C; stage_rc(tid * 16 + i * 8192, R, C); const int Rb = Epi::PERM ? ((R & ~31) + perm32(R & 31)) : R;
        voffA[i] = (unsigned)(R * K + C) * 2u; voffB[i] = (unsigned)(Rb * K + C) * 2u; gR[i] = R; gCb[i] = (unsigned)C * 2u; }
#define PG8_GOFF(D0, D1, ui_) do { _Pragma("unroll") for (int i_ = 0; i_ < 2; ++i_) { D0[i_] = (unsigned)gmap[(ui_) * 256 + gR[i_]] * (unsigned)(K * 2) + gCb[i_]; D1[i_] = (unsigned)gmap[(ui_) * 256 + 128 + gR[i_]] * (unsigned)(K * 2) + gCb[i_]; } } while (0)
#define PG8_STAGE_A(bufoff, gbase, h_, nx_) do { if constexpr (GATHER) { if (nx_) PG8_STAGE(bufoff, gbase, ((h_) ? gN1 : gN0)); else PG8_STAGE(bufoff, gbase, ((h_) ? gC1 : gC0)); } \
        else PG8_STAGE(bufoff, (gbase) + ((h_) ? hstep : 0), voffA); } while (0)
    const size_t kstep = (size_t)(BK * 2);
    const size_t hstep = (size_t)HALF * K * 2;
    const size_t tstep = 2 * hstep;
    const unsigned ldsw = (unsigned)wid * 1024u;
    const int aoff = lds_byte(wr * 64 + fr, fq * 8), boff = lds_byte(wc * 32 + fr, fq * 8);
#define PG8_SA(b, h) (((b) * 2 + (h)) * HTB)
#define PG8_SB(b, h) ((4 + (b) * 2 + (h)) * HTB)
#define PG8_STAGE(bufoff, gbase, voff) do { _Pragma("unroll") for (int _i = 0; _i < 2; ++_i) \
        __builtin_amdgcn_global_load_lds((const unsigned*)((const char*)(gbase) + (voff)[_i]), (PG8_LAS unsigned*)(lds + (bufoff) + ldsw + _i * 8192), 16, 0, 0); } while (0)
#define PG8_LDA(dst, b, h) do { _Pragma("unroll") for (int m = 0; m < 4; ++m) _Pragma("unroll") for (int k = 0; k < 2; ++k) dst[m][k] = *(const PG8_LAS bf16x8*)(lds + PG8_SA(b, h) + aoff + m * 2048 + k * 1024); } while (0)
#define PG8_LDB(dst, b, h) do { _Pragma("unroll") for (int n = 0; n < 2; ++n) _Pragma("unroll") for (int k = 0; k < 2; ++k) dst[n][k] = *(const PG8_LAS bf16x8*)(lds + PG8_SB(b, h) + boff + n * 2048 + k * 1024); } while (0)
#define PG8_MMA16(ai, bj, At, Bt) do { __builtin_amdgcn_s_setprio(1); _Pragma("unroll") for (int m = 0; m < 4; ++m) _Pragma("unroll") for (int n = 0; n < 2; ++n) _Pragma("unroll") for (int k = 0; k < 2; ++k) \
        acc[ai][bj][m][n] = __builtin_amdgcn_mfma_f32_16x16x32_bf16(Bt[n][k], At[m][k], acc[ai][bj][m][n], 0, 0, 0); __builtin_amdgcn_s_setprio(0); } while (0)
#define PG8_LDA8(dst, b, h) do { _Pragma("unroll") for (int m = 0; m < 4; ++m) { const i32x4_ lo_ = *(const PG8_LAS i32x4_*)(lds + PG8_SA(b, h) + aoff + m * 2048), hi_ = *(const PG8_LAS i32x4_*)(lds + PG8_SA(b, h) + aoff + m * 2048 + 1024); \
        dst[m] = __builtin_shufflevector(lo_, hi_, 0, 1, 2, 3, 4, 5, 6, 7); } } while (0)
#define PG8_LDB8(dst, b, h) do { _Pragma("unroll") for (int n = 0; n < 2; ++n) { const i32x4_ lo_ = *(const PG8_LAS i32x4_*)(lds + PG8_SB(b, h) + boff + n * 2048), hi_ = *(const PG8_LAS i32x4_*)(lds + PG8_SB(b, h) + boff + n * 2048 + 1024); \
        dst[n] = __builtin_shufflevector(lo_, hi_, 0, 1, 2, 3, 4, 5, 6, 7); } } while (0)
#define PG8_MMA8(ai, bj, At, Bt) do { __builtin_amdgcn_s_setprio(1); _Pragma("unroll") for (int m = 0; m < 4; ++m) _Pragma("unroll") for (int n = 0; n < 2; ++n) \
        asm volatile("v_mfma_f32_16x16x128_f8f6f4 %0, %1, %2, %0" : "+v"(acc[ai][bj][m][n]) : "v"(Bt[n]), "v"(At[m])); \
        __builtin_amdgcn_s_setprio(0); } while (0)
#define PG8_LDAX(dst, b, h) do { if constexpr (FP8) PG8_LDA8(dst##8, b, h); else PG8_LDA(dst, b, h); } while (0)
#define PG8_LDBX(dst, b, h) do { if constexpr (FP8) PG8_LDB8(dst##8, b, h); else PG8_LDB(dst, b, h); } while (0)
#define PG8_MMA(ai, bj, At, Bt) do { if constexpr (FP8) PG8_MMA8(ai, bj, At##8, Bt##8); else PG8_MMA16(ai, bj, At, Bt); } while (0)
#define PG8_WAIT_V(n) asm volatile("s_waitcnt vmcnt(" #n ")" ::: "memory")
#define PG8_WAIT_L(n) asm volatile("s_waitcnt lgkmcnt(" #n ")" ::: "memory")
#define PG8_BAR __builtin_amdgcn_s_barrier()
#define PG8_SCHED __builtin_amdgcn_sched_barrier(0)
    Unit cur, nxt; int ui = 0;
    if (!S.next(0, cur)) return;
    f32x4 acc[2][2][4][2];
#pragma unroll
    for (int a = 0; a < 2; ++a)
#pragma unroll
        for (int b = 0; b < 2; ++b)
#pragma unroll
            for (int m = 0; m < 4; ++m)
#pragma unroll
                for (int n = 0; n < 2; ++n) acc[a][b][m][n] = (f32x4){0.f, 0.f, 0.f, 0.f};
    bf16x8 At[4][2], B0[2][2], B1[2][2];
    i32x8_ At8[4], B08[2], B18[2]; int scale1 = 0x7f7f7f7f; asm volatile("" : "+v"(scale1));
    const char* cA = (const char*)g.A + (GATHER ? (size_t)0 : (size_t)cur.pm * tstep); const char* cB = (const char*)g.Bt + (size_t)cur.pn * tstep;
    if constexpr (GATHER) { PG8_GOFF(gC0, gC1, 0); }
    S.a_ready(cur);
    E.pre(cur, wid, lane, 0);
    if constexpr (SP2) {
        PG8_STAGE(PG8_SB(0, 0), cB, voffB); PG8_STAGE(PG8_SB(0, 1), cB + hstep, voffB); PG8_STAGE_A(PG8_SA(0, 0), cA, 0, false); PG8_STAGE_A(PG8_SA(0, 1), cA, 1, false);
        if (wr == 1) PG8_BAR;
        PG8_WAIT_V(2); PG8_BAR;
        PG8_STAGE(PG8_SB(1, 0), cB + kstep, voffB); PG8_STAGE_A(PG8_SA(1, 0), cA + kstep, 0, false); PG8_STAGE(PG8_SB(1, 1), cB + hstep + kstep, voffB);
        PG8_WAIT_V(6); PG8_BAR;
    } else {
        PG8_STAGE(PG8_SB(0, 0), cB, voffB); PG8_STAGE(PG8_SA(0, 0), cA, voffA); PG8_STAGE(PG8_SB(0, 1), cB + hstep, voffB); PG8_STAGE(PG8_SA(0, 1), cA + hstep, voffA);
        if (wr == 1) PG8_BAR;
        PG8_WAIT_V(4); PG8_BAR;
        PG8_STAGE(PG8_SB(1, 0), cB + kstep, voffB); PG8_STAGE(PG8_SA(1, 0), cA + kstep, voffA); PG8_STAGE(PG8_SB(1, 1), cB + hstep + kstep, voffB);
        PG8_WAIT_V(6); PG8_BAR;
    }
    for (;;) {
        const bool has_next = S.next(ui + 1, nxt);
        const char* nA = (has_next && !GATHER) ? (const char*)g.A + (size_t)nxt.pm * tstep : cA; const char* nB = has_next ? (const char*)g.Bt + (size_t)nxt.pn * tstep : cB;
        if constexpr (GATHER) { if (has_next) { PG8_GOFF(gN0, gN1, ui + 1); } else { _Pragma("unroll") for (int i_ = 0; i_ < 2; ++i_) { gN0[i_] = gC0[i_]; gN1[i_] = gC1[i_]; } } }
#pragma clang loop unroll(disable)
        for (int t = 0; t < nt; t += 2) {
            const bool last = (t == nt - 2);
            const char* a1 = cA + (size_t)(t + 1) * kstep;
            const char* a2 = last ? nA : cA + (size_t)(t + 2) * kstep; const char* b2 = last ? nB : cB + (size_t)(t + 2) * kstep;
            const char* a3 = a2 + kstep; const char* b3 = b2 + kstep;
            if (last && has_next) S.a_ready(nxt);
            if constexpr (SP2) {
            PG8_LDBX(B0, 0, 0); PG8_LDBX(B1, 0, 1); PG8_SCHED; PG8_LDAX(At, 0, 0); PG8_STAGE_A(PG8_SA(1, 1), a1, 1, false);
            PG8_WAIT_V(8); PG8_WAIT_L(0); PG8_BAR; PG8_MMA(0, 0, At, B0); PG8_MMA(0, 1, At, B1); PG8_BAR; PG8_SCHED;
            PG8_LDAX(At, 0, 1); PG8_STAGE(PG8_SB(0, 0), b2, voffB); PG8_STAGE(PG8_SB(0, 1), b2 + hstep, voffB); PG8_STAGE_A(PG8_SA(0, 0), a2, 0, last);
            PG8_WAIT_V(8); PG8_WAIT_L(0); PG8_BAR; PG8_MMA(1, 0, At, B0); PG8_MMA(1, 1, At, B1); PG8_BAR; PG8_SCHED;
            PG8_LDBX(B0, 1, 0); PG8_LDBX(B1, 1, 1); PG8_SCHED; PG8_LDAX(At, 1, 0); PG8_STAGE_A(PG8_SA(0, 1), a2, 1, last);
            PG8_WAIT_V(8); PG8_WAIT_L(0); PG8_BAR; PG8_MMA(0, 0, At, B0); PG8_MMA(0, 1, At, B1); PG8_BAR; PG8_SCHED;
            PG8_LDAX(At, 1, 1); PG8_STAGE(PG8_SB(1, 0), b3, voffB); PG8_STAGE(PG8_SB(1, 1), b3 + hstep, voffB); PG8_STAGE_A(PG8_SA(1, 0), a3, 0, last);
            PG8_WAIT_V(8); PG8_WAIT_L(0); PG8_BAR; PG8_MMA(1, 0, At, B0); PG8_MMA(1, 1, At, B1); PG8_BAR; PG8_SCHED;
            } else {
            PG8_LDBX(B0, 0, 0); PG8_SCHED; PG8_LDAX(At, 0, 0); PG8_STAGE(PG8_SA(1, 1), a1 + hstep, voffA);
            PG8_WAIT_L(8); PG8_BAR; PG8_WAIT_L(0); PG8_MMA(0, 0, At, B0); PG8_BAR; PG8_SCHED;
            PG8_LDBX(B1, 0, 1); PG8_STAGE(PG8_SB(0, 0), b2, voffB);
            PG8_BAR; PG8_WAIT_L(0); PG8_MMA(0, 1, At, B1); PG8_BAR;
            PG8_LDAX(At, 0, 1); PG8_STAGE(PG8_SA(0, 0), a2, voffA);
            PG8_BAR; PG8_WAIT_L(0); PG8_MMA(1, 0, At, B0); PG8_BAR; PG8_SCHED;
            PG8_STAGE(PG8_SB(0, 1), b2 + hstep, voffB);
            PG8_WAIT_V(6); PG8_BAR; PG8_MMA(1, 1, At, B1); PG8_BAR;
            PG8_LDBX(B0, 1, 0); PG8_SCHED; PG8_LDAX(At, 1, 0); PG8_STAGE(PG8_SA(0, 1), a2 + hstep, voffA);
            PG8_WAIT_L(8); PG8_BAR; PG8_WAIT_L(0); PG8_MMA(0, 0, At, B0); PG8_BAR; PG8_SCHED;
            PG8_LDBX(B1, 1, 1); PG8_STAGE(PG8_SB(1, 0), b3, voffB);
            PG8_BAR; PG8_WAIT_L(0); PG8_MMA(0, 1, At, B1); PG8_BAR;
            PG8_LDAX(At, 1, 1); PG8_STAGE(PG8_SA(1, 0), a3, voffA);
            PG8_BAR; PG8_WAIT_L(0); PG8_MMA(1, 0, At, B0); PG8_BAR; PG8_SCHED;
            PG8_STAGE(PG8_SB(1, 1), b3 + hstep, voffB);
            PG8_WAIT_V(6); PG8_BAR; PG8_MMA(1, 1, At, B1); PG8_BAR;
            }
        }
        if constexpr (ALIGN_EPI) { if (wr == 0) PG8_BAR; }
        if constexpr (FP8) asm volatile("s_nop 15\n\ts_nop 15\n\ts_nop 15\n\ts_nop 15\n\ts_nop 15" ::: "memory");
        if constexpr (!Epi::AFTER_DRAIN) { Unit eu = cur; int fr_ = fr, fq_ = fq; asm volatile("" : "+v"(eu.pm), "+v"(eu.pn), "+v"(fr_), "+v"(fq_));
            E(acc, eu, wr, wc, fr_, fq_, ui & 1); S.done(cur); }
        if (!has_next) break;
#pragma unroll
        for (int a = 0; a < 2; ++a)
#pragma unroll
            for (int b = 0; b < 2; ++b)
#pragma unroll
                for (int m = 0; m < 4; ++m)
#pragma unroll
                    for (int n = 0; n < 2; ++n) acc[a][b][m][n] = (f32x4){0.f, 0.f, 0.f, 0.f};
        cur = nxt; cA = nA; cB = nB; ++ui;
        E.pre(cur, wid, lane, ui & 1);
        if constexpr (GATHER) { _Pragma("unroll") for (int i_ = 0; i_ < 2; ++i_) { gC0[i_] = gN0[i_]; gC1[i_] = gN1[i_]; } }
        if constexpr (ALIGN_EPI) { if (wr == 1) PG8_BAR; }
    }
    PG8_WAIT_V(0);
    if constexpr (!ALIGN_EPI) { if (wr == 0) PG8_BAR; }
    PG8_BAR;
    if constexpr (Epi::AFTER_DRAIN) { E.fused(acc, cur, wr, wc, fr, fq, lds, wid, lane); S.done(cur); }
#undef PG8_SA
#undef PG8_SB
#undef PG8_STAGE
#undef PG8_STAGE_A
#undef PG8_GOFF
#undef PG8_LDA
#undef PG8_LDB
#undef PG8_MMA
#undef PG8_MMA16
#undef PG8_MMA8
#undef PG8_LDA8
#undef PG8_LDB8
#undef PG8_LDAX
#undef PG8_LDBX
#undef PG8_WAIT_V
#undef PG8_WAIT_L
#undef PG8_BAR
#undef PG8_SCHED
}
}

#ifndef P2_FP8
#define P2_FP8 1
#endif
#ifndef MK_PER_PHASE
#define MK_PER_PHASE 0
#endif
#ifndef PROBE_TWICE
#define PROBE_TWICE -1
#endif
#ifndef DBG_SEL
#define DBG_SEL 9
#endif
#ifndef DBG_MODE
#define DBG_MODE 0
#endif
#if 0
#endif

#define GAS __attribute__((address_space(1)))
#define LAS __attribute__((address_space(3)))
typedef unsigned short bf16;
typedef float f32x4 __attribute__((ext_vector_type(4)));
typedef short bf16x8 __attribute__((ext_vector_type(8)));
typedef unsigned u32x4 __attribute__((ext_vector_type(4)));
typedef unsigned u32x2 __attribute__((ext_vector_type(2)));

constexpr int NB = 2, SEQ = 16384, D = 1024, T = NB * SEQ, CTXL = 256, TC = NB * CTXL, TALL = T + TC;
constexpr int NPROJ = 3328, NPROJ_SRC = 3088;
constexpr int PC_Z = 1536, PC_U = 2048, PC_V = 2560, PC_BA = 3072;
constexpr int NH = 4, NE = 32, NCH = 260;
constexpr int MAXPAN = 544, MAXROWS = MAXPAN * 256;
constexpr float EPS = 1e-6f;
constexpr int NWAVES = 8, NTHR = 512;
constexpr int NPHASE = 12;
constexpr int CV_A0 = 0, CV_A1 = 1536, CV_B1 = CV_A1 + 5376, CV_C1 = CV_B1 + 2304, CV_D0 = NE * 768 - 3072;

constexpr size_t MiB = 1ull << 20;
constexpr size_t WS_CTL = 0, CTL_BYTES = 1 * MiB;
constexpr size_t WS_MOD = 1 * MiB;
constexpr size_t WS_WRT = 1 * MiB + 128 * 1024;
constexpr size_t WS_BGUP = 1 * MiB + 256 * 1024;
constexpr size_t WS_TKE = 2 * MiB, WS_TKRANK = 2 * MiB + 512 * 1024, WS_TKGATE = 3 * MiB, WS_TKROW = 3 * MiB + 512 * 1024;
constexpr size_t WS_ROWGATE = 4 * MiB;
constexpr size_t WS_WINT = 6 * MiB;
constexpr size_t WS_WOUTT = 13 * MiB;
constexpr size_t WS_WGUT = 16 * MiB;
constexpr size_t WS_WDT = 144 * MiB;
constexpr size_t WS_X1 = 208 * MiB;
constexpr size_t WS_MIX = WS_X1;
constexpr size_t WS_H2 = 336 * MiB;
constexpr size_t WS_R1 = 400 * MiB;
constexpr size_t WS_P = WS_R1, WS_ACT = WS_R1;
constexpr size_t WS_R2 = 672 * MiB;
constexpr size_t WS_HALL = WS_R2, WS_O = WS_R2;
constexpr size_t WS_PREP = WS_R2 + 65 * MiB;
constexpr size_t WS_R = WS_PREP;
constexpr size_t WS_VEC = WS_R2 + 261 * MiB;
constexpr size_t WS_ROWTOK = WS_R2;
constexpr size_t WS_XS = WS_R2, WS_Y = WS_R2;
constexpr size_t WS_END = 944 * MiB;
constexpr size_t PREP_UNIT = 98304;
constexpr int PO_KQ = 0, PO_KT = 32768, PO_V = 49152, PO_T = 65536, PO_A = 81920;
constexpr int CW_BAR = 4096, CW_GCNT = 8192;

constexpr int LDS_BYTES = 163840;
constexpr int LDS_TAB = 131072;
constexpr int LDS_GMAP = LDS_TAB + 4096;
constexpr int LDS_EPI = LDS_GMAP + 17 * 1024 + 1024;
constexpr int LDS_MISC = LDS_BYTES - 64;

#define LDS_WAIT() asm volatile("s_waitcnt lgkmcnt(0)" ::: "memory")
#define VM_WAIT() asm volatile("s_waitcnt vmcnt(0)" ::: "memory")

__device__ __forceinline__ float bf2f(unsigned b) { return __uint_as_float(b << 16); }
__device__ __forceinline__ float bflo(unsigned w) { return __uint_as_float(w << 16); }
__device__ __forceinline__ float bfhi(unsigned w) { return __uint_as_float(w & 0xffff0000u); }
typedef __bf16 bf16x2_t __attribute__((ext_vector_type(2)));
typedef float f32x2_t __attribute__((ext_vector_type(2)));
__device__ __forceinline__ unsigned pk2(float lo, float hi) { const f32x2_t f = {lo, hi}; const bf16x2_t v = __builtin_convertvector(f, bf16x2_t); return __builtin_bit_cast(unsigned, v); }
__device__ __forceinline__ float sat8(float x) { return __builtin_amdgcn_fmed3f(x, -448.f, 448.f); }
__device__ __forceinline__ unsigned pk_fp8x4(float a, float b, float c, float d) { a = sat8(a); b = sat8(b); c = sat8(c); d = sat8(d); int w = 0; w = __builtin_amdgcn_cvt_pk_fp8_f32(a, b, w, false); w = __builtin_amdgcn_cvt_pk_fp8_f32(c, d, w, true); return (unsigned)w; }
__device__ __forceinline__ unsigned pk_fp8x4_ns(float a, float b, float c, float d) { int w = 0; w = __builtin_amdgcn_cvt_pk_fp8_f32(a, b, w, false); w = __builtin_amdgcn_cvt_pk_fp8_f32(c, d, w, true); return (unsigned)w; }
constexpr float W8_SCALE = 32.f, W8_INV = 1.f / 32.f;
__device__ __forceinline__ float frcp(float x) { return __builtin_amdgcn_rcpf(x); }
__device__ __forceinline__ float sigm(float x) { return frcp(1.f + __expf(-x)); }
__device__ __forceinline__ float silu_(float x) { return x * frcp(1.f + __expf(-x)); }
__device__ __forceinline__ float gelu_t(float x) { return x * frcp(1.f + __builtin_amdgcn_exp2f(x * (-2.3022081980180664f - 0.10294324017437584f * x * x))); }
#define DPP_MOV(v, ctrl) __builtin_bit_cast(float, __builtin_amdgcn_update_dpp(0, __builtin_bit_cast(int, (v)), (ctrl), 0xf, 0xf, true))
__device__ __forceinline__ float sum16(float v) { v += DPP_MOV(v, 0xB1); v += DPP_MOV(v, 0x4E); v += DPP_MOV(v, 0x124); v += DPP_MOV(v, 0x128); return v; }
__device__ __forceinline__ float wave_sum(float v) {
    v = sum16(v); const int iv = __builtin_bit_cast(int, v);
    return (__builtin_bit_cast(float, __builtin_amdgcn_readlane(iv, 0)) + __builtin_bit_cast(float, __builtin_amdgcn_readlane(iv, 16))) + (__builtin_bit_cast(float, __builtin_amdgcn_readlane(iv, 32)) + __builtin_bit_cast(float, __builtin_amdgcn_readlane(iv, 48)));
}
#define XB_TMO      128
#define XB_XCNT(j)  (256  + 64 * (j))
#define XB_XSUB(j)  (1280 + 64 * (j))
#define XB_XGEN(j)  (2304 + 64 * (j))
#define XB_TOP      3328
#define XB_TOPGEN   3392
#define XCD_BAR_WORDS 3456
#define XB_SPIN_CAP (1u << 18)
__device__ __forceinline__ unsigned xb_ld(unsigned* p)              { return __hip_atomic_load(p, __ATOMIC_RELAXED, __HIP_MEMORY_SCOPE_AGENT); }
__device__ __forceinline__ unsigned xb_add(unsigned* p, unsigned v) { return __hip_atomic_fetch_add(p, v, __ATOMIC_RELAXED, __HIP_MEMORY_SCOPE_AGENT); }
__device__ __forceinline__ unsigned xb_xcc_id() { return (unsigned)__builtin_amdgcn_s_getreg((3 << 11) | 20) & 0xFu; }
#define XB_SPIN(cond, bar) do { unsigned _sp = 0; while (cond) { __builtin_amdgcn_s_sleep(1); \
    if ((++_sp & 255u) == 0u) { if (xb_ld(&(bar)[XB_TMO])) break; if (_sp > XB_SPIN_CAP) { atomicAdd(&(bar)[XB_TMO], 1u); break; } } } } while (0)
struct XcdBarrier { unsigned* bar; unsigned x; volatile LAS unsigned* st; };
__device__ __forceinline__ XcdBarrier xcd_barrier_post(unsigned* bar, volatile LAS unsigned* st) {
    XcdBarrier b; b.bar = bar; b.x = xb_xcc_id(); b.st = st;
    if (threadIdx.x == 0) (void)xb_add(&bar[XB_XCNT(b.x)], 1u);
    return b;
}
__device__ __forceinline__ void xcd_barrier_complete(unsigned* bar, unsigned x, unsigned& nloc, unsigned& nx) {
    const unsigned G = gridDim.x * gridDim.y * gridDim.z;
    unsigned sum, cnt, mine, sp = 0u;
    for (;;) {
        sum = 0u; cnt = 0u; mine = 0u;
#pragma unroll
        for (unsigned j = 0; j < 16; ++j) { const unsigned c = xb_ld(&bar[XB_XCNT(j)]); sum += c; cnt += (c > 0u) ? 1u : 0u; mine = (j == x) ? c : mine; }
        if (sum == G) break;
        __builtin_amdgcn_s_sleep(1);
        if ((++sp & 255u) == 0u) { if (xb_ld(&bar[XB_TMO])) break; if (sp > XB_SPIN_CAP) { atomicAdd(&bar[XB_TMO], 1u); break; } }
    }
    nloc = mine > 0u ? mine : 1u; nx = cnt > 0u ? cnt : 1u;
}
__device__ __forceinline__ void xcd_barrier(const XcdBarrier& b) {
    asm volatile("s_waitcnt vmcnt(0)" ::: "memory");
    __syncthreads();
    if (threadIdx.x == 0) {
        unsigned* bar = b.bar;
        __builtin_amdgcn_s_waitcnt(0);
        unsigned nloc = b.st[0], nx = b.st[1];
        if (nloc == 0u) { xcd_barrier_complete(bar, b.x, nloc, nx); b.st[0] = nloc; b.st[1] = nx; }
        const unsigned old = xb_add(&bar[XB_XSUB(b.x)], 1u);
        const unsigned gen = old / nloc;
        if (old + 1u == (gen + 1u) * nloc) {
            __builtin_amdgcn_fence(__ATOMIC_RELEASE, "agent");
            asm volatile("s_waitcnt vmcnt(0)" ::: "memory");
            const unsigned og = xb_add(&bar[XB_TOP], 1u);
            const unsigned tg = og / nx;
            if (og + 1u == (tg + 1u) * nx) xb_add(&bar[XB_TOPGEN], 1u);
            else XB_SPIN(xb_ld(&bar[XB_TOPGEN]) == tg, bar);
            __builtin_amdgcn_fence(__ATOMIC_ACQUIRE, "agent");
            xb_add(&bar[XB_XGEN(b.x)], 1u);
            asm volatile("s_waitcnt vmcnt(0)" ::: "memory");
        } else {
            XB_SPIN(xb_ld(&bar[XB_XGEN(b.x)]) == gen, bar);
            __builtin_amdgcn_fence(__ATOMIC_ACQUIRE, "agent");
            asm volatile("s_waitcnt vmcnt(0)" ::: "memory");
        }
    }
    __syncthreads();
}

struct Fr {
    LAS unsigned char* lds; unsigned char* ws; const float* in[23]; float* out;
    int tid, lane, wave, wg, G;
};
#define WSP(T_, off) ((T_*)(F.ws + (off)))

struct MapId { __device__ __forceinline__ int operator()(int n) const { return n; } };
struct MapIn { __device__ __forceinline__ int operator()(int n) const { return n < 1536 ? n : (n < 1552 ? PC_BA + (n - 1536) : n - 16); } };
struct MapGu { __device__ __forceinline__ int operator()(int s) const { const int a = s >> 1; return 32 * (a >> 4) + 16 * (s & 1) + (a & 15); } };
template <class RM> __device__ __forceinline__ void tr_item(const float* W, int N, int k0, int n0, bf16* WT, RM rm, LAS float* scr, int lane) {
    const int cq = lane & 15, rq = lane >> 4;
#pragma unroll
    for (int i = 0; i < 16; ++i) { const int kk = 4 * i + rq, n = n0 + 4 * cq; f32x4 v = (f32x4){0.f, 0.f, 0.f, 0.f};
        if (n < N) v = *(const f32x4*)(W + (size_t)(k0 + kk) * N + n);
        *(LAS f32x4*)(scr + kk * 68 + 4 * cq) = v; }
    LDS_WAIT();
    const int c = lane & 7;
#pragma unroll
    for (int j = 0; j < 8; ++j) { const int n = 8 * j + (lane >> 3);
        if (n0 + n < N) { const LAS float* s = scr + (8 * c) * 68 + n;
            u32x4 o; o.x = pk2(s[0], s[68]); o.y = pk2(s[136], s[204]); o.z = pk2(s[272], s[340]); o.w = pk2(s[408], s[476]);
            *(u32x4*)(WT + (size_t)rm(n0 + n) * 1024 + k0 + 8 * c) = o; } }
    LDS_WAIT();
}
struct MapGu8 { __device__ __forceinline__ int operator()(int s) const { const int a = s >> 1, n = s & 1, pn = a >> 7, al = a & 127; return 256 * pn + 128 * ((al >> 2) & 1) + 32 * (al >> 5) + 16 * n + 4 * ((al >> 3) & 3) + (al & 3); } };
struct MapDn8 { __device__ __forceinline__ int operator()(int o) const { const int pn = o >> 8, ol = o & 255; return 256 * pn + 128 * ((ol >> 3) & 1) + 32 * (ol >> 6) + 8 * ((ol >> 4) & 3) + (ol & 7); } };
template <class RM> __device__ __forceinline__ void tr_item8(const float* W, int N, int k0, int n0, unsigned char* WT, RM rm, LAS float* scr, int lane) {
    const int cq = lane & 15, rq = lane >> 4;
#pragma unroll
    for (int i = 0; i < 16; ++i) { const int kk = 4 * i + rq, n = n0 + 4 * cq; *(LAS f32x4*)(scr + kk * 68 + 4 * cq) = *(const f32x4*)(W + (size_t)(k0 + kk) * N + n); }
    LDS_WAIT();
    const int c = lane & 7;
#pragma unroll
    for (int j = 0; j < 8; ++j) { const int n = 8 * j + (lane >> 3); const LAS float* sp = scr + (8 * c) * 68 + n;
        u32x2 o; o.x = pk_fp8x4(sp[0] * W8_SCALE, sp[68] * W8_SCALE, sp[136] * W8_SCALE, sp[204] * W8_SCALE); o.y = pk_fp8x4(sp[272] * W8_SCALE, sp[340] * W8_SCALE, sp[408] * W8_SCALE, sp[476] * W8_SCALE);
        *(u32x2*)(WT + (size_t)rm(n0 + n) * 1024 + k0 + 8 * c) = o; }
    LDS_WAIT();
}
template <class RM> __device__ __forceinline__ void tr_item8g(const float* W, int N, int k0, int n0, unsigned char* WT, RM rm, LAS float* scr, int lane) {
    const int cq = lane & 15, rq = lane >> 4;
#pragma unroll
    for (int i = 0; i < 16; ++i) { const int kk = 4 * i + rq, n = n0 + 4 * cq; f32x4 v = (f32x4){0.f, 0.f, 0.f, 0.f};
        if (n < N) v = *(const f32x4*)(W + (size_t)(k0 + kk) * N + n);
        *(LAS f32x4*)(scr + kk * 68 + 4 * cq) = v; }
    LDS_WAIT();
    const int c = lane & 7;
#pragma unroll
    for (int j = 0; j < 8; ++j) { const int n = 8 * j + (lane >> 3); const LAS float* sp = scr + (8 * c) * 68 + n;
        u32x2 o; o.x = pk_fp8x4(sp[0] * W8_SCALE, sp[68] * W8_SCALE, sp[136] * W8_SCALE, sp[204] * W8_SCALE); o.y = pk_fp8x4(sp[272] * W8_SCALE, sp[340] * W8_SCALE, sp[408] * W8_SCALE, sp[476] * W8_SCALE);
        if (n0 + n < N) *(u32x2*)(WT + (size_t)rm(n0 + n) * 1024 + k0 + 8 * c) = o; }
    LDS_WAIT();
}
__device__ __forceinline__ void p0_prologue(const Fr& F) {
    const float* c = F.in[1]; const float* cc = F.in[3]; const float* wada = F.in[4]; const float* bada = F.in[5];
    {
        LAS float* SIL = (LAS float*)F.lds; LAS float* RED = SIL + 3072; float* MOD = WSP(float, WS_MOD);
        for (int u = F.wg; u < 96; u += F.G) {
            for (int i = F.tid; i < 3072; i += NTHR) { const int r = i >> 10, k = i & 1023; const float x = r == 0 ? c[k] : (r == 1 ? c[1024 + k] : cc[k]); SIL[i] = silu_(x); }
            __syncthreads();
            const int n0 = u * 64, kb = F.wave * 128; float a0 = 0.f, a1 = 0.f, a2 = 0.f;
#pragma unroll 64
            for (int k = 0; k < 128; ++k) { const float w = wada[(size_t)(kb + k) * 6144 + n0 + F.lane];
 a0 += SIL[kb + k] * w; a1 += SIL[1024 + kb + k] * w; a2 += SIL[2048 + kb + k] * w; }
            RED[(F.wave * 3 + 0) * 64 + F.lane] = a0; RED[(F.wave * 3 + 1) * 64 + F.lane] = a1; RED[(F.wave * 3 + 2) * 64 + F.lane] = a2;
            __syncthreads();
            if (F.tid < 192) { const int r = F.tid >> 6, l = F.tid & 63; float s = bada[n0 + l];
#pragma unroll
                for (int w = 0; w < 8; ++w) s += RED[(w * 3 + r) * 64 + l];
                MOD[r * 6144 + n0 + l] = s; }
            __syncthreads();
        }
    }
    {
        LAS float* scr = (LAS float*)(F.lds + F.wave * 17408);
        const int w0 = F.G >= 192 ? 96 : 0;
        const int gw = (F.wg - w0) * NWAVES + F.wave, NGW = (F.G - w0) * NWAVES;
        constexpr int I_IN = 16 * 49, I_OUT = 16 * 16;
        for (int it = F.wg >= w0 ? gw : I_IN + I_OUT; it < I_IN + I_OUT; it += NGW) {
            int r = it;
            if (r < I_IN) { if (P2_FP8) tr_item8g(F.in[7], NPROJ_SRC, (r / 49) * 64, (r % 49) * 64, WSP(unsigned char, WS_WINT), MapIn{}, scr, F.lane); else tr_item(F.in[7], NPROJ_SRC, (r / 49) * 64, (r % 49) * 64, WSP(bf16, WS_WINT), MapIn{}, scr, F.lane); continue; } r -= I_IN;
            tr_item(F.in[16], 1024, (r / 16) * 64, (r % 16) * 64, WSP(bf16, WS_WOUTT), MapId{}, scr, F.lane);
        }
    }
    {
        const int w0 = F.G >= 192 ? 96 : 0; const int NGT = (F.G - w0) * NTHR, gt = F.wg >= w0 ? (F.wg - w0) * NTHR + F.tid : (1 << 30);
        float* WRT = WSP(float, WS_WRT); const float* rw = F.in[17];
        for (int i = gt; i < NE * 1024; i += NGT) { const int e = i >> 10, k = i & 1023; WRT[i] = rw[k * NE + e]; }
        float* BG = WSP(float, WS_BGUP); const float* bgu = F.in[20]; MapGu8 mg;
        for (int i = gt; i < NE * 2048; i += NGT) { const int e = i >> 11, s = i & 2047; BG[e * 2048 + mg(s)] = bgu[i] + ((s & 1) ? 1.f : 0.f); }
        u32x4* z = P2_FP8 ? (u32x4*)(WSP(unsigned char, WS_WINT) + (size_t)NPROJ_SRC * 1024) : (u32x4*)(WSP(bf16, WS_WINT) + (size_t)NPROJ_SRC * 1024);
        for (int i = gt; i < (NPROJ - NPROJ_SRC) * 1024 / (P2_FP8 ? 16 : 8); i += NGT) z[i] = (u32x4){0u, 0u, 0u, 0u};
    }
}

__device__ __forceinline__ void p4_convert(const Fr& F, int worker, int nworkers, int it_lo, int it_hi) {
    LAS float* scr = (LAS float*)(F.lds + F.wave * 17408);
    const int gw = worker * NWAVES + F.wave, NGW = nworkers * NWAVES;
    constexpr int I_GU = NE * 16 * 32, I_DN = NE * 16 * 16;
    for (int it = it_lo + gw; it < it_hi; it += NGW) {
        int r = it;
        if (r < I_GU) { const int e = r / 512, rr = r % 512; tr_item8(F.in[19] + (size_t)e * 1024 * 2048, 2048, (rr / 32) * 64, (rr % 32) * 64, WSP(unsigned char, WS_WGUT) + (size_t)e * 2048 * 1024, MapGu8{}, scr, F.lane); continue; } r -= I_GU;
        { const int e = r / 256, rr = r % 256; tr_item8(F.in[21] + (size_t)e * 1024 * 1024, 1024, (rr / 16) * 64, (rr % 16) * 64, WSP(unsigned char, WS_WDT) + (size_t)e * 1024 * 1024, MapDn8{}, scr, F.lane); }
    }
}
struct CvItem { const float* W; unsigned char* WT; int N, k0, n0; bool gu; };
__device__ __forceinline__ CvItem cv_item(const Fr& F, int it) {
    constexpr int I_GU = NE * 16 * 32; CvItem c;
    if (it < I_GU) { const int e = it / 512, rr = it % 512; c.W = F.in[19] + (size_t)e * 1024 * 2048; c.N = 2048; c.k0 = (rr / 32) * 64; c.n0 = (rr % 32) * 64; c.WT = WSP(unsigned char, WS_WGUT) + (size_t)e * 2048 * 1024; c.gu = true; }
    else { const int r = it - I_GU, e = r / 256, rr = r % 256; c.W = F.in[21] + (size_t)e * 1024 * 1024; c.N = 1024; c.k0 = (rr / 16) * 64; c.n0 = (rr % 16) * 64; c.WT = WSP(unsigned char, WS_WDT) + (size_t)e * 1024 * 1024; c.gu = false; }
    return c;
}
__device__ __forceinline__ void cv_load(const CvItem& c, f32x4 (&v)[16], int lane) {
    const int cq = lane & 15, rq = lane >> 4;
#pragma unroll
    for (int i = 0; i < 16; ++i) v[i] = *(const f32x4*)(c.W + (size_t)(c.k0 + 4 * i + rq) * c.N + c.n0 + 4 * cq);
}
template <class RM> __device__ __forceinline__ void cv_finish(const CvItem& c, const f32x4 (&v)[16], RM rm, LAS float* scr, int lane) {
    const int cq = lane & 15, rq = lane >> 4;
#pragma unroll
    for (int i = 0; i < 16; ++i) *(LAS f32x4*)(scr + (4 * i + rq) * 68 + 4 * cq) = v[i];
    LDS_WAIT();
    const int cc = lane & 7;
#pragma unroll
    for (int j = 0; j < 8; ++j) { const int n = 8 * j + (lane >> 3); const LAS float* sp = scr + (8 * cc) * 68 + n;
        u32x2 o; o.x = pk_fp8x4(sp[0] * W8_SCALE, sp[68] * W8_SCALE, sp[136] * W8_SCALE, sp[204] * W8_SCALE); o.y = pk_fp8x4(sp[272] * W8_SCALE, sp[340] * W8_SCALE, sp[408] * W8_SCALE, sp[476] * W8_SCALE);
        *(u32x2*)(c.WT + (size_t)rm(c.n0 + n) * 1024 + c.k0 + 8 * cc) = o; }
    LDS_WAIT();
}
__device__ __forceinline__ void p4_convert2(const Fr& F, int worker, int nworkers, int it_lo, int it_hi) {
    LAS float* scr = (LAS float*)(F.lds + F.wave * 17408);
    const int gw = worker * NWAVES + F.wave, NGW = nworkers * NWAVES, lane = F.lane;
    for (int it = it_lo + gw; it < it_hi; it += 2 * NGW) {
        const int it2 = it + NGW; const bool two = it2 < it_hi;
        const CvItem c0 = cv_item(F, it), c1 = cv_item(F, two ? it2 : it);
        f32x4 v0[16], v1[16]; cv_load(c0, v0, lane); cv_load(c1, v1, lane);
        if (c0.gu) cv_finish(c0, v0, MapGu8{}, scr, lane); else cv_finish(c0, v0, MapDn8{}, scr, lane);
        if (two) { if (c1.gu) cv_finish(c1, v1, MapGu8{}, scr, lane); else cv_finish(c1, v1, MapDn8{}, scr, lane); }
    }
}
template <class SEAMFN> __device__ __forceinline__ void p1_norm(const Fr& F, SEAMFN seam) {
    const float* x = F.in[0]; const float* ctx = F.in[2]; const float* ng = F.in[6]; const float* MOD = WSP(float, WS_MOD); bf16* H = WSP(bf16, WS_HALL);
    const int gw = F.wg * NWAVES + F.wave, NGW = F.G * NWAVES, lane = F.lane;
    f32x4 cur[4][4], nxt[4][4];
#define P1_ROWS(blk_) ((blk_) * 4 < T ? x + (size_t)(blk_) * 4 * D : ctx + (size_t)((blk_) * 4 - T) * D)
    if (gw < TALL / 4) { const float* xb = P1_ROWS(gw);
#pragma unroll
        for (int i = 0; i < 4; ++i)
#pragma unroll
            for (int j = 0; j < 4; ++j) cur[i][j] = *(const f32x4*)(xb + (size_t)i * D + 256 * j + 4 * lane); }
    seam();
    for (int blk = gw; blk < TALL / 4; blk += NGW) {
        const int r0 = blk * 4; const int mi = r0 < T ? (r0 >> 14) : 2;
        const float* m0 = MOD + mi * 6144; const float* m1 = m0 + 1024;
        { const int bn = blk + NGW < TALL / 4 ? blk + NGW : blk; const float* xn = P1_ROWS(bn);
#pragma unroll
            for (int i = 0; i < 4; ++i)
#pragma unroll
                for (int j = 0; j < 4; ++j) nxt[i][j] = *(const f32x4*)(xn + (size_t)i * D + 256 * j + 4 * lane); }
        f32x4 sc[4], sh[4];
#pragma unroll
        for (int j = 0; j < 4; ++j) { const int k = 256 * j + 4 * lane; sc[j] = *(const f32x4*)(ng + k) * (*(const f32x4*)(m1 + k) + 1.f); sh[j] = *(const f32x4*)(m0 + k); }
#pragma unroll
        for (int i = 0; i < 4; ++i) {
            float ss = 0.f;
#pragma unroll
            for (int j = 0; j < 4; ++j) ss += (cur[i][j].x * cur[i][j].x + cur[i][j].y * cur[i][j].y) + (cur[i][j].z * cur[i][j].z + cur[i][j].w * cur[i][j].w);
            const float rstd = rsqrtf(wave_sum(ss) * (1.f / D) + EPS);
#pragma unroll
            for (int j = 0; j < 4; ++j) { const f32x4 h = cur[i][j] * rstd * sc[j] + sh[j];
                if (P2_FP8 == 1) *(unsigned*)((unsigned char*)H + (size_t)(r0 + i) * D + 256 * j + 4 * lane) = pk_fp8x4(h.x, h.y, h.z, h.w);
                else { u32x2 o; o.x = pk2(h.x, h.y); o.y = pk2(h.z, h.w); *(u32x2*)(H + (size_t)(r0 + i) * D + 256 * j + 4 * lane) = o; } }
        }
#pragma unroll
        for (int i = 0; i < 4; ++i)
#pragma unroll
            for (int j = 0; j < 4; ++j) cur[i][j] = nxt[i][j];
    }
#undef P1_ROWS
}

__device__ __forceinline__ void p3_prep(const Fr& F) {
    const bf16* P = WSP(bf16, WS_P); const float* convw = F.in[8]; const float* alog = F.in[9]; const float* dtb = F.in[10];
    LAS bf16* QL = (LAS bf16*)F.lds; LAS bf16* KL = QL + 64 * 136; LAS bf16* VL = KL + 64 * 136;
    LAS float* AM = (LAS float*)(F.lds + 52224); LAS float* XM = AM + 2 * 64 * 65; LAS bf16* AT = (LAS bf16*)(F.lds + 118784);
    LAS float* TMPW = (LAS float*)(F.lds + 137216); LAS float* GV = (LAS float*)(F.lds + 139392);
    u32x4 xa[3][6]; unsigned short gbb = 0, gaa = 0; float gdt = 0.f, gal = 0.f;
#define P3_ISSUE(u_, tid_) do { const int b_ = (u_) / (NCH * NH), rem_ = (u_) % (NCH * NH), cn_ = rem_ >> 2, h_ = rem_ & 3; int rb_, lo_, hi_; \
        if (cn_ < 4) { lo_ = T + b_ * CTXL; hi_ = lo_ + CTXL; rb_ = lo_ + cn_ * 64; } else { rb_ = b_ * SEQ + (cn_ - 4) * 64; lo_ = rb_; hi_ = rb_ + 64; } \
        _Pragma("unroll") for (int part_ = 0; part_ < 3; ++part_) { const int col_ = part_ * 512 + h_ * 128 + ((tid_) & 15) * 8; \
            _Pragma("unroll") for (int sub_ = 0; sub_ < 2; ++sub_) { const int row_ = rb_ + (sub_ << 5) + ((tid_) >> 4); const u32x4 zero_ = (u32x4){0u, 0u, 0u, 0u}; \
                xa[part_][sub_ * 3 + 1] = *(const u32x4*)(P + (size_t)row_ * NPROJ + col_); xa[part_][sub_ * 3 + 0] = zero_; xa[part_][sub_ * 3 + 2] = zero_; \
                if (row_ - 1 >= lo_) xa[part_][sub_ * 3 + 0] = *(const u32x4*)(P + (size_t)(row_ - 1) * NPROJ + col_); \
                if (row_ + 1 < hi_) xa[part_][sub_ * 3 + 2] = *(const u32x4*)(P + (size_t)(row_ + 1) * NPROJ + col_); } } \
        if (((tid_) >> 6) < 2) { const int wv_ = (tid_) >> 6, row_ = rb_ + ((tid_) & 63); gbb = P[(size_t)row_ * NPROJ + PC_BA + wv_ * 4 + h_]; gaa = P[(size_t)row_ * NPROJ + PC_BA + 8 + wv_ * 4 + h_]; gdt = dtb[wv_ * 4 + h_]; gal = alog[wv_ * 4 + h_]; } } while (0)
    if (F.wg < NB * NCH * NH) { int tid0 = F.tid; asm volatile("" : "+v"(tid0)); P3_ISSUE(F.wg, tid0); }
    for (int u = F.wg; u < NB * NCH * NH; u += F.G) {
        int tid = F.tid; asm volatile("" : "+v"(tid));
        const int lane = tid & 63, wave = __builtin_amdgcn_readfirstlane(tid >> 6), l16 = lane & 15, q4 = lane >> 4;
        const int b = u / (NCH * NH), rem = u % (NCH * NH), cn = rem >> 2, h = rem & 3;
        int rowbase, lo, hi;
        if (cn < 4) { lo = T + b * CTXL; hi = lo + CTXL; rowbase = lo + cn * 64; } else { rowbase = b * SEQ + (cn - 4) * 64; lo = rowbase; hi = rowbase + 64; }
        unsigned char* pu = F.ws + WS_PREP + (size_t)u * PREP_UNIT; float* vec = WSP(float, WS_VEC) + (size_t)u * 512;
        f32x4 cwc[6], cwn[6];
#define P3_LOADW(WD, part_) do { const int cg_ = tid & 15, col_ = (part_) * 512 + h * 128 + cg_ * 8; \
            _Pragma("unroll") for (int hh_ = 0; hh_ < 2; ++hh_) { WD[hh_ * 3 + 0] = *(const f32x4*)(convw + col_ + 4 * hh_); WD[hh_ * 3 + 1] = *(const f32x4*)(convw + 1536 + col_ + 4 * hh_); WD[hh_ * 3 + 2] = *(const f32x4*)(convw + 3072 + col_ + 4 * hh_); } } while (0)
        P3_LOADW(cwc, 0);
#pragma unroll
        for (int part = 0; part < 3; ++part) {
            const int cg = tid & 15;
            u32x4 (&xc)[6] = xa[part];
            if (part < 2) P3_LOADW(cwn, part + 1);
#pragma unroll
            for (int sub = 0; sub < 2; ++sub) {
                const int i = (sub << 5) + (tid >> 4);
                const u32x4 xm = xc[sub * 3 + 0], x0 = xc[sub * 3 + 1], xp = xc[sub * 3 + 2];
                float val[8];
#pragma unroll
                for (int hh = 0; hh < 2; ++hh) {
                    const f32x4 w0 = cwc[hh * 3 + 0], w1 = cwc[hh * 3 + 1], w2 = cwc[hh * 3 + 2];
                    const unsigned m0 = hh ? xm.z : xm.x, m1 = hh ? xm.w : xm.y, c0 = hh ? x0.z : x0.x, c1 = hh ? x0.w : x0.y, p0 = hh ? xp.z : xp.x, p1 = hh ? xp.w : xp.y;
                    val[4 * hh + 0] = w0.x * bflo(m0) + w1.x * bflo(c0) + w2.x * bflo(p0);
                    val[4 * hh + 1] = w0.y * bfhi(m0) + w1.y * bfhi(c0) + w2.y * bfhi(p0);
                    val[4 * hh + 2] = w0.z * bflo(m1) + w1.z * bflo(c1) + w2.z * bflo(p1);
                    val[4 * hh + 3] = w0.w * bfhi(m1) + w1.w * bfhi(c1) + w2.w * bfhi(p1);
                }
                float ss = 0.f;
#pragma unroll
                for (int e = 0; e < 8; ++e) { val[e] = silu_(val[e]); ss += val[e] * val[e]; }
                if (part < 2) { ss = sum16(ss); const float sc = rsqrtf(ss + EPS) * (part == 0 ? 0.08838834764831845f : 1.f);
#pragma unroll
                    for (int e = 0; e < 8; ++e) val[e] *= sc; }
                u32x4 w; w.x = pk2(val[0], val[1]); w.y = pk2(val[2], val[3]); w.z = pk2(val[4], val[5]); w.w = pk2(val[6], val[7]);
                LAS bf16* dst = part == 0 ? QL : (part == 1 ? KL : VL);
                *(LAS u32x4*)(dst + i * 136 + cg * 8) = w;
                if (part < 2) { const int rb = (part == 0 ? 4 : 0) + (i >> 4), ks = cg >> 2, ln = (i & 15) + 16 * (cg & 3);
                    *(u32x4*)(pu + PO_KQ + ((rb * 4 + ks) * 64 + ln) * 16) = w; }
            }
#pragma unroll
            for (int e = 0; e < 6; ++e) cwc[e] = cwn[e];
        }
#undef P3_LOADW
        if (wave < 2) {
            const int d = wave, row = rowbase + lane;
            const float bb = bf2f(gbb), aa = bf2f(gaa); (void)row;
            const float beta = sigm(bb), xx = aa + gdt;
            const float sp = xx > 20.f ? xx : __logf(1.f + __expf(xx));
            float Gc = -__expf(gal) * sp;
#pragma unroll
            for (int o = 1; o < 64; o <<= 1) { const float up = __shfl_up(Gc, o), dn = __shfl_down(Gc, o);
                if (d == 0) { if (lane >= o) Gc += up; } else { if (lane + o < 64) Gc += dn; } }
            const float glast = __shfl(Gc, d == 0 ? 63 : 0);
            GV[d * 64 + lane] = Gc; GV[128 + d * 64 + lane] = beta;
            float* vd = vec + d * 256;
            vd[lane] = __expf(Gc); vd[64 + lane] = beta; vd[128 + lane] = __expf(glast - Gc); vd[192 + lane] = __expf(glast);
        }
        __syncthreads();
#pragma unroll
        for (int jj = 0; jj < 4; ++jj) {
            const int job = wave * 4 + jj, mat = job >> 4, ti = (job >> 2) & 3, tj = job & 3;
            const LAS bf16* Ap = (mat == 0 ? KL : QL) + (ti * 16 + l16) * 136 + q4 * 8;
            const LAS bf16* Bp = KL + (tj * 16 + l16) * 136 + q4 * 8;
            f32x4 acc = (f32x4){0.f, 0.f, 0.f, 0.f};
#pragma unroll
            for (int ks = 0; ks < 4; ++ks) acc = __builtin_amdgcn_mfma_f32_16x16x32_bf16(*(const LAS bf16x8*)(Ap + ks * 32), *(const LAS bf16x8*)(Bp + ks * 32), acc, 0, 0, 0);
            const int j = tj * 16 + l16;
#pragma unroll
            for (int d = 0; d < 2; ++d) {
                const float Gj = GV[d * 64 + j];
#pragma unroll
                for (int r = 0; r < 4; ++r) { const int i = ti * 16 + 4 * q4 + r; const float Gi = GV[d * 64 + i];
                    const float dec = __expf(fminf(Gi - Gj, 0.f));
                    if (mat == 0) { const bool ok = d == 0 ? (j < i) : (j > i); const float v = ok ? GV[128 + d * 64 + i] * acc[r] * dec : 0.f;
                        const int ii = d == 0 ? i : 63 - i, jx = d == 0 ? j : 63 - j; AM[d * 4160 + ii * 65 + jx] = v; }
                    else { const bool ok = d == 0 ? (j <= i) : (j >= i); const float v = ok ? acc[r] * dec : 0.f; AT[d * 4608 + i * 72 + j] = (bf16)(pk2(v, 0.f) & 0xffffu); }
                }
            }
        }
        __syncthreads();
        { const int un = u + F.G < NB * NCH * NH ? u + F.G : u; P3_ISSUE(un, tid); }
        if (wave < 2) {
            const int d = wave; LAS float* A = AM + d * 4160; LAS float* X = XM + d * 4160; LAS float* TW = TMPW + d * 272;
            for (int r = 0; r < 64; ++r) X[r * 65 + lane] = 0.f;
            LDS_WAIT();
            { const int blk = q4, c = l16; const LAS float* Ab = A + (blk * 16) * 65 + blk * 16; float xv[16];
#pragma unroll
                for (int r = 0; r < 16; ++r) { float s = (r == c) ? 1.f : 0.f;
#pragma unroll
                    for (int m = 0; m < r; ++m) s -= Ab[r * 65 + m] * xv[m];
                    xv[r] = s; }
#pragma unroll
                for (int r = 0; r < 16; ++r) X[(blk * 16 + r) * 65 + blk * 16 + c] = xv[r];
            }
            LDS_WAIT();
#pragma unroll
            for (int dd = 1; dd <= 3; ++dd)
#pragma unroll
                for (int a = dd; a <= 3; ++a) { const int bq = a - dd;
                    f32x4 acc = (f32x4){0.f, 0.f, 0.f, 0.f};
#pragma unroll
                    for (int cc2 = bq; cc2 < a; ++cc2)
#pragma unroll
                        for (int kk = 0; kk < 4; ++kk) { const float av = A[(a * 16 + l16) * 65 + cc2 * 16 + 4 * kk + q4], bv = X[(cc2 * 16 + 4 * kk + q4) * 65 + bq * 16 + l16];
                            acc = __builtin_amdgcn_mfma_f32_16x16x4f32(av, bv, acc, 0, 0, 0); }
#pragma unroll
                    for (int r = 0; r < 4; ++r) TW[(4 * q4 + r) * 17 + l16] = acc[r];
                    LDS_WAIT();
                    f32x4 acc2 = (f32x4){0.f, 0.f, 0.f, 0.f};
#pragma unroll
                    for (int kk = 0; kk < 4; ++kk) { const float av = X[(a * 16 + l16) * 65 + a * 16 + 4 * kk + q4], bv = TW[(4 * kk + q4) * 17 + l16];
                        acc2 = __builtin_amdgcn_mfma_f32_16x16x4f32(av, bv, acc2, 0, 0, 0); }
#pragma unroll
                    for (int r = 0; r < 4; ++r) X[(a * 16 + 4 * q4 + r) * 65 + bq * 16 + l16] = -acc2[r];
                    LDS_WAIT();
                }
        } else {
            const int t6 = tid - 128;
            for (int idx = t6; idx < 1024; idx += 384) { const int d = idx >> 9, e = idx & 511, rb = e >> 7, ks = (e >> 6) & 1, ln = e & 63, i = rb * 16 + (ln & 15), j0 = ks * 32 + (ln >> 4) * 8;
                *(u32x4*)(pu + PO_A + d * 8192 + e * 16) = *(const LAS u32x4*)(AT + d * 4608 + i * 72 + j0); }
            for (int e = t6; e < 1024; e += 384) { const int mb = e >> 7, ks = (e >> 6) & 1, ln = e & 63, m = mb * 16 + (ln & 15), kk0 = ks * 32 + (ln >> 4) * 8;
                unsigned short kv[8];
#pragma unroll
                for (int jj = 0; jj < 8; ++jj) kv[jj] = KL[(kk0 + jj) * 136 + m];
                u32x4 w; w.x = kv[0] | ((unsigned)kv[1] << 16); w.y = kv[2] | ((unsigned)kv[3] << 16); w.z = kv[4] | ((unsigned)kv[5] << 16); w.w = kv[6] | ((unsigned)kv[7] << 16);
                *(u32x4*)(pu + PO_KT + e * 16) = w; }
            for (int e = t6; e < 2048; e += 384) { const int nt = e >> 8, rb = (e >> 6) & 3, ln = e & 63, col = nt * 16 + (ln & 15), row0 = rb * 16 + 4 * (ln >> 4);
                const unsigned v0 = VL[(row0 + 0) * 136 + col], v1 = VL[(row0 + 1) * 136 + col], v2 = VL[(row0 + 2) * 136 + col], v3 = VL[(row0 + 3) * 136 + col];
                u32x2 w; w.x = v0 | (v1 << 16); w.y = v2 | (v3 << 16);
                *(u32x2*)(pu + PO_V + e * 8) = w; }
        }
        __syncthreads();
#pragma unroll
        for (int rep = 0; rep < 2; ++rep) { const int idx = rep * NTHR + tid, d = idx >> 9, e = idx & 511, rb = e >> 7, ks = (e >> 6) & 1, ln = e & 63, i = rb * 16 + (ln & 15), j0 = ks * 32 + (ln >> 4) * 8;
            float tv[8];
#pragma unroll
            for (int jj = 0; jj < 8; ++jj) tv[jj] = d == 0 ? XM[i * 65 + j0 + jj] : XM[4160 + (63 - i) * 65 + (63 - (j0 + jj))];
            u32x4 w; w.x = pk2(tv[0], tv[1]); w.y = pk2(tv[2], tv[3]); w.z = pk2(tv[4], tv[5]); w.w = pk2(tv[6], tv[7]);
            *(u32x4*)(pu + PO_T + d * 8192 + e * 16) = w;
        }
        __syncthreads();
    }
}

constexpr int SNT = 8;
constexpr int SROW = 144, TROWS = 80;
constexpr size_t WS_SLOC = WS_R1 + 212 * MiB, WS_PMAT = WS_SLOC + 16 * MiB, WS_SST = WS_PMAT + 16 * MiB;
__device__ __forceinline__ int sb_lo(int j) { return j < 4 ? 17 * j : 68 + 16 * (j - 4); }
struct ScanRegs { bf16x8 kqA[4], kqB[4]; bf16x8 kt[2], ta[2]; f32x4 eg; float gl; u32x2 vv[SNT]; f32x4 be, kd; };
struct ScanAddr { const unsigned char* pu; const float* vd; };
__device__ __forceinline__ ScanAddr scan_addr(const unsigned char* ws, int d, int b, int h, int s) {
    const int cn = d == 0 ? s : (s < 4 ? 3 - s : 263 - s);
    const int u = (b * NCH + cn) * NH + h;
    ScanAddr a; a.pu = ws + WS_PREP + (size_t)u * PREP_UNIT; a.vd = (const float*)(ws + WS_VEC) + (size_t)u * 512 + d * 256; return a;
}
template <bool OUT> __device__ __forceinline__ void ld_kq(bf16x8 (&kq)[4], const ScanAddr& a, int w, int lane) {
    const int rb = OUT ? w : (w & 3);
#pragma unroll
    for (int ks = 0; ks < 4; ++ks) kq[ks] = *(const bf16x8*)(a.pu + PO_KQ + ((rb * 4 + ks) * 64 + lane) * 16);
}
template <bool HASV, bool OUT> __device__ __forceinline__ void ld_p1(ScanRegs& R, const ScanAddr& a, int w, int lane) {
    const int r0 = 16 * (w & 3) + 4 * (lane >> 4);
    R.eg = *(const f32x4*)(a.vd + r0); R.be = *(const f32x4*)(a.vd + 64 + r0);
    if (HASV) { const int nt0 = OUT ? 0 : 4 * (w >> 2);
#pragma unroll
        for (int i = 0; i < (OUT ? SNT : SNT / 2); ++i) R.vv[i] = *(const u32x2*)(a.pu + PO_V + (((nt0 + i) * 4 + (w & 3)) * 64 + lane) * 8); }
}
template <bool OUT> __device__ __forceinline__ void ld_ta(ScanRegs& R, const ScanAddr& a, int d, int w, int lane) {
    const int tao = ((OUT && w >= 4) ? PO_A : PO_T) + d * 8192;
#pragma unroll
    for (int ks = 0; ks < 2; ++ks) R.ta[ks] = *(const bf16x8*)(a.pu + tao + (((w & 3) * 2 + ks) * 64 + lane) * 16);
}
__device__ __forceinline__ void ld_p3(ScanRegs& R, const ScanAddr& a, int w, int lane) {
#pragma unroll
    for (int ks = 0; ks < 2; ++ks) R.kt[ks] = *(const bf16x8*)(a.pu + PO_KT + ((w * 2 + ks) * 64 + lane) * 16);
    R.gl = a.vd[192];
}
template <bool HASV, bool OUT, int PAR>
__device__ __forceinline__ void scan_step(ScanRegs& R, f32x4 (&S)[SNT], LAS bf16* ST, LAS bf16* TT, LAS bf16* VN, LAS bf16* VS, bf16* Od, int col0,
                                          const unsigned char* ws, int d, int b, int h, int s, int s1, int w, int lane) {
    constexpr int NTW = OUT ? SNT : SNT / 2;
    const int l16 = lane & 15, q4 = lane >> 4, rowo = 16 * (w & 3) + 4 * q4, nt0 = OUT ? 0 : 4 * (w >> 2);
    const bool kwave = !OUT || w < 4;
    const int sn1 = s + 1 < s1 ? s + 1 : s1 - 1, sn2 = s + 2 < s1 ? s + 2 : s1 - 1;
    const ScanAddr a1 = scan_addr(ws, d, b, h, sn1);
    bf16x8 (&kq)[4] = PAR ? R.kqB : R.kqA;
    bf16x8 fb[2][8];
    f32x4 a1v[NTW];
    {
#define RD1(c_) do { _Pragma("unroll") for (int i_ = 0; i_ < 8; ++i_) fb[(c_) & 1][i_] = *(const LAS bf16x8*)(ST + ((nt0 + 2 * (c_) + (i_ >> 2)) * 16 + l16) * SROW + (i_ & 3) * 32 + q4 * 8); } while (0)
        RD1(0);
#pragma unroll
        for (int c = 0; c < NTW / 2; ++c) {
            if (c + 1 < NTW / 2) RD1(c + 1);
            __builtin_amdgcn_sched_barrier(0);
#pragma unroll
            for (int j = 0; j < 2; ++j) { f32x4 acc = (f32x4){0.f, 0.f, 0.f, 0.f};
#pragma unroll
                for (int ks = 0; ks < 4; ++ks) acc = __builtin_amdgcn_mfma_f32_16x16x32_bf16(kq[ks], fb[c & 1][j * 4 + ks], acc, 0, 0, 0);
                a1v[2 * c + j] = acc; }
            __builtin_amdgcn_sched_barrier(0);
        }
#undef RD1
    }
    if (kwave) {
#pragma unroll
        for (int i = 0; i < NTW; ++i) { f32x4 t;
            if (HASV) { const f32x4 v = (f32x4){bflo(R.vv[i].x), bfhi(R.vv[i].x), bflo(R.vv[i].y), bfhi(R.vv[i].y)}; t = R.be * (v - R.eg * a1v[i]); }
            else t = R.be * (R.eg * a1v[i]) * -1.f;
            u32x2 pw; pw.x = pk2(t.x, t.y); pw.y = pk2(t.z, t.w); *(LAS u32x2*)(TT + ((nt0 + i) * 16 + l16) * TROWS + rowo) = pw; }
    } else {
#pragma unroll
        for (int i = 0; i < NTW; ++i) a1v[i] = R.eg * a1v[i];
    }
    { const ScanAddr a2 = scan_addr(ws, d, b, h, sn2); ld_kq<OUT>(kq, a2, w, lane); ld_p1<HASV, OUT>(R, a1, w, lane); }
    __syncthreads();
#define RD2(BUF, t0_, c_) do { _Pragma("unroll") for (int i_ = 0; i_ < 8; ++i_) fb[(c_) & 1][i_] = *(const LAS bf16x8*)(BUF + (((t0_) + 4 * (c_) + (i_ >> 1)) * 16 + l16) * TROWS + (i_ & 1) * 32 + q4 * 8); } while (0)
    if (kwave) {
        RD2(TT, nt0, 0);
#pragma unroll
        for (int c = 0; c < NTW / 4; ++c) {
            if (c + 1 < NTW / 4) RD2(TT, nt0, c + 1);
            __builtin_amdgcn_sched_barrier(0);
#pragma unroll
            for (int j = 0; j < 4; ++j) { const int nt = nt0 + 4 * c + j; f32x4 vn = (f32x4){0.f, 0.f, 0.f, 0.f};
#pragma unroll
                for (int ks = 0; ks < 2; ++ks) vn = __builtin_amdgcn_mfma_f32_16x16x32_bf16(R.ta[ks], fb[c & 1][j * 2 + ks], vn, 0, 0, 0);
                const f32x4 vs = R.kd * vn;
                u32x2 pw; pw.x = pk2(vn.x, vn.y); pw.y = pk2(vn.z, vn.w); *(LAS u32x2*)(VN + (nt * 16 + l16) * TROWS + rowo) = pw;
                u32x2 ps; ps.x = pk2(vs.x, vs.y); ps.y = pk2(vs.z, vs.w); *(LAS u32x2*)(VS + (nt * 16 + l16) * TROWS + rowo) = ps; }
            __builtin_amdgcn_sched_barrier(0);
        }
        ld_ta<OUT>(R, a1, d, w, lane); R.kd = *(const f32x4*)(a1.vd + 128 + rowo);
    }
    __syncthreads();
    if (!kwave) {
        RD2(VN, 0, 0);
#pragma unroll
        for (int c = 0; c < 2; ++c) {
            if (c + 1 < 2) RD2(VN, 0, c + 1);
            __builtin_amdgcn_sched_barrier(0);
#pragma unroll
            for (int j = 0; j < 4; ++j) { const int nt = 4 * c + j;
#pragma unroll
                for (int ks = 0; ks < 2; ++ks) a1v[nt < NTW ? nt : 0] = __builtin_amdgcn_mfma_f32_16x16x32_bf16(R.ta[ks], fb[c & 1][j * 2 + ks], a1v[nt < NTW ? nt : 0], 0, 0, 0); }
            __builtin_amdgcn_sched_barrier(0);
        }
        ld_ta<OUT>(R, a1, d, w, lane);
    }
    RD2(VS, 0, 0);
#pragma unroll
    for (int c = 0; c < 2; ++c) {
        if (c + 1 < 2) RD2(VS, 0, c + 1);
        __builtin_amdgcn_sched_barrier(0);
#pragma unroll
        for (int j = 0; j < 4; ++j) { const int nt = 4 * c + j; f32x4 sv = S[nt] * R.gl;
#pragma unroll
            for (int ks = 0; ks < 2; ++ks) sv = __builtin_amdgcn_mfma_f32_16x16x32_bf16(R.kt[ks], fb[c & 1][j * 2 + ks], sv, 0, 0, 0);
            S[nt] = sv;
            u32x2 pw; pw.x = pk2(sv.x, sv.y); pw.y = pk2(sv.z, sv.w); *(LAS u32x2*)(ST + (nt * 16 + l16) * SROW + 16 * w + 4 * q4) = pw; }
        __builtin_amdgcn_sched_barrier(0);
    }
#undef RD2
    ld_p3(R, a1, w, lane);
    if (OUT && w >= 4 && s >= 4) {
        const int n = d == 0 ? s - 4 : 259 - s, trow0 = b * SEQ + n * 64;
        int ln_ = lane; asm volatile("" : "+v"(ln_));
        const int l16 = ln_ & 15, rowo = 16 * (w & 3) + 4 * (ln_ >> 4);
#pragma unroll
        for (int nt = 0; nt < NTW; ++nt)
#pragma unroll
            for (int r = 0; r < 4; ++r) Od[(size_t)(trow0 + rowo + r) * 512 + col0 + nt * 16 + l16] = (bf16)(pk2(a1v[nt][r], 0.f) & 0xffffu); }
    __syncthreads();
}
template <int KIND>
__device__ __forceinline__ void scan_run(const Fr& F, int chain, int j) {
    int tid_ = F.tid; asm volatile("" : "+v"(tid_));
    const int d = chain >> 3, b = (chain >> 2) & 1, h = chain & 3, w = __builtin_amdgcn_readfirstlane(tid_ >> 6), lane = tid_ & 63, l16 = lane & 15, q4 = lane >> 4;
    LAS bf16* ST = (LAS bf16*)F.lds; LAS bf16* TT = ST + SNT * 16 * SROW; LAS bf16* VN = TT + SNT * 16 * TROWS; LAS bf16* VS = VN + SNT * 16 * TROWS;
    f32x4 S[SNT];
    const size_t sidx = ((size_t)chain * 16 + j) * 16384;
#pragma unroll
    for (int nt = 0; nt < SNT; ++nt) {
        if (KIND == 0) S[nt] = (f32x4){0.f, 0.f, 0.f, 0.f};
        else if (KIND == 1) { const int col = nt * 16 + l16;
#pragma unroll
            for (int r = 0; r < 4; ++r) S[nt][r] = (16 * w + 4 * q4 + r == col) ? 1.f : 0.f; }
        else S[nt] = j == 0 ? (f32x4){0.f, 0.f, 0.f, 0.f} : *(const f32x4*)(WSP(float, WS_SST) + sidx + ((nt * 8 + w) * 64 + lane) * 4);
        u32x2 pw; pw.x = pk2(S[nt].x, S[nt].y); pw.y = pk2(S[nt].z, S[nt].w); *(LAS u32x2*)(ST + (nt * 16 + l16) * SROW + 16 * w + 4 * q4) = pw; }
    __syncthreads();
    bf16* Od = WSP(bf16, WS_O) + (size_t)d * T * 512; const int col0 = h * 128;
    const int s0 = sb_lo(j), s1 = sb_lo(j + 1);
    ScanRegs R;
    { const ScanAddr a0 = scan_addr(F.ws, d, b, h, s0), a1 = scan_addr(F.ws, d, b, h, s0 + 1 < s1 ? s0 + 1 : s1 - 1);
        ld_kq<KIND == 2>(R.kqA, a0, w, lane); ld_p1<KIND != 1, KIND == 2>(R, a0, w, lane); ld_ta<KIND == 2>(R, a0, d, w, lane); R.kd = *(const f32x4*)(a0.vd + 128 + 16 * (w & 3) + 4 * q4); ld_p3(R, a0, w, lane);
        ld_kq<KIND == 2>(R.kqB, a1, w, lane); }
    for (int s = s0; s < s1; s += 2) {
        scan_step<KIND != 1, KIND == 2, 0>(R, S, ST, TT, VN, VS, Od, col0, F.ws, d, b, h, s, s1, w, lane);
        if (s + 1 < s1) scan_step<KIND != 1, KIND == 2, 1>(R, S, ST, TT, VN, VS, Od, col0, F.ws, d, b, h, s + 1, s1, w, lane);
    }
    if (KIND == 0) {
#pragma unroll
        for (int nt = 0; nt < SNT; ++nt) *(f32x4*)(WSP(float, WS_SLOC) + sidx + ((nt * 8 + w) * 64 + lane) * 4) = S[nt];
    } else if (KIND == 1) { bf16* Pm = WSP(bf16, WS_PMAT) + sidx;
#pragma unroll
        for (int nt = 0; nt < SNT; ++nt)
#pragma unroll
            for (int r = 0; r < 4; ++r) Pm[(16 * w + 4 * q4 + r) * 128 + nt * 16 + l16] = (bf16)(pk2(S[nt][r], 0.f) & 0xffffu);
    }
    __syncthreads();
}
__device__ __forceinline__ void scan_combine(const Fr& F, int cu) {
    const int chain = cu >> 3, nt = cu & 7, w = F.wave, lane = F.lane, l16 = lane & 15, q4 = lane >> 4;
    LAS bf16* ST = (LAS bf16*)F.lds;
    f32x4 S = (f32x4){0.f, 0.f, 0.f, 0.f};
    { u32x2 z; z.x = 0u; z.y = 0u; *(LAS u32x2*)(ST + l16 * SROW + 16 * w + 4 * q4) = z; }
    __syncthreads();
    bf16x8 pa[4][4]; f32x4 sl[4];
#define SC2_LOAD(k_, j_) do { const size_t si_ = ((size_t)chain * 16 + (j_)) * 16384; const bf16* Pm_ = WSP(bf16, WS_PMAT) + si_; \
        _Pragma("unroll") for (int ks = 0; ks < 4; ++ks) pa[k_][ks] = *(const bf16x8*)(Pm_ + (16 * w + l16) * 128 + ks * 32 + q4 * 8); \
        sl[k_] = *(const f32x4*)(WSP(float, WS_SLOC) + si_ + ((nt * 8 + w) * 64 + lane) * 4); } while (0)
    SC2_LOAD(0, 0); SC2_LOAD(1, 1); SC2_LOAD(2, 2); SC2_LOAD(3, 3);
    f32x4 SA[15];
#pragma unroll
    for (int j = 0; j < 15; ++j) { const int k = j & 3;
        f32x4 acc = sl[k];
#pragma unroll
        for (int ks = 0; ks < 4; ++ks) acc = __builtin_amdgcn_mfma_f32_16x16x32_bf16(pa[k][ks], *(const LAS bf16x8*)(ST + l16 * SROW + ks * 32 + q4 * 8), acc, 0, 0, 0);
        SA[j] = acc;
        if (j + 4 < 15) SC2_LOAD(k, j + 4);
        __syncthreads();
        { u32x2 pw; pw.x = pk2(acc.x, acc.y); pw.y = pk2(acc.z, acc.w); *(LAS u32x2*)(ST + l16 * SROW + 16 * w + 4 * q4) = pw; }
        __syncthreads();
    }
#pragma unroll
    for (int j = 0; j < 15; ++j) *(f32x4*)(WSP(float, WS_SST) + ((size_t)chain * 16 + j + 1) * 16384 + ((nt * 8 + w) * 64 + lane) * 4) = SA[j];
    (void)S;
#undef SC2_LOAD
}
__device__ __forceinline__ void p4_sgu(const Fr& F, int worker, int nworkers, int u_lo, int u_hi) {
    const bf16* P = WSP(bf16, WS_P); bf16* MIX = WSP(bf16, WS_MIX);
    const float* lng = F.in[12]; const float* lnb = F.in[13]; const float* sw = F.in[14]; const float* sb = F.in[15];
    LAS bf16* VT = (LAS bf16*)F.lds;
    for (int u = u_lo + worker; u < u_hi; u += nworkers) {
        int tid = F.tid; asm volatile("" : "+v"(tid));
        const int lane = tid & 63, wave = __builtin_amdgcn_readfirstlane(tid >> 6), l16 = lane & 15, q4 = lane >> 4;
        const int g = u & 3, ch = u >> 2, row00 = ch * 128;
#pragma unroll
        for (int it = 0; it < 4; ++it) { const int item = it * NTHR + tid, cg = item & 15, row = item >> 4;
            const u32x4 xv = *(const u32x4*)(P + (size_t)(row00 + row) * NPROJ + PC_V + g * 128 + cg * 8);
            float v[8]; v[0] = bflo(xv.x); v[1] = bfhi(xv.x); v[2] = bflo(xv.y); v[3] = bfhi(xv.y); v[4] = bflo(xv.z); v[5] = bfhi(xv.z); v[6] = bflo(xv.w); v[7] = bfhi(xv.w);
            float s = 0.f;
#pragma unroll
            for (int e = 0; e < 8; ++e) { v[e] = gelu_t(v[e]); s += v[e]; }
            const float mean = sum16(s) * (1.f / 128.f); float q = 0.f;
#pragma unroll
            for (int e = 0; e < 8; ++e) { v[e] -= mean; q += v[e] * v[e]; }
            const float rstd = rsqrtf(sum16(q) * (1.f / 128.f) + EPS);
#pragma unroll
            for (int e = 0; e < 8; ++e) { const int c = cg * 8 + e; const float y = v[e] * rstd * lng[g * 128 + c] + lnb[g * 128 + c]; VT[c * 136 + ((((row >> 3) ^ cg) << 3) | (row & 7))] = (bf16)(pk2(y, 0.f) & 0xffffu); }
        }
        __syncthreads();
        bf16x8 wf[4];
#pragma unroll
        for (int ks = 0; ks < 4; ++ks) { const float* wp = sw + (size_t)g * 16384 + (wave * 16 + l16) * 128 + ks * 32 + q4 * 8; const f32x4 a = *(const f32x4*)wp, bq = *(const f32x4*)(wp + 4);
            u32x4 t; t.x = pk2(a.x, a.y); t.y = pk2(a.z, a.w); t.z = pk2(bq.x, bq.y); t.w = pk2(bq.z, bq.w); wf[ks] = __builtin_bit_cast(bf16x8, t); }
        const int prow = wave * 16 + l16; const float bs = sb[g * 128 + prow];
        u32x2 uq[8];
#pragma unroll
        for (int ct = 0; ct < 8; ++ct) uq[ct] = *(const u32x2*)(P + (size_t)(row00 + prow) * NPROJ + PC_U + g * 128 + ct * 16 + 4 * q4);
#pragma unroll
        for (int ct = 0; ct < 8; ++ct) { f32x4 acc = (f32x4){0.f, 0.f, 0.f, 0.f};
#pragma unroll
            for (int ks = 0; ks < 4; ++ks) acc = __builtin_amdgcn_mfma_f32_16x16x32_bf16(*(const LAS bf16x8*)(VT + (ct * 16 + l16) * 136 + (((ks * 4 + q4) ^ (ct * 2 + (l16 >> 3))) << 3)), wf[ks], acc, 0, 0, 0);
            const int c0 = ct * 16 + 4 * q4;
            const u32x2 uv = uq[ct];
            const float o0 = gelu_t(bflo(uv.x)) * (acc[0] + bs), o1 = gelu_t(bfhi(uv.x)) * (acc[1] + bs), o2 = gelu_t(bflo(uv.y)) * (acc[2] + bs), o3 = gelu_t(bfhi(uv.y)) * (acc[3] + bs);
            u32x2 w; w.x = pk2(o0, o1); w.y = pk2(o2, o3); if (DBG_MODE == 3) w = (u32x2){0u, 0u}; *(u32x2*)(MIX + (size_t)(row00 + prow) * D + 512 + g * 128 + c0) = w; }
        __syncthreads();
    }
}

__device__ __forceinline__ void p5_gdn_out(const Fr& F) {
    const bf16* P = WSP(bf16, WS_P); const bf16* O = WSP(bf16, WS_O); bf16* MIX = WSP(bf16, WS_MIX); const float* gng = F.in[11];
    const int gw = F.wg * NWAVES + F.wave, NGW = F.G * NWAVES, lane = F.lane;
    const f32x4 g0 = *(const f32x4*)(gng + (lane & 15) * 8), g1 = *(const f32x4*)(gng + (lane & 15) * 8 + 4);
    const float gg[8] = {g0.x, g0.y, g0.z, g0.w, g1.x, g1.y, g1.z, g1.w};
    for (int blk = gw; blk < T / 16; blk += NGW) {
        const int t0 = blk * 16;
        u32x4 a = *(const u32x4*)(O + (size_t)t0 * 512 + lane * 8), bq = *(const u32x4*)(O + (size_t)(T + t0) * 512 + lane * 8), z = *(const u32x4*)(P + (size_t)t0 * NPROJ + PC_Z + lane * 8);
#pragma clang loop unroll(disable)
        for (int i = 0; i < 16; ++i) {
            const int t = t0 + i, tn = t0 + (i + 1 < 16 ? i + 1 : i);
            const u32x4 an = *(const u32x4*)(O + (size_t)tn * 512 + lane * 8), bn = *(const u32x4*)(O + (size_t)(T + tn) * 512 + lane * 8), zn = *(const u32x4*)(P + (size_t)tn * NPROJ + PC_Z + lane * 8);
            float o[8]; o[0] = bflo(a.x) + bflo(bq.x); o[1] = bfhi(a.x) + bfhi(bq.x); o[2] = bflo(a.y) + bflo(bq.y); o[3] = bfhi(a.y) + bfhi(bq.y);
            o[4] = bflo(a.z) + bflo(bq.z); o[5] = bfhi(a.z) + bfhi(bq.z); o[6] = bflo(a.w) + bflo(bq.w); o[7] = bfhi(a.w) + bfhi(bq.w);
            float ss = 0.f;
#pragma unroll
            for (int e = 0; e < 8; ++e) ss += o[e] * o[e];
            const float rstd = rsqrtf(sum16(ss) * (1.f / 128.f) + EPS);
            const float zz[8] = {bflo(z.x), bfhi(z.x), bflo(z.y), bfhi(z.y), bflo(z.z), bfhi(z.z), bflo(z.w), bfhi(z.w)};
            float r[8];
#pragma unroll
            for (int e = 0; e < 8; ++e) r[e] = o[e] * rstd * gg[e] * silu_(zz[e]);
            u32x4 w; w.x = pk2(r[0], r[1]); w.y = pk2(r[2], r[3]); w.z = pk2(r[4], r[5]); w.w = pk2(r[6], r[7]);
            if (DBG_MODE == 2) w = (u32x4){0u, 0u, 0u, 0u};
            *(u32x4*)(MIX + (size_t)t * D + lane * 8) = w;
            a = an; bq = bn; z = zn;
        }
    }
}

template <class SEAMFN> __device__ __forceinline__ void p7_mid(const Fr& F, SEAMFN seam) {
    const float* x = F.in[0]; const float* ng = F.in[6]; const float* MOD = WSP(float, WS_MOD); const bf16* R = WSP(bf16, WS_R); const float* rbias = F.in[18];
    bf16* X1 = WSP(bf16, WS_X1); unsigned char* H2 = WSP(unsigned char, WS_H2);
    LAS bf16* HI = (LAS bf16*)F.lds; LAS bf16* LO = HI + 16 * 1032; LAS float* PART = (LAS float*)(F.lds + 66048);
    LAS int* ENT_E = (LAS int*)(F.lds + 83968); LAS int* ENT_R = ENT_E + 1024; LAS int* CNT = ENT_R + 1024; LAS int* BASE = CNT + 32;
    const int tid = F.tid, lane = F.lane, wave = F.wave, l16 = lane & 15, q4 = lane >> 4;
    if (tid < 32) CNT[tid] = 0;
    { int* RT = WSP(int, WS_ROWTOK); const int per = (MAXROWS + F.G - 1) / F.G; for (int i = tid; i < per; i += NTHR) { const int r = F.wg * per + i; if (r < MAXROWS) RT[r] = 0; } }
    const int TPW = T / F.G, t0 = F.wg * TPW;
    LAS float* AV = (LAS float*)(F.lds + 92672); LAS float* BV = AV + 1024; LAS float* CV = BV + 1024;
    { const float* mb = MOD + (t0 >> 14) * 6144;
        for (int k = tid; k < 1024; k += NTHR) { AV[k] = mb[2048 + k] * ng[1024 + k]; BV[k] = ng[2048 + k] * (mb[4096 + k] + 1.f); CV[k] = mb[3072 + k]; } }
    const float my_rbias = rbias[tid & 31];
    bf16x8 wh[4][2], wl[4][2];
    { const float* WRT = WSP(float, WS_WRT);
#pragma unroll
        for (int ks = 0; ks < 4; ++ks)
#pragma unroll
            for (int nt = 0; nt < 2; ++nt) { const float* wp = WRT + (size_t)(nt * 16 + l16) * 1024 + wave * 128 + ks * 32 + q4 * 8; const f32x4 a = *(const f32x4*)wp, b = *(const f32x4*)(wp + 4);
                u32x4 h; h.x = pk2(a.x, a.y); h.y = pk2(a.z, a.w); h.z = pk2(b.x, b.y); h.w = pk2(b.z, b.w);
                u32x4 l; l.x = pk2(a.x - bflo(h.x), a.y - bfhi(h.x)); l.y = pk2(a.z - bflo(h.y), a.w - bfhi(h.y)); l.z = pk2(b.x - bflo(h.z), b.y - bfhi(h.z)); l.w = pk2(b.z - bflo(h.w), b.w - bfhi(h.w));
                wh[ks][nt] = __builtin_bit_cast(bf16x8, h); wl[ks][nt] = __builtin_bit_cast(bf16x8, l); } }
    __syncthreads();
    u32x2 rq[2][4], rn[2][4]; f32x4 xq[2][4], xn[2][4];
#define P7_LOAD(RQ, XQ, tile_) do { _Pragma("unroll") for (int sub_ = 0; sub_ < 2; ++sub_) { const int t_ = t0 + (tile_) * 16 + 2 * wave + sub_; \
        _Pragma("unroll") for (int j_ = 0; j_ < 4; ++j_) { RQ[sub_][j_] = *(const u32x2*)(R + (size_t)t_ * D + 256 * j_ + 4 * lane); XQ[sub_][j_] = *(const f32x4*)(x + (size_t)t_ * D + 256 * j_ + 4 * lane); } } } while (0)
#pragma unroll
    for (int sub_ = 0; sub_ < 2; ++sub_) { const int t_ = t0 + 2 * wave + sub_;
#pragma unroll
        for (int j_ = 0; j_ < 4; ++j_) xq[sub_][j_] = *(const f32x4*)(x + (size_t)t_ * D + 256 * j_ + 4 * lane); }
    seam();
#pragma unroll
    for (int sub_ = 0; sub_ < 2; ++sub_) { const int t_ = t0 + 2 * wave + sub_;
#pragma unroll
        for (int j_ = 0; j_ < 4; ++j_) rq[sub_][j_] = *(const u32x2*)(R + (size_t)t_ * D + 256 * j_ + 4 * lane); }
    for (int tile = 0; tile < TPW / 16; ++tile) {
        { const int tn = tile + 1 < TPW / 16 ? tile + 1 : tile; P7_LOAD(rn, xn, tn); }
        f32x4 hq[2][4];
#pragma unroll
        for (int sub = 0; sub < 2; ++sub) {
            f32x4 rv[4]; float ss = 0.f;
#pragma unroll
            for (int j = 0; j < 4; ++j) { const u32x2 rw = rq[sub][j]; rv[j] = (f32x4){bflo(rw.x), bfhi(rw.x), bflo(rw.y), bfhi(rw.y)};
                ss += (rv[j].x * rv[j].x + rv[j].y * rv[j].y) + (rv[j].z * rv[j].z + rv[j].w * rv[j].w); }
            const float rstd1 = rsqrtf(wave_sum(ss) * (1.f / D) + EPS);
            f32x4 xv[4]; float s2 = 0.f;
#pragma unroll
            for (int j = 0; j < 4; ++j) { const int k = 256 * j + 4 * lane; const f32x4 av = *(const LAS f32x4*)(AV + k);
                xv[j] = xq[sub][j] + av * (rv[j] * rstd1);
                s2 += (xv[j].x * xv[j].x + xv[j].y * xv[j].y) + (xv[j].z * xv[j].z + xv[j].w * xv[j].w); }
            const float rstd2 = rsqrtf(wave_sum(s2) * (1.f / D) + EPS);
#pragma unroll
            for (int j = 0; j < 4; ++j) { const int k = 256 * j + 4 * lane; const f32x4 bv = *(const LAS f32x4*)(BV + k), cv = *(const LAS f32x4*)(CV + k);
                hq[sub][j] = xv[j] * rstd2 * bv + cv; xq[sub][j] = xv[j]; }
        }
#pragma unroll
        for (int sub = 0; sub < 2; ++sub) { const int tr = 2 * wave + sub, t = t0 + tile * 16 + tr;
#pragma unroll
            for (int j = 0; j < 4; ++j) { const int k = 256 * j + 4 * lane; const f32x4 hv = hq[sub][j];
                { u32x2 x1w; x1w.x = pk2(xq[sub][j].x, xq[sub][j].y); x1w.y = pk2(xq[sub][j].z, xq[sub][j].w); *(u32x2*)(X1 + (size_t)t * D + k) = x1w; }
                u32x2 o; o.x = pk2(hv.x, hv.y); o.y = pk2(hv.z, hv.w); *(unsigned*)(H2 + (size_t)t * D + k) = pk_fp8x4(hv.x, hv.y, hv.z, hv.w);
                u32x2 lo; lo.x = pk2(hv.x - bflo(o.x), hv.y - bfhi(o.x)); lo.y = pk2(hv.z - bflo(o.y), hv.w - bfhi(o.y));
                *(LAS u32x2*)(HI + tr * 1032 + k) = o; *(LAS u32x2*)(LO + tr * 1032 + k) = lo; } }
        __syncthreads();
        { f32x4 acc[2]; acc[0] = (f32x4){0.f, 0.f, 0.f, 0.f}; acc[1] = acc[0];
#pragma unroll
            for (int ks = 0; ks < 4; ++ks) { const int ko = l16 * 1032 + wave * 128 + ks * 32 + q4 * 8;
                const bf16x8 ah = *(const LAS bf16x8*)(HI + ko), al = *(const LAS bf16x8*)(LO + ko);
#pragma unroll
                for (int nt = 0; nt < 2; ++nt) { acc[nt] = __builtin_amdgcn_mfma_f32_16x16x32_bf16(ah, wh[ks][nt], acc[nt], 0, 0, 0);
                    acc[nt] = __builtin_amdgcn_mfma_f32_16x16x32_bf16(al, wh[ks][nt], acc[nt], 0, 0, 0);
                    acc[nt] = __builtin_amdgcn_mfma_f32_16x16x32_bf16(ah, wl[ks][nt], acc[nt], 0, 0, 0); } }
#pragma unroll
            for (int nt = 0; nt < 2; ++nt)
#pragma unroll
                for (int r = 0; r < 4; ++r) PART[(wave * 16 + 4 * q4 + r) * 33 + nt * 16 + l16] = acc[nt][r]; }
        __syncthreads();
        { const int tok = tid >> 5, me = tid & 31, t = t0 + tile * 16 + tok;
            float logit = my_rbias;
#pragma unroll
            for (int w = 0; w < 8; ++w) logit += PART[(w * 16 + tok) * 33 + me];
            float tv[4]; int ti[4];
#pragma unroll
            for (int k = 0; k < 4; ++k) { float bv = logit; int bi = me;
#define P7_AMAX(OV, OI) do { const float ov_ = (OV); const int oi_ = (OI); const bool tk_ = (ov_ > bv) | ((ov_ == bv) & (oi_ < bi)); bv = tk_ ? ov_ : bv; bi = tk_ ? oi_ : bi; } while (0)
                P7_AMAX(DPP_MOV(bv, 0xB1), __builtin_amdgcn_update_dpp(0, bi, 0xB1, 0xf, 0xf, true));
                P7_AMAX(DPP_MOV(bv, 0x4E), __builtin_amdgcn_update_dpp(0, bi, 0x4E, 0xf, 0xf, true));
                P7_AMAX(DPP_MOV(bv, 0x124), __builtin_amdgcn_update_dpp(0, bi, 0x124, 0xf, 0xf, true));
                P7_AMAX(DPP_MOV(bv, 0x128), __builtin_amdgcn_update_dpp(0, bi, 0x128, 0xf, 0xf, true));
                P7_AMAX(__shfl_xor(bv, 16), __shfl_xor(bi, 16));
#undef P7_AMAX
                tv[k] = bv; ti[k] = bi; if (me == bi) logit = -3.0e38f; }
            const float e1 = __expf(tv[1] - tv[0]), e2 = __expf(tv[2] - tv[0]), e3 = __expf(tv[3] - tv[0]), inv = 1.f / (1.f + e1 + e2 + e3);
            if (me == 0) { const float gt[4] = {inv, e1 * inv, e2 * inv, e3 * inv}; float* TG = WSP(float, WS_TKGATE); const int tl = tile * 16 + tok;
#pragma unroll
                for (int k = 0; k < 4; ++k) { const int rk = atomicAdd((int*)&CNT[ti[k]], 1); ENT_E[tl * 4 + k] = ti[k]; ENT_R[tl * 4 + k] = rk; TG[(size_t)t * 4 + k] = gt[k]; } }
        }
#pragma unroll
        for (int sub = 0; sub < 2; ++sub)
#pragma unroll
            for (int j = 0; j < 4; ++j) { rq[sub][j] = rn[sub][j]; xq[sub][j] = xn[sub][j]; }
    }
#undef P7_LOAD
    __syncthreads();
    if (tid < 32) BASE[tid] = (int)__hip_atomic_fetch_add(WSP(unsigned, WS_CTL) + CW_GCNT + 64 * tid, (unsigned)CNT[tid], __ATOMIC_RELAXED, __HIP_MEMORY_SCOPE_AGENT);
    __syncthreads();
    int* TE = WSP(int, WS_TKE); int* TR = WSP(int, WS_TKRANK);
    for (int i = tid; i < TPW * 4; i += NTHR) { const int e = ENT_E[i]; TE[(size_t)t0 * 4 + i] = e; TR[(size_t)t0 * 4 + i] = BASE[e] + ENT_R[i]; }
}

__device__ __forceinline__ void moe_tables(const Fr& F) {
    LAS int* NPL = (LAS int*)(F.lds + LDS_TAB); LAS int* RB = NPL + 32; LAS int* NPAN = NPL + 64; LAS int* PEXP = NPL + 128;
    if (F.tid < 32) NPL[F.tid] = ((int)__hip_atomic_load(WSP(unsigned, WS_CTL) + CW_GCNT + 64 * F.tid, __ATOMIC_RELAXED, __HIP_MEMORY_SCOPE_AGENT) + 255) >> 8;
    __syncthreads();
    if (F.tid < 32) { int s = 0; for (int e = 0; e < F.tid; ++e) s += NPL[e]; RB[F.tid] = s * 256; if (F.tid == 31) NPAN[0] = s + NPL[31];
        const int np = NPL[F.tid]; for (int p = 0; p < np; ++p) if (s + p < MAXPAN) PEXP[s + p] = F.tid; }
    __syncthreads();
}
__device__ __forceinline__ void p8_permute(const Fr& F) {
    moe_tables(F);
    const LAS int* RB = (const LAS int*)(F.lds + LDS_TAB) + 32;
    const int* TE = WSP(int, WS_TKE); const int* TR = WSP(int, WS_TKRANK); int* TROW = WSP(int, WS_TKROW);
    int* RT = WSP(int, WS_ROWTOK);
    const int gw = F.wg * NWAVES + F.wave, NGW = F.G * NWAVES, lane = F.lane;
    for (int blk = gw; blk < T / 16; blk += NGW) {
        const size_t a0 = (size_t)blk * 64;
        const int e = TE[a0 + lane]; int row = RB[e] + TR[a0 + lane]; row = row < MAXROWS ? row : MAXROWS - 1;
        TROW[a0 + lane] = row; RT[row] = blk * 16 + (lane >> 2);
    }
}
struct MoeOrder {
    int nM, nN, nwg, G, c; const LAS int* pexp;
    __device__ __forceinline__ void init(int nM_, int nN_, int G_, int c_, const LAS int* pexp_) { nM = nM_; nN = nN_; nwg = nM * nN; G = G_; c = c_; pexp = pexp_; }
    __device__ __forceinline__ bool next(int i, pg8::Unit& u) const {
        const long L = (long)i * G + c; if (L >= nwg) return false;
        int wgid = (int)L; { const int q = nwg / pg8::NXCD, r = nwg % pg8::NXCD, xcd = wgid % pg8::NXCD, off = wgid / pg8::NXCD; wgid = (xcd < r ? xcd * (q + 1) : r * (q + 1) + (xcd - r) * q) + off; }
        const int nig = pg8::WGM * nN, gid = wgid / nig, fm = gid * pg8::WGM, gsz = (nM - fm) < pg8::WGM ? (nM - fm) : pg8::WGM;
        u.pm = fm + ((wgid % nig) % gsz); u.pn = pexp[u.pm] * nN + (wgid % nig) / gsz; return true;
    }
    __device__ __forceinline__ void a_ready(const pg8::Unit&) const {}
    __device__ __forceinline__ void done(const pg8::Unit&) const {}
};
struct EpiStore {
    static constexpr bool PERM = true, AFTER_DRAIN = false;
    bf16* O; int ldc;
    __device__ __forceinline__ void pre(const pg8::Unit&, int, int, int) const {}
    __device__ __forceinline__ void operator()(const pg8::f32x4 (&acc)[2][2][4][2], const pg8::Unit& u, int wr, int wc, int fr, int fq, int par) const {
        const int row0 = u.pm * 256 + wr * 64 + fr, col0 = u.pn * 256 + wc * 32 + 8 * fq;
#pragma unroll
        for (int ai = 0; ai < 2; ++ai)
#pragma unroll
            for (int m = 0; m < 4; ++m) { bf16* rowp = O + (size_t)(row0 + ai * 128 + m * 16) * ldc + col0;
#pragma unroll
                for (int bj = 0; bj < 2; ++bj) { const pg8::f32x4 v0 = acc[ai][bj][m][0], v1 = acc[ai][bj][m][1];
                    u32x4 w; w.x = pk2(v0[0], v0[1]); w.y = pk2(v0[2], v0[3]); w.z = pk2(v1[0], v1[1]); w.w = pk2(v1[2], v1[3]);
                    *(u32x4*)(rowp + bj * 128) = w; } }
    }
};
struct EpiStoreS {
    static constexpr bool PERM = true, AFTER_DRAIN = false;
    bf16* O; int ldc;
    __device__ __forceinline__ void pre(const pg8::Unit&, int, int, int) const {}
    __device__ __forceinline__ void operator()(const pg8::f32x4 (&acc)[2][2][4][2], const pg8::Unit& u, int wr, int wc, int fr, int fq, int par) const {
        const int row0 = u.pm * 256 + wr * 64 + fr, col0 = u.pn * 256 + wc * 32 + 8 * fq;
#pragma unroll
        for (int ai = 0; ai < 2; ++ai)
#pragma unroll
            for (int m = 0; m < 4; ++m) { bf16* rowp = O + (size_t)(row0 + ai * 128 + m * 16) * ldc + col0;
#pragma unroll
                for (int bj = 0; bj < 2; ++bj) { const pg8::f32x4 v0 = acc[ai][bj][m][0] * W8_INV, v1 = acc[ai][bj][m][1] * W8_INV;
                    u32x4 w; w.x = pk2(v0[0], v0[1]); w.y = pk2(v0[2], v0[3]); w.z = pk2(v1[0], v1[1]); w.w = pk2(v1[2], v1[3]);
                    *(u32x4*)(rowp + bj * 128) = w; } }
    }
};
template <int EMODE = 0>
struct EpiSwiGLUT {
    static constexpr bool PERM = false, AFTER_DRAIN = false;
    unsigned char* ACT; const float* bias; LAS float* le;
    __device__ __forceinline__ void pre(const pg8::Unit& u, int wid, int lane, int par) const { if (EMODE == 3) return;
        if (wid < 4) __builtin_amdgcn_global_load_lds((const unsigned*)(bias + (u.pn >> 3) * 2048 + (u.pn & 7) * 256 + wid * 64 + lane), (LAS unsigned*)(le + par * 512 + wid * 64), 4, 0, 0); }
    __device__ __forceinline__ void operator()(const pg8::f32x4 (&acc)[2][2][4][2], const pg8::Unit& u, int wr, int wc, int fr, int fq, int par) const {
        if (EMODE == 3) return;
        const int e = u.pn >> 3, pnl = u.pn & 7, row0 = u.pm * 256 + wr * 64 + fr;
        const LAS float* bb = le + par * 512 + wc * 32 + 4 * fq; (void)e;
        pg8::f32x4 bg[2], bu[2];
#pragma unroll
        for (int bj = 0; bj < 2; ++bj) { bg[bj] = *(const LAS pg8::f32x4*)(bb + bj * 128); bu[bj] = *(const LAS pg8::f32x4*)(bb + bj * 128 + 16); }
#pragma unroll
        for (int ai = 0; ai < 2; ++ai)
#pragma unroll
            for (int m = 0; m < 4; ++m) { float a[8];
#pragma unroll
                for (int bj = 0; bj < 2; ++bj) { const pg8::f32x4 gv = acc[ai][bj][m][0] * W8_INV + bg[bj], uv = acc[ai][bj][m][1] * W8_INV + bu[bj];
#pragma unroll
                    for (int j = 0; j < 4; ++j) { const float gt = fminf(gv[j], 7.f), up1 = __builtin_amdgcn_fmed3f(uv[j], -6.f, 8.f);
                        a[4 * bj + j] = up1 * gt * frcp(1.f + __builtin_amdgcn_exp2f(gt * (-1.702f * 1.4426950408889634f))); } }
                u32x2 w; w.x = pk_fp8x4_ns(a[0], a[1], a[2], a[3]); w.y = pk_fp8x4_ns(a[4], a[5], a[6], a[7]);
                *(u32x2*)(ACT + (size_t)(row0 + ai * 128 + m * 16) * D + pnl * 128 + wc * 32 + 8 * fq) = w; }
    }
};
typedef EpiSwiGLUT<0> EpiSwiGLU;
constexpr float Y8_SCALE = 4.f, Y8_INV = 1.f / 4.f;
template <int EMODE = 0>
struct EpiDownT {
    static constexpr bool PERM = true, AFTER_DRAIN = false;
    unsigned char* Y; const float* bias; const float* rowgate; LAS float* le;
    __device__ __forceinline__ void pre(const pg8::Unit& u, int wid, int lane, int par) const { if (EMODE == 3) return;
        if (wid >= 4) __builtin_amdgcn_global_load_lds((const unsigned*)(bias + (u.pn >> 2) * 1024 + (u.pn & 3) * 256 + (wid - 4) * 64 + lane), (LAS unsigned*)(le + par * 512 + wid * 64), 4, 0, 0); }
    __device__ __forceinline__ void operator()(const pg8::f32x4 (&acc)[2][2][4][2], const pg8::Unit& u, int wr, int wc, int fr, int fq, int par) const {
        if (EMODE == 3) return;
        const int e = u.pn >> 2, pnl = u.pn & 3, row0 = u.pm * 256 + wr * 64 + fr, col0 = pnl * 256 + wc * 64 + 16 * fq;
        pg8::f32x4 bv[2][2];
#pragma unroll
        for (int bj = 0; bj < 2; ++bj)
#pragma unroll
            for (int n = 0; n < 2; ++n) bv[bj][n] = *(const LAS pg8::f32x4*)(le + par * 512 + 256 + wc * 64 + 16 * fq + 8 * bj + 4 * n) * Y8_SCALE;
        (void)e;
        constexpr float SC = W8_INV * Y8_SCALE;
#pragma unroll
        for (int ai = 0; ai < 2; ++ai)
#pragma unroll
            for (int m = 0; m < 4; ++m) { const int row = row0 + ai * 128 + m * 16; unsigned char* rowp = Y + (size_t)row * D + col0;
                u32x4 w;
                { const pg8::f32x4 v0 = acc[ai][0][m][0] * SC + bv[0][0], v1 = acc[ai][0][m][1] * SC + bv[0][1]; w.x = pk_fp8x4(v0[0], v0[1], v0[2], v0[3]); w.y = pk_fp8x4(v1[0], v1[1], v1[2], v1[3]); }
                { const pg8::f32x4 v0 = acc[ai][1][m][0] * SC + bv[1][0], v1 = acc[ai][1][m][1] * SC + bv[1][1]; w.z = pk_fp8x4(v0[0], v0[1], v0[2], v0[3]); w.w = pk_fp8x4(v1[0], v1[1], v1[2], v1[3]); }
                *(u32x4*)rowp = w; }
    }
};
typedef EpiDownT<0> EpiDown;
__device__ __forceinline__ void p11_final(const Fr& F) {
    const float* ng = F.in[6]; const float* MOD = WSP(float, WS_MOD); const bf16* X1 = WSP(bf16, WS_X1); const unsigned char* Y = WSP(unsigned char, WS_Y); const int* TROW = WSP(int, WS_TKROW); const float* TG = WSP(float, WS_TKGATE);
    const int gw = F.wg * NWAVES + F.wave, NGW = F.G * NWAVES, lane = F.lane;
    typedef float f32x2_ __attribute__((ext_vector_type(2)));
    for (int blk = gw; blk < T / 16; blk += NGW) {
        const int t0 = blk * 16, b = t0 >> 14; const float* mb = MOD + b * 6144 + 5120;
        const int myrow = TROW[(size_t)t0 * 4 + lane]; const float myg = TG[(size_t)t0 * 4 + lane];
        f32x4 gm[4];
#pragma unroll
        for (int j = 0; j < 4; ++j) { const int k = 256 * j + 4 * lane; gm[j] = *(const f32x4*)(ng + 3072 + k) * *(const f32x4*)(mb + k); }
        int yq0[4][4], yq1[4][4]; u32x2 xq0[4], xq1[4];
#define P11_LOAD(YQ, XQ, tk_) do { _Pragma("unroll") for (int k_ = 0; k_ < 4; ++k_) { const int row_ = __builtin_amdgcn_readlane(myrow, 4 * (tk_) + k_); \
            _Pragma("unroll") for (int j_ = 0; j_ < 4; ++j_) YQ[k_][j_] = *(const int*)(Y + (size_t)row_ * D + 256 * j_ + 4 * lane); } \
            _Pragma("unroll") for (int j_ = 0; j_ < 4; ++j_) XQ[j_] = *(const u32x2*)(X1 + (size_t)(t0 + (tk_)) * D + 256 * j_ + 4 * lane); } while (0)
#define P11_DO(YQ, XQ, tk_) do { f32x4 y[4]; \
            _Pragma("unroll") for (int j = 0; j < 4; ++j) y[j] = (f32x4){0.f, 0.f, 0.f, 0.f}; \
            _Pragma("unroll") for (int k = 0; k < 4; ++k) { const float g_ = __builtin_bit_cast(float, __builtin_amdgcn_readlane(__builtin_bit_cast(int, myg), 4 * (tk_) + k)); \
                _Pragma("unroll") for (int j = 0; j < 4; ++j) { const int w = YQ[k][j]; const f32x2_ lo = __builtin_amdgcn_cvt_pk_f32_fp8(w, false), hi = __builtin_amdgcn_cvt_pk_f32_fp8(w, true); y[j] += g_ * (f32x4){lo.x, lo.y, hi.x, hi.y}; } } \
            float ss = 0.f; \
            _Pragma("unroll") for (int j = 0; j < 4; ++j) { y[j] = y[j] * Y8_INV; ss += (y[j].x * y[j].x + y[j].y * y[j].y) + (y[j].z * y[j].z + y[j].w * y[j].w); } \
            const float rstd = rsqrtf(wave_sum(ss) * (1.f / D) + EPS); \
            _Pragma("unroll") for (int j = 0; j < 4; ++j) { const int k = 256 * j + 4 * lane; const u32x2 xw = XQ[j]; const f32x4 x1 = (f32x4){bflo(xw.x), bfhi(xw.x), bflo(xw.y), bfhi(xw.y)}; \
                *(f32x4*)(F.out + (size_t)(t0 + (tk_)) * D + k) = (DBG_MODE >= 1) ? x1 : x1 + gm[j] * (y[j] * rstd); } } while (0)
        P11_LOAD(yq0, xq0, 0);
#pragma clang loop unroll(disable)
        for (int tk = 0; tk < 16; tk += 2) {
            P11_LOAD(yq1, xq1, tk + 1);
            P11_DO(yq0, xq0, tk);
            if (tk + 2 < 16) P11_LOAD(yq0, xq0, tk + 2);
            P11_DO(yq1, xq1, tk + 1);
        }
#undef P11_DO
#undef P11_LOAD
    }
}

struct Args { const float* in[23]; float* out; unsigned char* ws; int ph_lo, ph_hi; };
__global__ void __launch_bounds__(NTHR, 2) mk_fwd(Args args) {
    extern __shared__ __attribute__((aligned(16))) unsigned char lds_raw[];
    Fr F; F.lds = (LAS unsigned char*)lds_raw; F.ws = args.ws; F.out = args.out;
#pragma unroll
    for (int i = 0; i < 23; ++i) F.in[i] = args.in[i];
    F.tid = threadIdx.x; F.lane = F.tid & 63; F.wave = __builtin_amdgcn_readfirstlane(F.tid >> 6); F.wg = blockIdx.x; F.G = gridDim.x;
    volatile LAS unsigned* MISC = (volatile LAS unsigned*)(F.lds + LDS_MISC);
    if (F.tid < 16) MISC[F.tid] = 0u;
    __syncthreads();
    const int lo = args.ph_lo, hi = args.ph_hi;
    XcdBarrier bar; bar.bar = WSP(unsigned, WS_CTL) + CW_BAR; bar.x = 0; bar.st = nullptr;
    if (hi - lo > 1) bar = xcd_barrier_post(WSP(unsigned, WS_CTL) + CW_BAR, MISC + 8);
#define IN(k) (lo <= (k) && (k) < hi)
#define SEAM(k) do { if (IN(k) && IN((k) + 1)) xcd_barrier(bar); } while (0)
#define PH0 { p0_prologue(F); }
#define PH1 { p1_norm(F, [&]() { if (IN(0) && IN(1)) xcd_barrier(bar); }); }
#define PH2 { pg8::Gemm g{WSP(bf16, WS_HALL), WSP(bf16, WS_WINT), TALL, NPROJ, P2_FP8 ? D / 2 : D}; pg8::StaticOrder S; S.init(TALL, NPROJ, F.G, F.wg); \
        if (P2_FP8) { EpiStoreS E{WSP(bf16, WS_P), NPROJ}; pg8::gemm_phase<EpiStoreS, pg8::StaticOrder, true, true, true>(F.lds, g, S, E); } \
        else { EpiStore E{WSP(bf16, WS_P), NPROJ}; pg8::gemm_phase<EpiStore, pg8::StaticOrder, true, true>(F.lds, g, S, E); } \
        if (F.wg >= 154 && F.G == 256) p4_convert(F, F.wg - 154, 102, CV_A0, CV_A1); }
#define PH3 { p3_prep(F); if (F.wg >= 32 && F.G == 256) p4_convert(F, F.wg - 32, 224, CV_A1, CV_B1); }
#define PH4 {   \
        if (F.wg < 240) { scan_run<0>(F, F.wg / 15, F.wg % 15); scan_run<1>(F, F.wg / 15, F.wg % 15); } else if (F.G == 256) p4_convert(F, F.wg - 240, 16, CV_B1, CV_C1);        \
        xcd_barrier(bar); \
        if (F.wg < 128) { scan_combine(F, F.wg); if (F.G == 256) p4_sgu(F, F.wg, 128, 256, 384); } else { p4_sgu(F, F.wg - 128, F.G - 128, 0, 256); }        \
        xcd_barrier(bar); \
        if (F.wg < 256) scan_run<2>(F, F.wg >> 4, F.wg & 15); \
        p4_sgu(F, F.wg, F.G, F.G == 256 ? 384 : 256, NB * 128 * 4); p4_convert(F, F.wg, F.G, F.G == 256 ? CV_C1 : 0, CV_D0); }
#define PH5 { p5_gdn_out(F); }
#define PH6 { pg8::Gemm g{WSP(bf16, WS_MIX), WSP(bf16, WS_WOUTT), T, D, D}; pg8::StaticOrder S; S.init(T, D, F.G, F.wg); \
        EpiStore E{WSP(bf16, WS_R), D}; pg8::gemm_phase<EpiStore, pg8::StaticOrder, true, true>(F.lds, g, S, E); }
#define PH7 { p7_mid(F, [&]() { if (IN(6) && IN(7)) xcd_barrier(bar); }); }
#define PH8 { p8_permute(F); }
#define PH9 { if (!IN(8)) moe_tables(F);        \
        const LAS int* tab = (const LAS int*)(F.lds + LDS_TAB); const int npan = tab[64] < MAXPAN ? tab[64] : MAXPAN; \
        pg8::Gemm g{WSP(bf16, WS_H2), WSP(bf16, WS_WGUT), npan * 256, 2048, D / 2}; MoeOrder S; S.init(npan, 8, F.G, F.wg, tab + 128); \
        { LAS int* gm = (LAS int*)(F.lds + LDS_GMAP); const int* RT = WSP(int, WS_ROWTOK); pg8::Unit uu; \
            for (int i = 0; i < 17 && S.next(i, uu); ++i) if (F.tid < 256) gm[i * 256 + F.tid] = RT[uu.pm * 256 + F.tid]; \
            __syncthreads(); } \
        EpiSwiGLU E{WSP(unsigned char, WS_ACT), WSP(float, WS_BGUP), (LAS float*)(F.lds + LDS_EPI)}; pg8::gemm_phase<EpiSwiGLU, MoeOrder, true, true, true, true>(F.lds, g, S, E, (const LAS int*)(F.lds + LDS_GMAP)); \
        { Fr F2 = F; { int t_ = threadIdx.x; asm volatile("" : "+v"(t_)); F2.tid = t_; F2.lane = t_ & 63; }        \
            const int rem = (npan * 8) % F.G; if (rem == 0) p4_convert2(F2, F.wg, F.G, CV_D0, NE * 768); else if (F.wg >= rem) p4_convert2(F2, F.wg - rem, F.G - rem, CV_D0, NE * 768); } }
#define PH10 { moe_tables(F); const LAS int* tab = (const LAS int*)(F.lds + LDS_TAB); const int npan = tab[64] < MAXPAN ? tab[64] : MAXPAN; \
        pg8::Gemm g{WSP(bf16, WS_ACT), WSP(bf16, WS_WDT), npan * 256, 1024, D / 2}; MoeOrder S; S.init(npan, 4, F.G, F.wg, tab + 128); \
        EpiDown E{WSP(unsigned char, WS_Y), F.in[22], WSP(float, WS_ROWGATE), (LAS float*)(F.lds + LDS_EPI)}; pg8::gemm_phase<EpiDown, MoeOrder, true, true, true>(F.lds, g, S, E); }
#define RUN(k, BODY) do { if (IN(k)) BODY if (PROBE_TWICE == (k) && IN(k)) { xcd_barrier(bar); BODY } } while (0)
    RUN(0, PH0); if (!IN(1)) SEAM(0);
    RUN(1, PH1); SEAM(1);
    RUN(2, PH2); SEAM(2);
    RUN(3, PH3); SEAM(3);
    RUN(4, PH4);
    if (PROBE_TWICE == 46 && IN(4)) { xcd_barrier(bar); if (F.wg < 240) scan_run<0>(F, F.wg / 15, F.wg % 15); else if (F.wg < 256) scan_run<1>(F, (F.wg - 240) / 15, (F.wg - 240) % 15); if (F.wg < 224) scan_run<1>(F, (F.wg + 16) / 15, (F.wg + 16) % 15); }
    if (PROBE_TWICE == 47 && IN(4)) { xcd_barrier(bar); if (F.wg < 256) scan_run<2>(F, F.wg >> 4, F.wg & 15); }
    if (PROBE_TWICE == 48 && IN(4)) { xcd_barrier(bar); p4_convert(F, F.wg, F.G, CV_C1, CV_D0); }
    if (PROBE_TWICE == 49 && IN(4)) { xcd_barrier(bar); if (F.wg < 128) scan_combine(F, F.wg); }
    SEAM(4);
    RUN(5, PH5); SEAM(5);
    RUN(6, PH6); if (!IN(7)) SEAM(6);
    RUN(7, PH7); SEAM(7);
    RUN(8, PH8); SEAM(8);
    RUN(9, PH9);
#define PH9X(EM) { moe_tables(F); const LAS int* tab = (const LAS int*)(F.lds + LDS_TAB); const int npan = tab[64] < MAXPAN ? tab[64] : MAXPAN; \
        pg8::Gemm g{WSP(bf16, WS_H2), WSP(bf16, WS_WGUT), npan * 256, 2048, D / 2}; MoeOrder S; S.init(npan, 8, F.G, F.wg, tab + 128); \
        { LAS int* gm = (LAS int*)(F.lds + LDS_GMAP); const int* RT = WSP(int, WS_ROWTOK); pg8::Unit uu; \
            for (int i = 0; i < 17 && S.next(i, uu); ++i) if (F.tid < 256) gm[i * 256 + F.tid] = RT[uu.pm * 256 + F.tid]; \
            __syncthreads(); } \
        EpiSwiGLUT<EM> E{WSP(unsigned char, WS_Y), WSP(float, WS_BGUP), (LAS float*)(F.lds + LDS_EPI)}; pg8::gemm_phase<EpiSwiGLUT<EM>, MoeOrder, true, true, true, true>(F.lds, g, S, E, (const LAS int*)(F.lds + LDS_GMAP)); }
    if (PROBE_TWICE == 90 && IN(9)) { xcd_barrier(bar); PH9X(0) }
    if (PROBE_TWICE == 93 && IN(9)) { xcd_barrier(bar); PH9X(3) }
    SEAM(9);
    RUN(10, PH10);
#define PH10X(EM) { moe_tables(F); const LAS int* tab = (const LAS int*)(F.lds + LDS_TAB); const int npan = tab[64] < MAXPAN ? tab[64] : MAXPAN; \
        pg8::Gemm g{WSP(bf16, WS_ACT), WSP(bf16, WS_WDT), npan * 256, 1024, D / 2}; MoeOrder S; S.init(npan, 4, F.G, F.wg, tab + 128); \
        EpiDownT<EM> E{WSP(unsigned char, WS_R1) + 136 * MiB, F.in[22], WSP(float, WS_ROWGATE), (LAS float*)(F.lds + LDS_EPI)}; pg8::gemm_phase<EpiDownT<EM>, MoeOrder, true, true, true>(F.lds, g, S, E); }
    if (PROBE_TWICE == 100 && IN(10)) { xcd_barrier(bar); PH10X(0) }
    if (PROBE_TWICE == 101 && IN(10)) { xcd_barrier(bar); PH10X(1) }
    if (PROBE_TWICE == 103 && IN(10)) { xcd_barrier(bar); PH10X(3) }
    if (PROBE_TWICE == 104 && IN(10)) { xcd_barrier(bar); moe_tables(F); const LAS int* tab = (const LAS int*)(F.lds + LDS_TAB); const int npan = tab[64] < MAXPAN ? tab[64] : MAXPAN;
        pg8::Gemm g{WSP(bf16, WS_ACT), WSP(bf16, WS_WDT), npan * 256, 1024, D}; MoeOrder S; S.init(npan / 2, 4, F.G, F.wg, tab + 128);
        EpiDownT<3> E{WSP(unsigned char, WS_R1) + 136 * MiB, F.in[22], WSP(float, WS_ROWGATE), (LAS float*)(F.lds + LDS_EPI)}; pg8::gemm_phase<EpiDownT<3>, MoeOrder, true, true, true>(F.lds, g, S, E); }
    SEAM(10);
    if (IN(11)) {
        if (DBG_MODE == 10) { const unsigned short* src = (const unsigned short*)(F.ws + WS_PREP);
            for (size_t i = (size_t)F.wg * NTHR + F.tid; i < (size_t)T * D; i += (size_t)F.G * NTHR) { float v = bf2f(src[i * 3]); F.out[i] = (v == v && fabsf(v) < 1e30f) ? v : 0.f; } }
        else if (DBG_MODE == 11) { const unsigned short* src = (const unsigned short*)(F.ws + WS_O);
            for (size_t i = (size_t)F.wg * NTHR + F.tid; i < (size_t)T * D; i += (size_t)F.G * NTHR) { float v = bf2f(src[i]); F.out[i] = (v == v && fabsf(v) < 1e30f) ? v : 0.f; } }
        else { p11_final(F); if (PROBE_TWICE == 11) { xcd_barrier(bar); p11_final(F); } } }
#undef IN
#undef SEAM
}

extern "C" void kernel_launch(void* const* d_in, const int* in_sizes, int n_in, void* d_out, int out_size, void* d_ws, size_t ws_size, hipStream_t stream) {
    static int grid = 0;
    if (grid == 0) {
        if (n_in != 23 || out_size != T * D || ws_size < WS_END) { fprintf(stderr, "kernel_launch: unexpected problem (n_in %d, out %d, ws %zu)\n", n_in, out_size, ws_size); grid = -1; return; }
        int dev = 0, cus = 0;
        if (hipGetDevice(&dev) != hipSuccess || hipDeviceGetAttribute(&cus, hipDeviceAttributeMultiprocessorCount, dev) != hipSuccess) { grid = -1; return; }
        if (hipFuncSetAttribute((const void*)mk_fwd, hipFuncAttributeMaxDynamicSharedMemorySize, LDS_BYTES) != hipSuccess) { fprintf(stderr, "kernel_launch: hipFuncSetAttribute failed\n"); grid = -1; return; }
        int per_cu = 0;
        if (hipOccupancyMaxActiveBlocksPerMultiprocessor(&per_cu, (const void*)mk_fwd, NTHR, LDS_BYTES) != hipSuccess || per_cu < 1) fprintf(stderr, "kernel_launch: occupancy query says %d\n", per_cu);
        (void)hipGetLastError();
        grid = cus;
        if (T % grid != 0 || T / grid > 256 || (T / grid) % 16 != 0 || SEQ % (T / grid) != 0) { fprintf(stderr, "kernel_launch: grid %d unsupported\n", grid); grid = -1; return; }
    }
    if (grid < 0) return;
    (void)hipMemsetAsync((char*)d_ws + WS_CTL + (size_t)CW_BAR * 4, 0, (size_t)(CW_GCNT + 64 * NE - CW_BAR) * 4, stream);
    Args a{};
    for (int i = 0; i < 23; ++i) a.in[i] = (const float*)d_in[i];
    a.out = (float*)d_out; a.ws = (unsigned char*)d_ws;
#if MK_PER_PHASE
    for (int p = 0; p < NPHASE; ++p) { if (DBG_MODE >= 10 && p >= 5 && p <= 10) continue; a.ph_lo = p; a.ph_hi = p + 1; hipLaunchKernelGGL(mk_fwd, dim3(grid), dim3(NTHR), LDS_BYTES, stream, a); }
#else
    a.ph_lo = 0; a.ph_hi = NPHASE; hipLaunchKernelGGL(mk_fwd, dim3(grid), dim3(NTHR), LDS_BYTES, stream, a);
#endif
}
```
